# Optimizing an MI355X kernel written in HIP

```python
import math
import jax, jax.numpy as jnp
from jax import lax
import numpy as np

D_MODEL = 2048
BATCH = 8
SEQ = 2048
DEPTH = 2

GRID_W = 64
CTX_LEN = 256
MIX_WIDTH = D_MODEL
A_HEAD_DIM = 128
A_WIDTH = D_MODEL // 2
A_HEADS = A_WIDTH // A_HEAD_DIM
B_HEADS = 4
B_VAL_WIDTH = D_MODEL // 2
B_VAL_DIM = B_VAL_WIDTH // B_HEADS
B_KEY_WIDTH = B_VAL_WIDTH // 2
B_KEY_DIM = B_KEY_WIDTH // B_HEADS
GATE_RANK = 16
GLA_GATE_TEMP = 16.0
C_HEAD_DIM = 128
C_HEADS = D_MODEL // (2 * C_HEAD_DIM)
C_VAL_DIM = 2 * C_HEAD_DIM
Q_BLOCK = 128
CHUNK = 32
ROPE_BASE = 10000.0
EPS = 1e-6
N_EVEN = (DEPTH + 1) // 2
N_ODD = DEPTH // 2
EVEN_IN_WIDTH = 4 * A_WIDTH + 2 * B_KEY_WIDTH + B_VAL_WIDTH + 2 * GATE_RANK + MIX_WIDTH
ODD_IN_WIDTH = 4 * MIX_WIDTH

kernel_name = "hybrid_hgrn2_gla_diffattn_dit"


def rms_norm(x, gain):
    xf = x.astype(jnp.float32)
    y = xf * lax.rsqrt(jnp.mean(xf * xf, axis=-1, keepdims=True) + EPS)
    return (y * gain.astype(jnp.float32)).astype(x.dtype)


def adaln(cond, w, b):
    m = jax.nn.silu(cond) @ w + b
    return jnp.split(m, 3, axis=-1)


def to_heads(z, n_heads):
    bsz, length, _ = z.shape
    return z.reshape(bsz, length, n_heads, -1).transpose(0, 2, 1, 3)


def from_heads(z):
    bsz, n_heads, length, d = z.shape
    return z.transpose(0, 2, 1, 3).reshape(bsz, length, n_heads * d)


def grid_positions(n_tokens):
    rows = n_tokens // GRID_W
    pos_r = jnp.repeat(jnp.arange(rows, dtype=jnp.int32), GRID_W)
    pos_c = jnp.tile(jnp.arange(GRID_W, dtype=jnp.int32), rows)
    return pos_r, pos_c


def rope_1d(x, pos):
    half = x.shape[-1] // 2
    inv = ROPE_BASE ** (-jnp.arange(half, dtype=jnp.float32) / half)
    ang = pos.astype(jnp.float32)[:, None] * inv
    cos, sin = jnp.cos(ang), jnp.sin(ang)
    x1, x2 = x[..., :half], x[..., half:]
    return jnp.concatenate([x1 * cos - x2 * sin, x2 * cos + x1 * sin], axis=-1)


def rope_2d(x, pos_r, pos_c):
    r = x.shape[-1] // 2
    return jnp.concatenate([rope_1d(x[..., :r], pos_r), rope_1d(x[..., r:], pos_c)], axis=-1)


def gated_linear_scan(q, k, v, log_a, s0):
    bsz, n_heads, length, dk = q.shape
    n_chunks = length // CHUNK

    def to_chunks(z):
        z = z.astype(jnp.float32).reshape(bsz, n_heads, n_chunks, CHUNK, z.shape[-1])
        return jnp.moveaxis(z, 2, 0)

    mask = jnp.tril(jnp.ones((CHUNK, CHUNK), dtype=bool))

    def step(s, xs):
        qn, kn, vn, an = xs
        b = jnp.cumsum(an, axis=-2)
        q_dec = qn * jnp.exp(b)
        k_inv = kn * jnp.exp(-b)
        scores = jnp.where(mask, jnp.einsum("bhtd,bhsd->bhts", q_dec, k_inv), 0.0)
        o = jnp.einsum("bhts,bhsv->bhtv", scores, vn) + jnp.einsum("bhtd,bhdv->bhtv", q_dec, s)
        b_last = b[..., -1:, :]
        k_tail = kn * jnp.exp(b_last - b)
        s_new = jnp.exp(b_last)[..., 0, :, None] * s + jnp.einsum("bhsd,bhsv->bhdv", k_tail, vn)
        return s_new, o

    s_fin, o_chunks = lax.scan(step, s0.astype(jnp.float32),
                               (to_chunks(q), to_chunks(k), to_chunks(v), to_chunks(log_a)))
    o = jnp.moveaxis(o_chunks, 0, 2).reshape(bsz, n_heads, length, v.shape[-1])
    return o, s_fin


def bidir_prefix_scan(q, k_f, k_b, v, la_f, la_b, n_ctx):
    bsz, n_heads, _, dk = q.shape
    s0 = jnp.zeros((bsz, n_heads, dk, v.shape[-1]), jnp.float32)

    def split(z):
        return z[:, :, :n_ctx], z[:, :, n_ctx:]

    def flip(z):
        return jnp.flip(z, axis=2)

    qc, ql = split(q)
    kfc, kfl = split(k_f)
    kbc, kbl = split(k_b)
    vc, vl = split(v)
    afc, afl = split(la_f)
    abc, abl = split(la_b)
    o_cf, s_f = gated_linear_scan(qc, kfc, vc, afc, s0)
    o_lf, _ = gated_linear_scan(ql, kfl, vl, afl, s_f)
    o_cb, s_b = gated_linear_scan(flip(qc), flip(kbc), flip(vc), flip(abc), s0)
    o_lb, _ = gated_linear_scan(flip(ql), flip(kbl), flip(vl), flip(abl), s_b)
    return jnp.concatenate([o_cf + flip(o_cb), o_lf + flip(o_lb)], axis=2)


def even_mixer(h, n_ctx, layer, lb_logits, w_in, w_a2, b_a2, a_gain, b_gain, w_out):
    sizes = [A_WIDTH] * 4 + [B_KEY_WIDTH, B_KEY_WIDTH, B_VAL_WIDTH, GATE_RANK, GATE_RANK]
    cuts = np.cumsum(sizes).tolist()
    a_q, a_ff, a_fb, a_i, b_q, b_k, b_v, b_zf, b_zb, gate = jnp.split(h @ w_in, cuts, axis=-1)
    lb = jnp.cumsum(jax.nn.softmax(lb_logits.astype(jnp.float32), axis=0), axis=0)[layer]
    f_f = lb + (1.0 - lb) * jax.nn.sigmoid(a_ff.astype(jnp.float32))
    f_b = lb + (1.0 - lb) * jax.nn.sigmoid(a_fb.astype(jnp.float32))
    o_a = bidir_prefix_scan(
        to_heads(jax.nn.silu(a_q), A_HEADS),
        to_heads(1.0 - f_f, A_HEADS), to_heads(1.0 - f_b, A_HEADS),
        to_heads(a_i, A_HEADS),
        to_heads(jnp.log(f_f), A_HEADS), to_heads(jnp.log(f_b), A_HEADS), n_ctx)
    o_a = from_heads(rms_norm(o_a, a_gain))
    la_f = jax.nn.log_sigmoid((b_zf @ w_a2[0] + b_a2[0]).astype(jnp.float32)) / GLA_GATE_TEMP
    la_b = jax.nn.log_sigmoid((b_zb @ w_a2[1] + b_a2[1]).astype(jnp.float32)) / GLA_GATE_TEMP
    k_heads = to_heads(b_k, B_HEADS)
    o_b = bidir_prefix_scan(
        to_heads(b_q * (B_KEY_DIM ** -0.5), B_HEADS), k_heads, k_heads,
        to_heads(b_v, B_HEADS),
        to_heads(la_f, B_HEADS), to_heads(la_b, B_HEADS), n_ctx)
    o_b = from_heads(rms_norm(o_b, b_gain))
    o = jnp.concatenate([o_a, o_b], axis=-1).astype(h.dtype) * jax.nn.silu(gate)
    return o @ w_out


def odd_mixer(h, n_ctx, layer, w_in, q_gain, k_gain, lam_qk, o_gain, w_out, with_ctx_out):
    bsz, length, _ = h.shape
    n_lat = length - n_ctx
    q, k, v, gate = jnp.split(h @ w_in, 4, axis=-1)

    def pair_heads(z):
        return z.reshape(bsz, length, C_HEADS, 2, C_HEAD_DIM).transpose(3, 0, 2, 1, 4)

    q = rms_norm(pair_heads(q), q_gain)
    k = rms_norm(pair_heads(k), k_gain)
    v = to_heads(v, C_HEADS)
    pos_r, pos_c = grid_positions(n_lat)
    q_lat = rope_2d(q[..., n_ctx:, :], pos_r, pos_c)
    k_all = jnp.concatenate([k[..., :n_ctx, :].astype(jnp.float32),
                             rope_2d(k[..., n_ctx:, :], pos_r, pos_c)], axis=-2)
    lam_init = 0.8 - 0.6 * math.exp(-0.3 * layer)
    lq = lam_qk.astype(jnp.float32)
    lam = jnp.exp(jnp.sum(lq[0] * lq[1])) - jnp.exp(jnp.sum(lq[2] * lq[3])) + lam_init
    scale = C_HEAD_DIM ** -0.5

    def diff_attend(qq, kk, vv):
        s = jnp.einsum("nbhqd,nbhkd->nbhqk", qq.astype(jnp.float32), kk.astype(jnp.float32)) * scale
        p = jax.nn.softmax(s, axis=-1)
        return jnp.einsum("bhqk,bhkv->bhqv", p[0] - lam * p[1], vv.astype(jnp.float32))

    n_blk = n_lat // Q_BLOCK
    q_blocks = jnp.moveaxis(q_lat.reshape(2, bsz, C_HEADS, n_blk, Q_BLOCK, C_HEAD_DIM), 3, 0)
    o_lat = lax.map(lambda qb: diff_attend(qb, k_all, v), q_blocks)
    o = jnp.moveaxis(o_lat, 0, 2).reshape(bsz, C_HEADS, n_lat, C_VAL_DIM)
    if with_ctx_out:
        o_ctx = diff_attend(q[..., :n_ctx, :], k[..., :n_ctx, :], v[:, :, :n_ctx])
        o = jnp.concatenate([o_ctx, o], axis=2)
    else:
        gate = gate[:, n_ctx:]
    o = rms_norm(o, o_gain) * (1.0 - lam_init)
    return (from_heads(o).astype(h.dtype) * jax.nn.silu(gate)) @ w_out


def setup_inputs(seed: int = 0) -> dict:
    key = jax.random.key(seed)
    ks = jax.random.split(key, 20)
    f32 = jnp.float32
    D = D_MODEL

    def nrm(k, shape, scale):
        return jax.random.normal(k, shape, f32) * scale

    return {
        "x": nrm(ks[0], (BATCH, SEQ, D), 1.0),
        "c": nrm(ks[1], (BATCH, D), 1.0),
        "ctx": nrm(ks[2], (BATCH, CTX_LEN, D), 1.0),
        "c_ctx": nrm(ks[3], (D,), 1.0),
        "norm_gain": 1.0 + nrm(ks[4], (DEPTH, D), 0.02),
        "w_ada": nrm(ks[5], (DEPTH, D, 3 * D), 0.5 * D ** -0.5),
        "b_ada": nrm(ks[6], (DEPTH, 3 * D), 0.02),
        "lb_logits": nrm(ks[7], (DEPTH + 1, A_WIDTH), 0.1),
        "w_in_even": nrm(ks[8], (N_EVEN, D, EVEN_IN_WIDTH), D ** -0.5),
        "w_a2": nrm(ks[9], (N_EVEN, 2, GATE_RANK, B_KEY_WIDTH), GATE_RANK ** -0.5),
        "b_a2": nrm(ks[10], (N_EVEN, 2, B_KEY_WIDTH), 0.1),
        "a_out_gain": 1.0 + nrm(ks[11], (N_EVEN, A_HEAD_DIM), 0.02),
        "b_out_gain": 1.0 + nrm(ks[12], (N_EVEN, B_VAL_DIM), 0.02),
        "w_out_even": nrm(ks[13], (N_EVEN, MIX_WIDTH, D), MIX_WIDTH ** -0.5),
        "w_in_odd": nrm(ks[14], (N_ODD, D, ODD_IN_WIDTH), D ** -0.5),
        "q_norm_gain": 1.0 + nrm(ks[15], (N_ODD, C_HEAD_DIM), 0.02),
        "k_norm_gain": 1.0 + nrm(ks[16], (N_ODD, C_HEAD_DIM), 0.02),
        "lambda_qk": nrm(ks[17], (N_ODD, 4, C_HEAD_DIM), 0.1),
        "c_out_gain": 1.0 + nrm(ks[18], (N_ODD, C_VAL_DIM), 0.02),
        "w_out_odd": nrm(ks[19], (N_ODD, MIX_WIDTH, D), MIX_WIDTH ** -0.5),
    }


def reference(x, c, ctx, c_ctx, norm_gain, w_ada, b_ada, lb_logits, w_in_even, w_a2, b_a2,
              a_out_gain, b_out_gain, w_out_even, w_in_odd, q_norm_gain, k_norm_gain,
              lambda_qk, c_out_gain, w_out_odd):
    n_ctx = ctx.shape[1]
    n_lat = x.shape[1]
    for l in range(DEPTH):
        last = l == DEPTH - 1
        j = l // 2
        shift, scale, gate = adaln(c, w_ada[l], b_ada[l])
        shift_c, scale_c, gate_c = adaln(c_ctx, w_ada[l], b_ada[l])
        h_lat = rms_norm(x, norm_gain[l]) * (1.0 + scale[:, None]) + shift[:, None]
        h_ctx = rms_norm(ctx, norm_gain[l]) * (1.0 + scale_c) + shift_c
        h = jnp.concatenate([h_ctx, h_lat.astype(h_ctx.dtype)], axis=1)
        if l % 2 == 0:
            out = even_mixer(h, n_ctx, l, lb_logits, w_in_even[j], w_a2[j], b_a2[j],
                             a_out_gain[j], b_out_gain[j], w_out_even[j])
        else:
            out = odd_mixer(h, n_ctx, l, w_in_odd[j], q_norm_gain[j], k_norm_gain[j],
                            lambda_qk[j], c_out_gain[j], w_out_odd[j], not last)
        x = x + gate[:, None] * out[:, -n_lat:]
        if not last:
            ctx = ctx + gate_c * out[:, :n_ctx]
    return x
```

```cpp
#include <hip/hip_runtime.h>
#include <hip/hip_bf16.h>
#include <hip/hip_cooperative_groups.h>
#include <cstdio>
#include <cstdint>
#include <cmath>
namespace cg = cooperative_groups;

namespace pg8 {
#define PG8_LAS __attribute__((address_space(3)))
typedef unsigned short bf16_t;
typedef short bf16x8 __attribute__((ext_vector_type(8)));
typedef float f32x4 __attribute__((ext_vector_type(4)));
typedef unsigned u32x4 __attribute__((ext_vector_type(4)));
constexpr int BM = 256, BK = 64, HALF = 128, HTB = HALF * BK * 2  , STAGE_BYTES = 8 * HTB, NXCD = 8, WGM = 8;

__host__ __device__ __forceinline__ int lds_byte(int r, int c) { const int st = (r >> 4) * 2 + (c >> 5), rr = r & 15, cc = c & 31, ob = rr * 64 + cc * 2; return st * 1024 + (ob ^ (((ob >> 9) & 1) << 5)); }
__host__ __device__ __forceinline__ void stage_rc(int b, int& R, int& C) { const int st = b / 1024, sb = b % 1024, swz = sb ^ (((sb >> 9) & 1) << 5); R = (st >> 1) * 16 + swz / 64; C = (st & 1) * 32 + (swz % 64) / 2; }
__host__ __device__ __forceinline__ int perm32(int rho) { const int n = rho >> 4, i = rho & 15; return 8 * (i >> 2) + 4 * n + (i & 3); }

struct Unit { int pm, pn; };
struct Gemm { const bf16_t* A; const bf16_t* Bt; int M, N, K; };

struct StaticOrder {
    int nM, nN, nwg, G, c;
    __host__ __device__ void init(int M, int N, int G_, int c_) { nM = M / BM; nN = N / BM; nwg = nM * nN; G = G_; c = c_; }
    __host__ __device__ bool next(int i, Unit& u) const {
        const long L = (long)i * G + c; if (L >= nwg) return false;
        int wgid = (int)L; { const int q = nwg / NXCD, r = nwg % NXCD, xcd = wgid % NXCD, off = wgid / NXCD; wgid = (xcd < r ? xcd * (q + 1) : r * (q + 1) + (xcd - r) * q) + off; }
        const int nig = WGM * nN, gid = wgid / nig, fm = gid * WGM, gsz = (nM - fm) < WGM ? (nM - fm) : WGM;
        u.pm = fm + ((wgid % nig) % gsz); u.pn = (wgid % nig) / gsz; return true;
    }
    __device__ __forceinline__ void a_ready(const Unit&) const {}
    __device__ __forceinline__ void done(const Unit&) const {}
};

__device__ __forceinline__ unsigned cvt_pk_bf16(float lo, float hi) { unsigned r; asm volatile("v_cvt_pk_bf16_f32 %0, %1, %2" : "=v"(r) : "v"(lo), "v"(hi)); return r; }
struct EpiStoreBf16 {
    static constexpr bool PERM = true, AFTER_DRAIN = false;
    bf16_t* O; int ldc;
    __device__ __forceinline__ void operator()(const f32x4 (&acc)[2][2][4][2], const Unit& u, int wr, int wc, int fr, int fq) const {
        const int row0 = u.pm * BM + wr * 64 + fr; const int col0 = u.pn * BM + wc * 32 + 8 * fq;
#pragma unroll
        for (int ai = 0; ai < 2; ++ai)
#pragma unroll
            for (int m = 0; m < 4; ++m) { bf16_t* rowp = O + (size_t)(row0 + ai * HALF + m * 16) * ldc + col0;
#pragma unroll
                for (int bj = 0; bj < 2; ++bj) { const f32x4 v0 = acc[ai][bj][m][0], v1 = acc[ai][bj][m][1];
                    u32x4 w; w.x = cvt_pk_bf16(v0[0], v0[1]); w.y = cvt_pk_bf16(v0[2], v0[3]); w.z = cvt_pk_bf16(v1[0], v1[1]); w.w = cvt_pk_bf16(v1[2], v1[3]);
                    *(u32x4*)(rowp + bj * HALF) = w; } }
    }
};
struct EpiRes {
    static constexpr bool PERM = false, AFTER_DRAIN = false;
    const float* xsrc; float* xdst; const float* csrc; float* cdst; const float* mod; int tpb;
    __device__ __forceinline__ void operator()(const f32x4 (&acc)[2][2][4][2], const Unit& u, int wr, int wc, int fr, int fq) const {
        const int b = u.pm / tpb, j = u.pm - b * tpb;
        const float* src; float* dst; const float* g;
        if (tpb == 9 && j == 0) { const size_t off = (size_t)b * 256 * 2048; src = csrc + off; dst = cdst + off; g = mod + 8 * 6144 + 4096; }
        else { const int jj = (tpb == 9) ? j - 1 : j; const size_t off = ((size_t)b * 2048 + (size_t)jj * 256) * 2048; src = xsrc + off; dst = xdst + off; g = mod + b * 6144 + 4096; }
        const int r0 = wr * 64 + fr, col0 = u.pn * BM + wc * 32 + 4 * fq;
        f32x4 gv[2][2];
#pragma unroll
        for (int bj = 0; bj < 2; ++bj)
#pragma unroll
            for (int n = 0; n < 2; ++n) gv[bj][n] = *(const f32x4*)(g + col0 + bj * HALF + n * 16);
#pragma unroll
        for (int ai = 0; ai < 2; ++ai)
#pragma unroll
            for (int m = 0; m < 4; ++m) { const size_t roff = (size_t)(r0 + ai * HALF + m * 16) * 2048 + col0;
#pragma unroll
                for (int bj = 0; bj < 2; ++bj)
#pragma unroll
                    for (int n = 0; n < 2; ++n) { const f32x4 s = *(const f32x4*)(src + roff + bj * HALF + n * 16); *(f32x4*)(dst + roff + bj * HALF + n * 16) = s + gv[bj][n] * acc[ai][bj][m][n]; }
                asm volatile("" ::: "memory"); }
    }
};

template <class Epi, class Sched, bool ALIGN_EPI = false, bool SP2 = false>
__device__ __forceinline__ void gemm_phase(PG8_LAS unsigned char* lds, const Gemm g, const Sched& S, const Epi& E) {
    const int tid = threadIdx.x, wid = __builtin_amdgcn_readfirstlane(tid >> 6), lane = tid & 63, wr = wid >> 2, wc = wid & 3, fr = lane & 15, fq = lane >> 4;
    const int K = g.K, nt = K / BK;
    unsigned voffA[2], voffB[2];
#pragma unroll
    for (int i = 0; i < 2; ++i) { int R, C; stage_rc(tid * 16 + i * 8192, R, C); const int Rb = Epi::PERM ? ((R & ~31) + perm32(R & 31)) : R;
        voffA[i] = (unsigned)(R * K + C) * 2u; voffB[i] = (unsigned)(Rb * K + C) * 2u; }
    const size_t kstep = (size_t)(BK * 2);
    const size_t hstep = (size_t)HALF * K * 2;
    const size_t tstep = 2 * hstep;
    const unsigned ldsw = (unsigned)wid * 1024u;
    const int aoff = lds_byte(wr * 64 + fr, fq * 8), boff = lds_byte(wc * 32 + fr, fq * 8);
#define PG8_SA(b, h) (((b) * 2 + (h)) * HTB)
#define PG8_SB(b, h) ((4 + (b) * 2 + (h)) * HTB)
#define PG8_STAGE(bufoff, gbase, voff) do { _Pragma("unroll") for (int _i = 0; _i < 2; ++_i) \
        __builtin_amdgcn_global_load_lds((const unsigned*)((const char*)(gbase) + (voff)[_i]), (PG8_LAS unsigned*)(lds + (bufoff) + ldsw + _i * 8192), 16, 0, 0); } while (0)
#define PG8_LDA(dst, b, h) do { _Pragma("unroll") for (int m = 0; m < 4; ++m) _Pragma("unroll") for (int k = 0; k < 2; ++k) dst[m][k] = *(const PG8_LAS bf16x8*)(lds + PG8_SA(b, h) + aoff + m * 2048 + k * 1024); } while (0)
#define PG8_LDB(dst, b, h) do { _Pragma("unroll") for (int n = 0; n < 2; ++n) _Pragma("unroll") for (int k = 0; k < 2; ++k) dst[n][k] = *(const PG8_LAS bf16x8*)(lds + PG8_SB(b, h) + boff + n * 2048 + k * 1024); } while (0)
#define PG8_MMA(ai, bj, At, Bt) do { __builtin_amdgcn_s_setprio(1); _Pragma("unroll") for (int m = 0; m < 4; ++m) _Pragma("unroll") for (int n = 0; n < 2; ++n) _Pragma("unroll") for (int k = 0; k < 2; ++k) \
        acc[ai][bj][m][n] = __builtin_amdgcn_mfma_f32_16x16x32_bf16(Bt[n][k], At[m][k], acc[ai][bj][m][n], 0, 0, 0); __builtin_amdgcn_s_setprio(0); } while (0)
#define PG8_WAIT_V(n) asm volatile("s_waitcnt vmcnt(" #n ")" ::: "memory")
#define PG8_WAIT_L(n) asm volatile("s_waitcnt lgkmcnt(" #n ")" ::: "memory")
#define PG8_BAR __builtin_amdgcn_s_barrier()
#define PG8_SCHED __builtin_amdgcn_sched_barrier(0)
    Unit cur, nxt; int ui = 0;
    if (!S.next(0, cur)) return;
    f32x4 acc[2][2][4][2];
#pragma unroll
    for (int a = 0; a < 2; ++a)
#pragma unroll
        for (int b = 0; b < 2; ++b)
#pragma unroll
            for (int m = 0; m < 4; ++m)
#pragma unroll
                for (int n = 0; n < 2; ++n) acc[a][b][m][n] = (f32x4){0.f, 0.f, 0.f, 0.f};
    bf16x8 At[4][2], B0[2][2], B1[2][2];
    const char* cA = (const char*)g.A + (size_t)cur.pm * tstep; const char* cB = (const char*)g.Bt + (size_t)cur.pn * tstep;
    S.a_ready(cur);
    if constexpr (SP2) {
        PG8_STAGE(PG8_SB(0, 0), cB, voffB); PG8_STAGE(PG8_SB(0, 1), cB + hstep, voffB); PG8_STAGE(PG8_SA(0, 0), cA, voffA); PG8_STAGE(PG8_SA(0, 1), cA + hstep, voffA);
        if (wr == 1) PG8_BAR;
        PG8_WAIT_V(2); PG8_BAR;
        PG8_STAGE(PG8_SB(1, 0), cB + kstep, voffB); PG8_STAGE(PG8_SA(1, 0), cA + kstep, voffA); PG8_STAGE(PG8_SB(1, 1), cB + hstep + kstep, voffB);
        PG8_WAIT_V(6); PG8_BAR;
    } else {
        PG8_STAGE(PG8_SB(0, 0), cB, voffB); PG8_STAGE(PG8_SA(0, 0), cA, voffA); PG8_STAGE(PG8_SB(0, 1), cB + hstep, voffB); PG8_STAGE(PG8_SA(0, 1), cA + hstep, voffA);
        if (wr == 1) PG8_BAR;
        PG8_WAIT_V(4); PG8_BAR;
        PG8_STAGE(PG8_SB(1, 0), cB + kstep, voffB); PG8_STAGE(PG8_SA(1, 0), cA + kstep, voffA); PG8_STAGE(PG8_SB(1, 1), cB + hstep + kstep, voffB);
        PG8_WAIT_V(6); PG8_BAR;
    }
    for (;;) {
        const bool has_next = S.next(ui + 1, nxt);
        const char* nA = has_next ? (const char*)g.A + (size_t)nxt.pm * tstep : cA; const char* nB = has_next ? (const char*)g.Bt + (size_t)nxt.pn * tstep : cB;
        for (int t = 0; t < nt; t += 2) {
            const bool last = (t == nt - 2);
            const char* a1 = cA + (size_t)(t + 1) * kstep;
            const char* a2 = last ? nA : cA + (size_t)(t + 2) * kstep; const char* b2 = last ? nB : cB + (size_t)(t + 2) * kstep;
            const char* a3 = a2 + kstep; const char* b3 = b2 + kstep;
            if (last && has_next) S.a_ready(nxt);
            if constexpr (SP2) {
            PG8_LDB(B0, 0, 0); PG8_LDB(B1, 0, 1); PG8_SCHED; PG8_LDA(At, 0, 0); PG8_STAGE(PG8_SA(1, 1), a1 + hstep, voffA);
            PG8_WAIT_V(8); PG8_WAIT_L(0); PG8_BAR; PG8_MMA(0, 0, At, B0); PG8_MMA(0, 1, At, B1); PG8_BAR; PG8_SCHED;
            PG8_LDA(At, 0, 1); PG8_STAGE(PG8_SB(0, 0), b2, voffB); PG8_STAGE(PG8_SB(0, 1), b2 + hstep, voffB); PG8_STAGE(PG8_SA(0, 0), a2, voffA);
            PG8_WAIT_V(8); PG8_WAIT_L(0); PG8_BAR; PG8_MMA(1, 0, At, B0); PG8_MMA(1, 1, At, B1); PG8_BAR; PG8_SCHED;
            PG8_LDB(B0, 1, 0); PG8_LDB(B1, 1, 1); PG8_SCHED; PG8_LDA(At, 1, 0); PG8_STAGE(PG8_SA(0, 1), a2 + hstep, voffA);
            PG8_WAIT_V(8); PG8_WAIT_L(0); PG8_BAR; PG8_MMA(0, 0, At, B0); PG8_MMA(0, 1, At, B1); PG8_BAR; PG8_SCHED;
            PG8_LDA(At, 1, 1); PG8_STAGE(PG8_SB(1, 0), b3, voffB); PG8_STAGE(PG8_SB(1, 1), b3 + hstep, voffB); PG8_STAGE(PG8_SA(1, 0), a3, voffA);
            PG8_WAIT_V(8); PG8_WAIT_L(0); PG8_BAR; PG8_MMA(1, 0, At, B0); PG8_MMA(1, 1, At, B1); PG8_BAR; PG8_SCHED;
            } else {
            PG8_LDB(B0, 0, 0); PG8_SCHED; PG8_LDA(At, 0, 0); PG8_STAGE(PG8_SA(1, 1), a1 + hstep, voffA);
            PG8_WAIT_L(8); PG8_BAR; PG8_WAIT_L(0); PG8_MMA(0, 0, At, B0); PG8_BAR; PG8_SCHED;
            PG8_LDB(B1, 0, 1); PG8_STAGE(PG8_SB(0, 0), b2, voffB);
            PG8_BAR; PG8_WAIT_L(0); PG8_MMA(0, 1, At, B1); PG8_BAR;
            PG8_LDA(At, 0, 1); PG8_STAGE(PG8_SA(0, 0), a2, voffA);
            PG8_BAR; PG8_WAIT_L(0); PG8_MMA(1, 0, At, B0); PG8_BAR; PG8_SCHED;
            PG8_STAGE(PG8_SB(0, 1), b2 + hstep, voffB);
            PG8_WAIT_V(6); PG8_BAR; PG8_MMA(1, 1, At, B1); PG8_BAR;
            PG8_LDB(B0, 1, 0); PG8_SCHED; PG8_LDA(At, 1, 0); PG8_STAGE(PG8_SA(0, 1), a2 + hstep, voffA);
            PG8_WAIT_L(8); PG8_BAR; PG8_WAIT_L(0); PG8_MMA(0, 0, At, B0); PG8_BAR; PG8_SCHED;
            PG8_LDB(B1, 1, 1); PG8_STAGE(PG8_SB(1, 0), b3, voffB);
            PG8_BAR; PG8_WAIT_L(0); PG8_MMA(0, 1, At, B1); PG8_BAR;
            PG8_LDA(At, 1, 1); PG8_STAGE(PG8_SA(1, 0), a3, voffA);
            PG8_BAR; PG8_WAIT_L(0); PG8_MMA(1, 0, At, B0); PG8_BAR; PG8_SCHED;
            PG8_STAGE(PG8_SB(1, 1), b3 + hstep, voffB);
            PG8_WAIT_V(6); PG8_BAR; PG8_MMA(1, 1, At, B1); PG8_BAR;
            }
        }
        if constexpr (ALIGN_EPI) { if (wr == 0) PG8_BAR; }
        if constexpr (!Epi::AFTER_DRAIN) { E(acc, cur, wr, wc, fr, fq); S.done(cur); }
        if (!has_next) break;
#pragma unroll
        for (int a = 0; a < 2; ++a)
#pragma unroll
            for (int b = 0; b < 2; ++b)
#pragma unroll
                for (int m = 0; m < 4; ++m)
#pragma unroll
                    for (int n = 0; n < 2; ++n) acc[a][b][m][n] = (f32x4){0.f, 0.f, 0.f, 0.f};
        cur = nxt; cA = nA; cB = nB; ++ui;
        if constexpr (ALIGN_EPI) { if (wr == 1) PG8_BAR; }
    }
    PG8_WAIT_V(0);
    if constexpr (!ALIGN_EPI) { if (wr == 0) PG8_BAR; }
    PG8_BAR;
    if constexpr (Epi::AFTER_DRAIN) { E.fused(acc, cur, wr, wc, fr, fq, lds, wid, lane); S.done(cur); }
#undef PG8_SA
#undef PG8_SB
#undef PG8_STAGE
#undef PG8_LDA
#undef PG8_LDB
#undef PG8_MMA
#undef PG8_WAIT_V
#undef PG8_WAIT_L
#undef PG8_BAR
#undef PG8_SCHED
}
}
namespace attn {
using bf16 = __hip_bfloat16;
constexpr int   D = 128, NW = 8, QBLK = 32, KVBLK = 64;
constexpr float SCALE = 0.088388347648318440f;
constexpr float THR = 8.f;
#ifndef ATT_SDEPTH
#define ATT_SDEPTH 1
#endif
constexpr int SDEPTH = ATT_SDEPTH;
constexpr int LDQ = 8192, LDK = 8192, LDO = 2048;
constexpr size_t SHM_V = KVBLK * D * 2, SHM_K = KVBLK * D * 2, SHM_ATTN = 2 * SHM_V + 2 * SHM_K + NW * 64 * 4;
using bf16x8 = __attribute__((ext_vector_type(8))) short;
using s16x4  = __attribute__((ext_vector_type(4))) short;
using f32x16 = __attribute__((ext_vector_type(16))) float;
using f32x8  = __attribute__((ext_vector_type(8))) float;
using u32x4  = __attribute__((ext_vector_type(4))) unsigned;
#define KSWZ(row, colB) ((row) * 256 + ((colB) ^ (((row) & 7) << 4)))
#define SBAR() __builtin_amdgcn_sched_barrier(0)
__device__ __forceinline__ int crow(int r, int hi) { return (r & 3) + 8 * (r >> 2) + 4 * hi; }
__device__ __forceinline__ unsigned cvtpk(float lo, float hi) {
  unsigned r; asm volatile("v_cvt_pk_bf16_f32 %0, %1, %2" : "=v"(r) : "v"(lo), "v"(hi)); return r;
}
template <typename TIn> struct Stage;
template <> struct Stage<bf16>  { using T = bf16x8;
  __device__ static __forceinline__ T ld8(const bf16* p) { return *reinterpret_cast<const bf16x8*>(p); }
  __device__ static __forceinline__ bf16x8 tobf(T x) { return x; } };
template <> struct Stage<float> { using T = f32x8;
  __device__ static __forceinline__ T ld8(const float* p) { return *reinterpret_cast<const f32x8*>(p); }
  __device__ static __forceinline__ bf16x8 tobf(T x) {
    u32x4 w = {cvtpk(x[0], x[1]), cvtpk(x[2], x[3]), cvtpk(x[4], x[5]), cvtpk(x[6], x[7])}; return *reinterpret_cast<bf16x8*>(&w); } };

__device__ __forceinline__ void partialSM(f32x16& p0, f32x16& p1, float& m_reg, float& mn, float& alpha) {
  constexpr float C = SCALE * 1.4426950408889634f;
  float pmax = p0[0]; for (int r = 1; r < 16; ++r) pmax = fmaxf(pmax, p0[r]); for (int r = 0; r < 16; ++r) pmax = fmaxf(pmax, p1[r]);
  { auto rr = __builtin_amdgcn_permlane32_swap(__float_as_uint(pmax), __float_as_uint(pmax), false, false);
    pmax = fmaxf(__uint_as_float(rr[0]), __uint_as_float(rr[1])); }
  if (__builtin_expect(__all(pmax - m_reg <= THR / SCALE), 1)) { mn = m_reg; alpha = 1.f; }
  else { mn = fmaxf(m_reg, pmax); alpha = __builtin_amdgcn_exp2f((m_reg - mn) * C); m_reg = mn; }
  float mnC = -mn * C;
  for (int r = 0; r < 16; ++r) p0[r] = fmaf(p0[r], C, mnC); for (int r = 0; r < 16; ++r) p1[r] = fmaf(p1[r], C, mnC);
  for (int r = 0; r < 16; ++r) p0[r] = __builtin_amdgcn_exp2f(p0[r]);
}
__device__ __forceinline__ void finishSM(f32x16& p0, f32x16& p1, float alpha, float& l_reg, bf16x8& pa0, bf16x8& pa1, bf16x8& pa2, bf16x8& pa3) {
  for (int r = 0; r < 16; ++r) p1[r] = __builtin_amdgcn_exp2f(p1[r]);
  float ps = 0; for (int r = 0; r < 16; ++r) ps += p0[r]; for (int r = 0; r < 16; ++r) ps += p1[r];
  { auto rr = __builtin_amdgcn_permlane32_swap(__float_as_uint(ps), __float_as_uint(ps), false, false);
    ps = __uint_as_float(rr[0]) + __uint_as_float(rr[1]); }
  l_reg = l_reg * alpha + ps;
#define PK4(P, BASE, OUT) do { unsigned a0 = cvtpk(P[BASE + 0], P[BASE + 1]), a1 = cvtpk(P[BASE + 2], P[BASE + 3]);   \
    unsigned b0 = cvtpk(P[BASE + 4], P[BASE + 5]), b1 = cvtpk(P[BASE + 6], P[BASE + 7]);                              \
    auto r0 = __builtin_amdgcn_permlane32_swap(a0, b0, false, false); auto r1 = __builtin_amdgcn_permlane32_swap(a1, b1, false, false); \
    u32x4 w = {r0[0], r1[0], r0[1], r1[1]}; OUT = *reinterpret_cast<bf16x8*>(&w); } while (0)
  PK4(p0, 0, pa0); PK4(p0, 8, pa1); PK4(p1, 0, pa2); PK4(p1, 8, pa3);
#undef PK4
}
__device__ __forceinline__ void qkt(f32x16& p0, f32x16& p1, const bf16* Ks, const bf16x8* qr, int r32, int hi) {
  p0 = f32x16{}; p1 = f32x16{};
  for (int d0 = 0; d0 < 8; ++d0) { int cb = (d0 * 16 + hi * 8) * 2;
    bf16x8 b0 = *reinterpret_cast<const bf16x8*>((const char*)Ks + KSWZ(r32, cb));
    bf16x8 b1 = *reinterpret_cast<const bf16x8*>((const char*)Ks + KSWZ(32 + r32, cb));
    p0 = __builtin_amdgcn_mfma_f32_32x32x16_bf16(b0, qr[d0], p0, 0, 0, 0);
    p1 = __builtin_amdgcn_mfma_f32_32x32x16_bf16(b1, qr[d0], p1, 0, 0, 0); }
}
__device__ __forceinline__ int v_st(int k, int c) { const int kk = (k & ~0xC) | ((k & 4) << 1) | ((k & 8) >> 1); return ((kk >> 3) * 4 + (c >> 5)) * 512 + ((kk & 7) * 32 + (c & 31)) * 2; }
__device__ __forceinline__ int v_rd_base(int lane) { return ((lane & 3) << 3) | (((lane >> 2) & 3) << 6) | (((lane >> 4) & 1) << 5) | (((lane >> 5) & 1) << 8); }
constexpr int v_rd_off(int d0, int ks, int half) { return d0 * 512 + ks * 4096 + half * 2048; }
template <int OFF> __device__ __forceinline__ s16x4 tr_read(int vb) {
  s16x4 r; asm volatile("ds_read_b64_tr_b16 %0, %1 offset:%2" : "=&v"(r) : "v"(vb), "i"(OFF) : "memory"); return r;
}
template <int D0> __device__ __forceinline__ void pv_one(f32x16& od, int vb, bf16x8 pa0, bf16x8 pa1, bf16x8 pa2, bf16x8 pa3) {
  const s16x4 l0 = tr_read<v_rd_off(D0, 0, 0)>(vb), h0 = tr_read<v_rd_off(D0, 0, 1)>(vb), l1 = tr_read<v_rd_off(D0, 1, 0)>(vb), h1 = tr_read<v_rd_off(D0, 1, 1)>(vb);
  const s16x4 l2 = tr_read<v_rd_off(D0, 2, 0)>(vb), h2 = tr_read<v_rd_off(D0, 2, 1)>(vb), l3 = tr_read<v_rd_off(D0, 3, 0)>(vb), h3 = tr_read<v_rd_off(D0, 3, 1)>(vb);
  asm volatile("s_waitcnt lgkmcnt(0)" ::: "memory"); SBAR();
#define PK(L, H) (bf16x8){L[0], L[1], L[2], L[3], H[0], H[1], H[2], H[3]}
  od = __builtin_amdgcn_mfma_f32_32x32x16_bf16(pa0, PK(l0, h0), od, 0, 0, 0);
  od = __builtin_amdgcn_mfma_f32_32x32x16_bf16(pa1, PK(l1, h1), od, 0, 0, 0);
  od = __builtin_amdgcn_mfma_f32_32x32x16_bf16(pa2, PK(l2, h2), od, 0, 0, 0);
  od = __builtin_amdgcn_mfma_f32_32x32x16_bf16(pa3, PK(l3, h3), od, 0, 0, 0);
#undef PK
}
__device__ __forceinline__ void pv_d0(f32x16* o, int vb, bf16x8 pa0, bf16x8 pa1, bf16x8 pa2, bf16x8 pa3) {
  pv_one<0>(o[0], vb, pa0, pa1, pa2, pa3); pv_one<1>(o[1], vb, pa0, pa1, pa2, pa3); pv_one<2>(o[2], vb, pa0, pa1, pa2, pa3); pv_one<3>(o[3], vb, pa0, pa1, pa2, pa3);
}

template <typename TQ>
__device__ __forceinline__ void attn_dense_body(const TQ* __restrict__ Qb, const bf16* __restrict__ Kh, const bf16* __restrict__ Vh,
                                                bf16* __restrict__ Ob, int seq, char* lds) {
  using St = Stage<bf16>; using SQ = Stage<TQ>;
  const int tid = threadIdx.x, wid = tid >> 6, lane = tid & 63, r32 = lane & 31, hi = lane >> 5;
  bf16* V_lds = (bf16*)lds; bf16* K_lds = (bf16*)(lds + 2 * SHM_V);
  float* ws = (float*)(lds + 2 * SHM_V + 2 * SHM_K) + wid * 64; float* li_l = ws; float* al_l = ws + 32;
  float m_reg = -1e30f, l_reg = 0; f32x16 o[4] = {}; bf16x8 qr[8];
  const TQ* Qw = Qb + (long)(wid * QBLK + r32) * LDQ + hi * 8;
#pragma unroll
  for (int d0 = 0; d0 < 8; ++d0) qr[d0] = SQ::tobf(SQ::ld8(Qw + d0 * 16));
  const int sr = tid >> 4, sc = (tid & 15) * 8, vst0 = v_st(sr, sc), vst1 = v_st(32 + sr, sc);
  const int vb0 = (int)(uintptr_t)V_lds + v_rd_base(lane);
  struct { typename St::T vs0, vs1, ks0, ks1; } sr_[SDEPTH];
#define SLOAD(i, k0) do { sr_[i].vs0 = St::ld8(&Vh[(long)((k0) + sr) * LDK + sc]); sr_[i].vs1 = St::ld8(&Vh[(long)((k0) + 32 + sr) * LDK + sc]); \
    sr_[i].ks0 = St::ld8(&Kh[(long)((k0) + sr) * LDK + sc]); sr_[i].ks1 = St::ld8(&Kh[(long)((k0) + 32 + sr) * LDK + sc]); } while (0)
#define SWRITE(b, i) do { *(bf16x8*)((char*)V_lds + (b) * SHM_V + vst0) = St::tobf(sr_[i].vs0);          \
    *(bf16x8*)((char*)V_lds + (b) * SHM_V + vst1) = St::tobf(sr_[i].vs1); int kc = sc * 2;               \
    *(bf16x8*)((char*)K_lds + (b) * SHM_K + KSWZ(sr, kc)) = St::tobf(sr_[i].ks0);                       \
    *(bf16x8*)((char*)K_lds + (b) * SHM_K + KSWZ(32 + sr, kc)) = St::tobf(sr_[i].ks1); } while (0)
#define SWAIT() do { if constexpr (SDEPTH == 2) asm volatile("s_waitcnt vmcnt(4)" ::: "memory"); else asm volatile("s_waitcnt vmcnt(0)" ::: "memory"); } while (0)
#define RESC(a) do { if (__any((a) < 1.f)) { if (hi == 0) al_l[r32] = (a); asm volatile("s_waitcnt lgkmcnt(0)" ::: "memory"); \
    for (int d = 0; d < 4; ++d) for (int r = 0; r < 16; ++r) o[d][r] *= al_l[crow(r, hi)]; } } while (0)
  f32x16 pA0, pA1, pB0, pB1; float mnA, mnB, alA, alB; bf16x8 pa0, pa1, pa2, pa3; const int NT = seq / KVBLK;
  constexpr int SE = 0, SO = SDEPTH - 1;
  SLOAD(SE, 0); asm volatile("s_waitcnt vmcnt(0)" ::: "memory"); SWRITE(0, SE); __syncthreads();
  qkt(pA0, pA1, K_lds, qr, r32, hi); partialSM(pA0, pA1, m_reg, mnA, alA);
  SLOAD(SO, KVBLK); if constexpr (SDEPTH == 2) { if (2 < NT) SLOAD(SE, 2 * KVBLK); }
  SWAIT(); SWRITE(1, SO); __syncthreads();
  for (int j = 1; j + 1 < NT; j += 2) {
    SBAR(); qkt(pB0, pB1, (bf16*)((char*)K_lds + SHM_K), qr, r32, hi);
    finishSM(pA0, pA1, alA, l_reg, pa0, pa1, pa2, pa3); SBAR();
    SLOAD(SO, (j + SDEPTH) * KVBLK); SBAR();
    pv_d0(o, vb0, pa0, pa1, pa2, pa3); partialSM(pB0, pB1, m_reg, mnB, alB);
    __syncthreads(); SWAIT(); SWRITE(0, SE);
    RESC(alB); __syncthreads();
    SBAR(); qkt(pA0, pA1, K_lds, qr, r32, hi);
    finishSM(pB0, pB1, alB, l_reg, pa0, pa1, pa2, pa3); SBAR();
    if (SDEPTH == 1 || j + 3 < NT) SLOAD(SE, (j + 1 + SDEPTH) * KVBLK); SBAR();
    pv_d0(o, vb0 + (int)SHM_V, pa0, pa1, pa2, pa3); partialSM(pA0, pA1, m_reg, mnA, alA);
    __syncthreads(); SWAIT(); SWRITE(1, SO);
    RESC(alA); __syncthreads();
  }
  SBAR(); qkt(pB0, pB1, (bf16*)((char*)K_lds + SHM_K), qr, r32, hi);
  finishSM(pA0, pA1, alA, l_reg, pa0, pa1, pa2, pa3); SBAR();
  pv_d0(o, vb0, pa0, pa1, pa2, pa3); partialSM(pB0, pB1, m_reg, mnB, alB);
  __syncthreads(); RESC(alB);
  finishSM(pB0, pB1, alB, l_reg, pa0, pa1, pa2, pa3); SBAR();
  pv_d0(o, vb0 + (int)SHM_V, pa0, pa1, pa2, pa3);
  if (hi == 0) li_l[r32] = l_reg; asm volatile("s_waitcnt lgkmcnt(0)" ::: "memory");
  float rli[16];
#pragma unroll
  for (int r = 0; r < 16; ++r) rli[r] = __builtin_amdgcn_rcpf(li_l[crow(r, hi)]);
  bf16* Ow = Ob + (long)(wid * QBLK) * LDO;
#pragma unroll
  for (int r = 0; r < 16; ++r) { int orow = crow(r, hi);
    for (int d0 = 0; d0 < 4; ++d0) Ow[(long)orow * LDO + d0 * 32 + r32] = __float2bfloat16(o[d0][r] * rli[r]); }
#undef SLOAD
#undef SWRITE
#undef SWAIT
#undef RESC
}

}

constexpr int NWAVES = 8;
#ifndef MK_ONE_LAUNCH
#define MK_ONE_LAUNCH 0
#endif
constexpr int NB = 8, SEQ = 2048, NCTX = 256, LTOK = SEQ + NCTX, DM = 2048;
constexpr int MROWS = NB * LTOK;
constexpr int MLAT = NB * SEQ;
constexpr int NE_SRC = 8224, NP = 8192;
constexpr float EPS = 1e-6f;
constexpr int EC_AQ = 0, EC_AFF = 1024, EC_AFB = 2048, EC_AI = 3072, EC_BQ = 4096, EC_BK = 4608, EC_BV = 5120, EC_GATE = 6144;
constexpr int OC_Q = 0, OC_K = 2048, OC_V = 4096, OC_GATE = 6144;
constexpr float LAM_INIT1 = 0.35550906759f;

constexpr size_t MiB = 1u << 20;
constexpr size_t WS_CTL = 0, CTL_ZERO_BYTES = 1 * MiB;
constexpr size_t WS_MOD = 1 * MiB;
constexpr size_t WS_WZ = 2 * MiB;
constexpr size_t WS_Z = 3 * MiB;
constexpr size_t WS_WOO = 8 * MiB;
constexpr size_t WS_WIE = 16 * MiB;
constexpr size_t WS_WOE = 48 * MiB;
constexpr size_t WS_WIO = 56 * MiB;
constexpr size_t WS_H = 88 * MiB;
constexpr size_t WS_P = 160 * MiB;
constexpr size_t WS_CTX1 = 448 * MiB;
constexpr size_t WS_END = 464 * MiB;
constexpr size_t WS_O0 = 16 * MiB, WS_O1 = 80 * MiB;
static_assert(WS_O1 + (size_t)MLAT * DM * 2 <= WS_P, "attention output overlay");

constexpr int LDS_BYTES = 147456;

#define GAS __attribute__((address_space(1)))
#define LAS __attribute__((address_space(3)))
typedef unsigned short bf16;
typedef unsigned v4u __attribute__((ext_vector_type(4)));
typedef unsigned v2u __attribute__((ext_vector_type(2)));
typedef float f32x4 __attribute__((ext_vector_type(4)));
typedef short bf16x8 __attribute__((ext_vector_type(8)));

__device__ __forceinline__ unsigned f2bf(float f) { unsigned u = __builtin_bit_cast(unsigned, f); return (u + 0x7fffu + ((u >> 16) & 1u)) >> 16; }
__device__ __forceinline__ unsigned pk2(float lo, float hi) { return f2bf(lo) | (f2bf(hi) << 16); }
__device__ __forceinline__ float bf2f(unsigned short v) { return __uint_as_float((unsigned)v << 16); }
__device__ __forceinline__ float bflo(unsigned w) { return __uint_as_float(w << 16); }
__device__ __forceinline__ float bfhi(unsigned w) { return __uint_as_float(w & 0xffff0000u); }
__device__ __forceinline__ void unpack8(const v4u w, float (&x)[8]) { x[0] = bflo(w.x); x[1] = bfhi(w.x); x[2] = bflo(w.y); x[3] = bfhi(w.y); x[4] = bflo(w.z); x[5] = bfhi(w.z); x[6] = bflo(w.w); x[7] = bfhi(w.w); }
__device__ __forceinline__ v4u pack8(const float (&x)[8]) { v4u w; w.x = pk2(x[0], x[1]); w.y = pk2(x[2], x[3]); w.z = pk2(x[4], x[5]); w.w = pk2(x[6], x[7]); return w; }
__device__ __forceinline__ float wave_sum(float v) {
#pragma unroll
    for (int o = 1; o < 64; o <<= 1) v += __shfl_xor(v, o);
    return v;
}
__device__ __forceinline__ float sigmoidf_(float x) { return 1.f / (1.f + __expf(-x)); }
__device__ __forceinline__ float siluf_(float x) { return x / (1.f + __expf(-x)); }
__device__ __forceinline__ float logsigmoidf_(float x) { return fminf(x, 0.f) - log1pf(__expf(-fabsf(x))); }
__device__ __forceinline__ void sincos_(float x, float& s, float& c) {
    const float k = rintf(x * 0.63661977236758134f);
    float r = fmaf(-k, 1.5707962512969971f, x); r = fmaf(-k, 7.5497894158615964e-8f, r);
    const float r2 = r * r;
    float sp = fmaf(r2, 2.7557314297e-6f, -1.9841270114e-4f); sp = fmaf(sp, r2, 8.3333337680e-3f); sp = fmaf(sp, r2, -1.6666667163e-1f); sp = fmaf(sp * r2, r, r);
    float cp = fmaf(r2, 2.4801587642e-5f, -1.3888889225e-3f); cp = fmaf(cp, r2, 4.1666667908e-2f); cp = fmaf(cp, r2, -0.5f); cp = fmaf(cp, r2, 1.0f);
    const int q = (int)k & 3;
    const float ss = (q & 1) ? cp : sp, cc = (q & 1) ? sp : cp;
    s = (q & 2) ? -ss : ss; c = ((q + 1) & 2) ? -cc : cc;
}

struct Args { const float* in[20]; float* out; unsigned char* ws; int ph_lo, ph_hi; };
struct Frame {
    LAS unsigned char* lds;
    int tid, lane, wave, G;
    const float* in[20]; float* out; unsigned char* ws;
};
enum { I_X = 0, I_C, I_CTX, I_CCTX, I_NG, I_WADA, I_BADA, I_LB, I_WINE, I_WA2, I_BA2, I_AG, I_BG, I_WOE, I_WINO, I_QG, I_KG, I_LQK, I_CG, I_WOO };

__device__ __forceinline__ void p0_transpose_item(const float* W, int N, int k0, int n0, bf16* WT, int drow0, LAS float* scr, int lane) {
#pragma unroll 8
    for (int i = 0; i < 32; ++i) { const int kk = 2 * i + (lane >> 5); scr[kk * 33 + (lane & 31)] = W[(size_t)(k0 + kk) * N + n0 + (lane & 31)]; }
    asm volatile("s_waitcnt lgkmcnt(0)" ::: "memory");
    const int c = lane & 7;
#pragma unroll
    for (int j = 0; j < 4; ++j) { const int n = (lane >> 3) + 8 * j; const LAS float* s = scr + (8 * c) * 33 + n;
        v4u o; o.x = pk2(s[0 * 33], s[1 * 33]); o.y = pk2(s[2 * 33], s[3 * 33]); o.z = pk2(s[4 * 33], s[5 * 33]); o.w = pk2(s[6 * 33], s[7 * 33]);
        *(GAS v4u*)(WT + (size_t)(drow0 + n) * 2048 + k0 + 8 * c) = o; }
    asm volatile("s_waitcnt lgkmcnt(0)" ::: "memory");
}
__device__ __forceinline__ void p0_prologue(Frame& F) {
    if (blockIdx.x < 192) {
        const int l = blockIdx.x / 96, n0 = (blockIdx.x % 96) * 64;
        LAS float* sc = (LAS float*)F.lds;
        LAS float* red = (LAS float*)(F.lds + 9 * 2048 * 4);
        for (int i = F.tid; i < 9 * 2048; i += 512) { const int r = i >> 11, k = i & 2047; const float c = (r < 8) ? F.in[I_C][r * 2048 + k] : F.in[I_CCTX][k]; sc[i] = siluf_(c); }
        __syncthreads();
        const float* w = F.in[I_WADA] + (size_t)l * 2048 * 6144 + n0 + F.lane;
        float acc[9];
#pragma unroll
        for (int r = 0; r < 9; ++r) acc[r] = 0.f;
        const int kb = F.wave * 256;
#pragma unroll 2
        for (int k = 0; k < 256; k += 4) {
            float wv[4];
#pragma unroll
            for (int i = 0; i < 4; ++i) wv[i] = w[(size_t)(kb + k + i) * 6144];
#pragma unroll
            for (int r = 0; r < 9; ++r) { const f32x4 s = *(const LAS f32x4*)(sc + r * 2048 + kb + k); acc[r] += s[0] * wv[0] + s[1] * wv[1] + s[2] * wv[2] + s[3] * wv[3]; }
        }
#pragma unroll
        for (int r = 0; r < 9; ++r) red[(F.wave * 9 + r) * 64 + F.lane] = acc[r];
        __syncthreads();
        for (int t = F.tid; t < 576; t += 512) { const int r = t >> 6, c = t & 63; float s = 0.f;
#pragma unroll
            for (int wv = 0; wv < 8; ++wv) s += red[(wv * 9 + r) * 64 + c];
            ((float*)(F.ws + WS_MOD))[(size_t)(l * 9 + r) * 6144 + n0 + c] = s + F.in[I_BADA][l * 6144 + n0 + c]; }
        __syncthreads();
    }
    LAS float* scr = (LAS float*)(F.lds + F.wave * 16384);
    const int gw = blockIdx.x * NWAVES + F.wave, NGW = F.G * NWAVES;
    constexpr int I_E = 32 * 257, I_S = 32 * 64, I_O = 32 * 256;
    for (int it = gw; it < I_E + I_S + I_O + I_S; it += NGW) {
        int r = it;
        if (r < I_E) { const int kb = r / 257, nb = r % 257;
            if (nb < 192) p0_transpose_item(F.in[I_WINE], NE_SRC, 64 * kb, 32 * nb, (bf16*)(F.ws + WS_WIE), 32 * nb, scr, F.lane);
            else if (nb == 192) p0_transpose_item(F.in[I_WINE], NE_SRC, 64 * kb, 32 * nb, (bf16*)(F.ws + WS_WZ), 0, scr, F.lane);
            else p0_transpose_item(F.in[I_WINE], NE_SRC, 64 * kb, 32 * nb, (bf16*)(F.ws + WS_WIE), 32 * nb - 32, scr, F.lane);
            continue; }
        r -= I_E;
        if (r < I_S) { p0_transpose_item(F.in[I_WOE], 2048, 64 * (r / 64), 32 * (r % 64), (bf16*)(F.ws + WS_WOE), 32 * (r % 64), scr, F.lane); continue; }
        r -= I_S;
        if (r < I_O) { p0_transpose_item(F.in[I_WINO], 8192, 64 * (r / 256), 32 * (r % 256), (bf16*)(F.ws + WS_WIO), 32 * (r % 256), scr, F.lane); continue; }
        r -= I_O;
        p0_transpose_item(F.in[I_WOO], 2048, 64 * (r / 64), 32 * (r % 64), (bf16*)(F.ws + WS_WOO), 32 * (r % 64), scr, F.lane);
    }
}

__device__ __forceinline__ void modulate_phase(Frame& F, int l, const float* xsrc, const float* csrc) {
    const int gw = blockIdx.x * NWAVES + F.wave, NGW = F.G * NWAVES;
    const float* gain = F.in[I_NG] + l * 2048;
    bf16* H = (bf16*)(F.ws + WS_H);
    for (int m = gw; m < MROWS; m += NGW) {
        const int b = m / LTOK, t = m - b * LTOK;
        const float* src = (t < NCTX) ? csrc + ((size_t)b * NCTX + t) * DM : xsrc + ((size_t)b * SEQ + (t - NCTX)) * DM;
        const float* mod = (const float*)(F.ws + WS_MOD) + (size_t)(l * 9 + ((t < NCTX) ? 8 : b)) * 6144;
        f32x4 v[8]; float ss = 0.f;
#pragma unroll
        for (int j = 0; j < 8; ++j) { v[j] = *(const f32x4*)(src + (F.lane + 64 * j) * 4); ss += (v[j].x * v[j].x + v[j].y * v[j].y) + (v[j].z * v[j].z + v[j].w * v[j].w); }
        const float rstd = rsqrtf(wave_sum(ss) * (1.f / DM) + EPS);
#pragma unroll
        for (int j = 0; j < 8; ++j) { const int col = (F.lane + 64 * j) * 4;
            const f32x4 g = *(const f32x4*)(gain + col), sh = *(const f32x4*)(mod + col), sl = *(const f32x4*)(mod + 2048 + col);
            const f32x4 y = (v[j] * rstd) * g * (sl + 1.f) + sh;
            v2u o; o.x = pk2(y.x, y.y); o.y = pk2(y.z, y.w);
            *(v2u*)(H + (size_t)m * DM + col) = o; }
    }
}

__device__ __forceinline__ void zgemm_phase(Frame& F) {
    const int gw = blockIdx.x * NWAVES + F.wave, NGW = F.G * NWAVES;
    const bf16* H = (const bf16*)(F.ws + WS_H); const bf16* WZ = (const bf16*)(F.ws + WS_WZ); float* Z = (float*)(F.ws + WS_Z);
    const int fr = F.lane & 15, fq = F.lane >> 4;
    for (int u = gw; u < MROWS / 16; u += NGW) {
        const bf16* ap = H + (size_t)(u * 16 + fr) * DM + 8 * fq; const bf16* b0p = WZ + (size_t)fr * DM + 8 * fq; const bf16* b1p = WZ + (size_t)(16 + fr) * DM + 8 * fq;
        f32x4 a0 = {0.f, 0.f, 0.f, 0.f}, a1 = {0.f, 0.f, 0.f, 0.f};
#pragma unroll 4
        for (int k0 = 0; k0 < DM; k0 += 32) {
            const bf16x8 a = *(const bf16x8*)(ap + k0), b0 = *(const bf16x8*)(b0p + k0), b1 = *(const bf16x8*)(b1p + k0);
            a0 = __builtin_amdgcn_mfma_f32_16x16x32_bf16(a, b0, a0, 0, 0, 0); a1 = __builtin_amdgcn_mfma_f32_16x16x32_bf16(a, b1, a1, 0, 0, 0);
        }
#pragma unroll
        for (int i = 0; i < 4; ++i) { float* zr = Z + (size_t)(u * 16 + fq * 4 + i) * 32; zr[fr] = a0[i]; zr[16 + fr] = a1[i]; }
    }
}

__device__ __forceinline__ void scan_phase_v1(Frame& F, bf16* OF, bf16* OB) {
    const bf16* P = (const bf16*)(F.ws + WS_P); const float* Z = (const float*)(F.ws + WS_Z);
    LAS float* qs = (LAS float*)(F.lds + F.wave * 12800); LAS float* ks = qs + 1024; LAS float* as = qs + 2048; LAS float* vs = qs + 3072;
    const int gw = blockIdx.x * NWAVES + F.wave, NGW = F.G * NWAVES;
    const int c = F.lane & 15, dq = F.lane >> 4;
    const int ps = F.lane >> 4, pd0 = (F.lane & 15) * 8;
    for (int u = gw; u < 2048; u += NGW) {
        const bool isA = u < 1024; const int uu = isA ? u : u - 1024;
        int b, h, dir, slice;
        if (isA) { const int seq = uu >> 3; slice = uu & 7; b = seq >> 4; h = (seq >> 1) & 7; dir = seq & 1; }
        else { const int seq = uu >> 4; slice = uu & 15; b = seq >> 3; h = (seq >> 1) & 3; dir = seq & 1; }
        const int qcol = isA ? EC_AQ + h * 128 : EC_BQ + h * 128;
        const int kcol = isA ? (dir ? EC_AFB : EC_AFF) + h * 128 : EC_BK + h * 128;
        const int vcol = isA ? EC_AI + h * 128 + slice * 16 + c : EC_BV + h * 256 + slice * 16 + c;
        const int ocol = isA ? h * 128 + slice * 16 + c : 1024 + h * 256 + slice * 16 + c;
        bf16* OUT = dir ? OB : OF;
        float lbv[8];
        if (isA) {
#pragma unroll
            for (int e = 0; e < 8; ++e) { const int cc = h * 128 + pd0 + e; const float l0 = F.in[I_LB][cc], l1 = F.in[I_LB][1024 + cc], l2 = F.in[I_LB][2048 + cc];
                const float mx = fmaxf(l0, fmaxf(l1, l2)); const float e0 = __expf(l0 - mx), e1 = __expf(l1 - mx), e2 = __expf(l2 - mx); lbv[e] = e0 / (e0 + e1 + e2); }
        } else {
#pragma unroll
            for (int e = 0; e < 8; ++e) lbv[e] = F.in[I_BA2][dir * 512 + h * 128 + pd0 + e];
        }
        const float* wa2 = F.in[I_WA2] + (size_t)dir * 16 * 512 + h * 128 + pd0;
        float S[32];
#pragma unroll
        for (int i = 0; i < 32; ++i) S[i] = 0.f;
        const size_t rowb = (size_t)b * LTOK;
        for (int ch = 0; ch < LTOK / 8; ++ch) {
            const int i0 = ch * 8;
            int tbase, tstep;
            if (!dir) { tbase = i0; tstep = 1; } else { tbase = (i0 < NCTX) ? (NCTX - 1 - i0) : (LTOK - 1 - (i0 - NCTX)); tstep = -1; }
#pragma unroll
            for (int k2 = 0; k2 < 2; ++k2) { const int idx = F.lane + 64 * k2, s = idx >> 4, cc = idx & 15; vs[idx] = bf2f(P[(rowb + tbase + tstep * s) * NP + vcol - c + cc]); }
#pragma unroll
            for (int half = 0; half < 2; ++half) {
                const int s = ps + 4 * half; const size_t row = rowb + tbase + tstep * s;
                float q8[8], k8[8], a8[8];
                { const v4u w = *(const v4u*)(P + row * NP + qcol + pd0); unpack8(w, q8); }
                { const v4u w = *(const v4u*)(P + row * NP + kcol + pd0); unpack8(w, k8); }
                if (isA) {
#pragma unroll
                    for (int e = 0; e < 8; ++e) { q8[e] = siluf_(q8[e]); const float f = lbv[e] + (1.f - lbv[e]) * sigmoidf_(k8[e]); a8[e] = f; k8[e] = 1.f - f; }
                } else {
                    float ar[8];
#pragma unroll
                    for (int e = 0; e < 8; ++e) ar[e] = lbv[e];
#pragma unroll 2
                    for (int r = 0; r < 16; ++r) { const float zr = Z[row * 32 + dir * 16 + r]; const f32x4 w0 = *(const f32x4*)(wa2 + r * 512), w1 = *(const f32x4*)(wa2 + r * 512 + 4);
                        ar[0] = fmaf(zr, w0[0], ar[0]); ar[1] = fmaf(zr, w0[1], ar[1]); ar[2] = fmaf(zr, w0[2], ar[2]); ar[3] = fmaf(zr, w0[3], ar[3]);
                        ar[4] = fmaf(zr, w1[0], ar[4]); ar[5] = fmaf(zr, w1[1], ar[5]); ar[6] = fmaf(zr, w1[2], ar[6]); ar[7] = fmaf(zr, w1[3], ar[7]); }
#pragma unroll
                    for (int e = 0; e < 8; ++e) { a8[e] = __expf(logsigmoidf_(ar[e]) * (1.f / 16.f)); q8[e] *= 0.088388347648318440f; }
                }
                *(LAS f32x4*)(qs + s * 128 + pd0) = (f32x4){q8[0], q8[1], q8[2], q8[3]}; *(LAS f32x4*)(qs + s * 128 + pd0 + 4) = (f32x4){q8[4], q8[5], q8[6], q8[7]};
                *(LAS f32x4*)(ks + s * 128 + pd0) = (f32x4){k8[0], k8[1], k8[2], k8[3]}; *(LAS f32x4*)(ks + s * 128 + pd0 + 4) = (f32x4){k8[4], k8[5], k8[6], k8[7]};
                *(LAS f32x4*)(as + s * 128 + pd0) = (f32x4){a8[0], a8[1], a8[2], a8[3]}; *(LAS f32x4*)(as + s * 128 + pd0 + 4) = (f32x4){a8[4], a8[5], a8[6], a8[7]};
            }
            asm volatile("s_waitcnt lgkmcnt(0)" ::: "memory");
#pragma unroll 1
            for (int s = 0; s < 8; ++s) {
                float o = 0.f; const float v = vs[s * 16 + c];
#pragma unroll
                for (int i4 = 0; i4 < 8; ++i4) {
                    const f32x4 q4 = *(const LAS f32x4*)(qs + s * 128 + dq * 32 + i4 * 4), k4 = *(const LAS f32x4*)(ks + s * 128 + dq * 32 + i4 * 4), a4 = *(const LAS f32x4*)(as + s * 128 + dq * 32 + i4 * 4);
#pragma unroll
                    for (int e = 0; e < 4; ++e) { const float sn = fmaf(a4[e], S[i4 * 4 + e], k4[e] * v); S[i4 * 4 + e] = sn; o = fmaf(q4[e], sn, o); }
                }
                o += __shfl_xor(o, 16); o += __shfl_xor(o, 32);
                if (dq == 0) OUT[(rowb + tbase + tstep * s) * DM + ocol] = (bf16)f2bf(o);
            }
            asm volatile("s_waitcnt lgkmcnt(0)" ::: "memory");
        }
    }
}

__device__ __forceinline__ void evengate_phase(Frame& F, const bf16* OF) {
    const int gw = blockIdx.x * NWAVES + F.wave, NGW = F.G * NWAVES;
    bf16* Y = (bf16*)(F.ws + WS_H); const bf16* P = (const bf16*)(F.ws + WS_P);
    for (int m = gw; m < MROWS; m += NGW) {
#pragma unroll
        for (int j = 0; j < 4; ++j) {
            const int col = j * 512 + F.lane * 8;
            float a[8], bb[8], g[8];
            unpack8(*(const v4u*)(OF + (size_t)m * DM + col), a); unpack8(*(const v4u*)(Y + (size_t)m * DM + col), bb); unpack8(*(const v4u*)(P + (size_t)m * NP + EC_GATE + col), g);
            float ss = 0.f;
#pragma unroll
            for (int e = 0; e < 8; ++e) { a[e] += bb[e]; ss += a[e] * a[e]; }
            ss += __shfl_xor(ss, 1); ss += __shfl_xor(ss, 2); ss += __shfl_xor(ss, 4); ss += __shfl_xor(ss, 8);
            float rstd; const float* gn;
            if (j < 2) { rstd = rsqrtf(ss * (1.f / 128.f) + EPS); gn = F.in[I_AG] + (col & 127); }
            else { ss += __shfl_xor(ss, 16); rstd = rsqrtf(ss * (1.f / 256.f) + EPS); gn = F.in[I_BG] + (col & 255); }
            float y[8];
#pragma unroll
            for (int e = 0; e < 8; ++e) y[e] = a[e] * rstd * gn[e] * siluf_(g[e]);
            *(v4u*)(Y + (size_t)m * DM + col) = pack8(y);
        }
    }
}

__device__ __forceinline__ void qknorm_rope_phase(Frame& F) {
    const int gw = blockIdx.x * NWAVES + F.wave, NGW = F.G * NWAVES;
    bf16* P = (bf16*)(F.ws + WS_P);
    const int l16 = F.lane & 15;
    float gq[8], gk[8], inv[8];
#pragma unroll
    for (int e = 0; e < 8; ++e) { gq[e] = F.in[I_QG][l16 * 8 + e]; gk[e] = F.in[I_KG][l16 * 8 + e]; inv[e] = exp2f(-(float)((F.lane & 3) * 8 + e) * (13.287712379549449f / 32.f)); }
    for (int m = gw; m < MROWS; m += NGW) {
        const int b = m / LTOK, t = m - b * LTOK; const bool lat = t >= NCTX; const int pos = t - NCTX;
        const float p = (float)((F.lane & 8) ? (pos & 63) : (pos >> 6));
        float cs[8], sn[8];
#pragma unroll
        for (int e = 0; e < 8; ++e) { if (lat) sincos_(p * inv[e], sn[e], cs[e]); else { sn[e] = 0.f; cs[e] = 1.f; } }
#pragma unroll
        for (int sect = 0; sect < 2; ++sect) {
            if (sect == 0 && !lat) continue;
#pragma unroll
            for (int j = 0; j < 4; ++j) {
                bf16* ptr = P + (size_t)m * NP + sect * 2048 + j * 512 + F.lane * 8;
                float x[8]; unpack8(*(const v4u*)ptr, x);
                float ss = 0.f;
#pragma unroll
                for (int e = 0; e < 8; ++e) ss += x[e] * x[e];
                ss += __shfl_xor(ss, 1); ss += __shfl_xor(ss, 2); ss += __shfl_xor(ss, 4); ss += __shfl_xor(ss, 8);
                const float rstd = rsqrtf(ss * (1.f / 128.f) + EPS);
                float y[8];
#pragma unroll
                for (int e = 0; e < 8; ++e) { x[e] = x[e] * rstd * (sect ? gk[e] : gq[e]); }
#pragma unroll
                for (int e = 0; e < 8; ++e) { const float o = __shfl_xor(x[e], 4); y[e] = (F.lane & 4) ? fmaf(o, sn[e], x[e] * cs[e]) : fmaf(-o, sn[e], x[e] * cs[e]); }
                *(v4u*)ptr = pack8(y);
            }
        }
    }
}

__device__ __forceinline__ void diffcombine_phase(Frame& F) {
    const int gw = blockIdx.x * NWAVES + F.wave, NGW = F.G * NWAVES;
    bf16* O0 = (bf16*)(F.ws + WS_O0); const bf16* O1 = (const bf16*)(F.ws + WS_O1); const bf16* P = (const bf16*)(F.ws + WS_P);
    const float* lq = F.in[I_LQK];
    const float d01 = wave_sum(lq[F.lane] * lq[128 + F.lane] + lq[64 + F.lane] * lq[192 + F.lane]);
    const float d23 = wave_sum(lq[256 + F.lane] * lq[384 + F.lane] + lq[320 + F.lane] * lq[448 + F.lane]);
    const float lam = expf(d01) - expf(d23) + LAM_INIT1;
    for (int m = gw; m < MLAT; m += NGW) {
        const int b = m / SEQ, s = m - b * SEQ; const size_t prow = (size_t)b * LTOK + NCTX + s;
#pragma unroll
        for (int j = 0; j < 4; ++j) {
            const int col = j * 512 + F.lane * 8;
            float a[8], bb[8], g[8];
            unpack8(*(const v4u*)(O0 + (size_t)m * DM + col), a); unpack8(*(const v4u*)(O1 + (size_t)m * DM + col), bb); unpack8(*(const v4u*)(P + prow * NP + OC_GATE + col), g);
            float ss = 0.f;
#pragma unroll
            for (int e = 0; e < 8; ++e) { a[e] = fmaf(-lam, bb[e], a[e]); ss += a[e] * a[e]; }
            ss += __shfl_xor(ss, 1); ss += __shfl_xor(ss, 2); ss += __shfl_xor(ss, 4); ss += __shfl_xor(ss, 8); ss += __shfl_xor(ss, 16);
            const float rstd = rsqrtf(ss * (1.f / 256.f) + EPS) * (1.f - LAM_INIT1);
            const float* gn = F.in[I_CG] + (col & 255);
            float y[8];
#pragma unroll
            for (int e = 0; e < 8; ++e) y[e] = a[e] * rstd * gn[e] * siluf_(g[e]);
            *(v4u*)(O0 + (size_t)m * DM + col) = pack8(y);
        }
    }
}

__device__ __forceinline__ void attn_phase_v1(Frame& F, char* lds) {
    const attn::bf16* P = (const attn::bf16*)(F.ws + WS_P);
    for (int u = blockIdx.x; u < 2048; u += F.G) {
        const int qb = u & 7, e = (u >> 3) & 1, mp = (u >> 4) & 1, h = (u >> 5) & 7, b = u >> 8;
        const attn::bf16* Q = P + ((size_t)b * LTOK + NCTX + qb * 256) * NP + OC_Q + h * 256 + mp * 128;
        const attn::bf16* K = P + ((size_t)b * LTOK) * NP + OC_K + h * 256 + mp * 128;
        const attn::bf16* V = P + ((size_t)b * LTOK) * NP + OC_V + h * 256 + e * 128;
        attn::bf16* O = (attn::bf16*)(F.ws + (mp ? WS_O1 : WS_O0)) + ((size_t)b * SEQ + qb * 256) * DM + h * 256 + e * 128;
        attn::attn_dense_body<attn::bf16>(Q, K, V, O, LTOK, lds);
        __syncthreads();
    }
}

__global__ void __launch_bounds__(NWAVES * 64, 2) mega_fwd(Args args) {
    extern __shared__ __attribute__((aligned(16))) unsigned char lds[];
    Frame F;
    F.lds = (LAS unsigned char*)lds;
    F.tid = threadIdx.x; F.lane = F.tid & 63; F.wave = __builtin_amdgcn_readfirstlane(F.tid >> 6); F.G = gridDim.x;
#pragma unroll
    for (int i = 0; i < 20; ++i) F.in[i] = args.in[i];
    F.out = args.out; F.ws = args.ws;
    const int lo = args.ph_lo, hi = args.ph_hi;
#define IN(k) (lo <= (k) && (k) < hi)
#if MK_ONE_LAUNCH
#define SEAM(k) do { if (IN(k) && IN((k) + 1)) { cg::this_grid().sync(); } } while (0)
#else
#define SEAM(k) do { } while (0)
#endif
    unsigned char* ws = args.ws;
    bf16* Hb = (bf16*)(ws + WS_H); bf16* Pb = (bf16*)(ws + WS_P);
    const float* mod0 = (const float*)(ws + WS_MOD); const float* mod1 = mod0 + 9 * 6144;
    float* ctx1 = (float*)(ws + WS_CTX1);

    if (IN(0)) { p0_prologue(F); } SEAM(0);
    if (IN(1)) { modulate_phase(F, 0, F.in[I_X], F.in[I_CTX]); } SEAM(1);
    if (IN(2)) {
        zgemm_phase(F);
        pg8::Gemm g{Hb, (const bf16*)(ws + WS_WIE), MROWS, NP, DM}; pg8::StaticOrder S; S.init(MROWS, NP, F.G, (int)blockIdx.x);
        pg8::EpiStoreBf16 E{Pb, NP};
        pg8::gemm_phase<pg8::EpiStoreBf16, pg8::StaticOrder, true, true>(F.lds, g, S, E);
    } SEAM(2);
    if (IN(3)) { scan_phase_v1(F, (bf16*)F.out, Hb); } SEAM(3);
    if (IN(4)) { evengate_phase(F, (const bf16*)F.out); } SEAM(4);
    if (IN(5)) {
        pg8::Gemm g{Hb, (const bf16*)(ws + WS_WOE), MROWS, DM, DM}; pg8::StaticOrder S; S.init(MROWS, DM, F.G, (int)blockIdx.x);
        pg8::EpiRes E{F.in[I_X], F.out, F.in[I_CTX], ctx1, mod0, 9};
        pg8::gemm_phase<pg8::EpiRes, pg8::StaticOrder, true, true>(F.lds, g, S, E);
    } SEAM(5);
    if (IN(6)) { modulate_phase(F, 1, F.out, ctx1); } SEAM(6);
    if (IN(7)) {
        pg8::Gemm g{Hb, (const bf16*)(ws + WS_WIO), MROWS, NP, DM}; pg8::StaticOrder S; S.init(MROWS, NP, F.G, (int)blockIdx.x);
        pg8::EpiStoreBf16 E{Pb, NP};
        pg8::gemm_phase<pg8::EpiStoreBf16, pg8::StaticOrder, true, true>(F.lds, g, S, E);
    } SEAM(7);
    if (IN(8)) { qknorm_rope_phase(F); } SEAM(8);
    if (IN(9)) { attn_phase_v1(F, (char*)lds); } SEAM(9);
    if (IN(10)) { diffcombine_phase(F); } SEAM(10);
    if (IN(11)) {
        pg8::Gemm g{(const bf16*)(ws + WS_O0), (const bf16*)(ws + WS_WOO), MLAT, DM, DM}; pg8::StaticOrder S; S.init(MLAT, DM, F.G, (int)blockIdx.x);
        pg8::EpiRes E{F.out, F.out, nullptr, nullptr, mod1, 8};
        pg8::gemm_phase<pg8::EpiRes, pg8::StaticOrder, true, true>(F.lds, g, S, E);
    }
#undef IN
#undef SEAM
}
constexpr int N_PHASES = 12;

extern "C" void kernel_launch(void* const* d_in, const int* in_sizes, int n_in, void* d_out, int out_size, void* d_ws, size_t ws_size, hipStream_t stream) {
    static int grid = 0;
    if (grid == 0) {
        if (n_in != 20 || in_sizes[0] != MLAT * DM || out_size != MLAT * DM || ws_size < WS_END) {
            fprintf(stderr, "kernel_launch: unexpected shapes: n_in %d in0 %d out %d ws %zu (need >= %zu)\n", n_in, n_in > 0 ? in_sizes[0] : -1, out_size, ws_size, (size_t)WS_END); grid = -1; return; }
        int dev = 0, cus = 0, per_cu = 0;
        if (hipGetDevice(&dev) != hipSuccess || hipDeviceGetAttribute(&cus, hipDeviceAttributeMultiprocessorCount, dev) != hipSuccess) { grid = -1; return; }
        if (hipFuncSetAttribute((const void*)mega_fwd, hipFuncAttributeMaxDynamicSharedMemorySize, LDS_BYTES) != hipSuccess) { fprintf(stderr, "kernel_launch: hipFuncSetAttribute failed\n"); grid = -1; return; }
        if (hipOccupancyMaxActiveBlocksPerMultiprocessor(&per_cu, (const void*)mega_fwd, NWAVES * 64, LDS_BYTES) != hipSuccess || per_cu < 1) { fprintf(stderr, "kernel_launch: occupancy query says %d blocks per CU\n", per_cu); (void)hipGetLastError(); grid = -1; return; }
        grid = cus;
    }
    if (grid < 0) return;
    Args a{};
    for (int i = 0; i < 20; ++i) a.in[i] = (const float*)d_in[i];
    a.out = (float*)d_out; a.ws = (unsigned char*)d_ws;
#if MK_ONE_LAUNCH
    a.ph_lo = 0; a.ph_hi = N_PHASES;
    void* kargs[] = {&a};
    const hipError_t e = hipLaunchCooperativeKernel((const void*)mega_fwd, dim3(grid), dim3(NWAVES * 64), kargs, LDS_BYTES, stream);
    if (e != hipSuccess) fprintf(stderr, "kernel_launch: cooperative launch failed: %s (grid %d)\n", hipGetErrorString(e), grid);
#else
    for (int p = 0; p < N_PHASES; ++p) {
        a.ph_lo = p; a.ph_hi = p + 1;
        hipLaunchKernelGGL(mega_fwd, dim3(grid), dim3(NWAVES * 64), LDS_BYTES, stream, a);
    }
    const hipError_t le = hipPeekAtLastError();
    if (le != hipSuccess) fprintf(stderr, "kernel_launch: launch failed: %s\n", hipGetErrorName(le));
#endif
}
```

```cpp
#include <hip/hip_runtime.h>
#include <hip/hip_bf16.h>
#include <hip/hip_cooperative_groups.h>
#include <cstdio>
#include <cstdint>
#include <cmath>
namespace cg = cooperative_groups;

namespace pg8 {
#define PG8_LAS __attribute__((address_space(3)))
typedef unsigned short bf16_t;
typedef short bf16x8 __attribute__((ext_vector_type(8)));
typedef float f32x4 __attribute__((ext_vector_type(4)));
typedef unsigned u32x4 __attribute__((ext_vector_type(4)));
constexpr int BM = 256, BK = 64, HALF = 128, HTB = HALF * BK * 2  , STAGE_BYTES = 8 * HTB, NXCD = 8, WGM = 8;

__host__ __device__ __forceinline__ int lds_byte(int r, int c) { const int st = (r >> 4) * 2 + (c >> 5), rr = r & 15, cc = c & 31, ob = rr * 64 + cc * 2; return st * 1024 + (ob ^ (((ob >> 9) & 1) << 5)); }
__host__ __device__ __forceinline__ void stage_rc(int b, int& R, int& C) { const int st = b / 1024, sb = b % 1024, swz = sb ^ (((sb >> 9) & 1) << 5); R = (st >> 1) * 16 + swz / 64; C = (st & 1) * 32 + (swz % 64) / 2; }
__host__ __device__ __forceinline__ int perm32(int rho) { const int n = rho >> 4, i = rho & 15; return 8 * (i >> 2) + 4 * n + (i & 3); }

struct Unit { int pm, pn; };
struct Gemm { const bf16_t* A; const bf16_t* Bt; int M, N, K; };

struct StaticOrder {
    int nM, nN, nwg, G, c;
    __host__ __device__ void init(int M, int N, int G_, int c_) { nM = M / BM; nN = N / BM; nwg = nM * nN; G = G_; c = c_; }
    __host__ __device__ bool next(int i, Unit& u) const {
        const long L = (long)i * G + c; if (L >= nwg) return false;
        int wgid = (int)L; { const int q = nwg / NXCD, r = nwg % NXCD, xcd = wgid % NXCD, off = wgid / NXCD; wgid = (xcd < r ? xcd * (q + 1) : r * (q + 1) + (xcd - r) * q) + off; }
        const int nig = WGM * nN, gid = wgid / nig, fm = gid * WGM, gsz = (nM - fm) < WGM ? (nM - fm) : WGM;
        u.pm = fm + ((wgid % nig) % gsz); u.pn = (wgid % nig) / gsz; return true;
    }
    __device__ __forceinline__ void a_ready(const Unit&) const {}
    __device__ __forceinline__ void done(const Unit&) const {}
};

__device__ __forceinline__ unsigned cvt_pk_bf16(float lo, float hi) { unsigned r; asm volatile("v_cvt_pk_bf16_f32 %0, %1, %2" : "=v"(r) : "v"(lo), "v"(hi)); return r; }
struct EpiStoreBf16 {
    static constexpr bool PERM = true, AFTER_DRAIN = false;
    bf16_t* O; int ldc;
    __device__ __forceinline__ void operator()(const f32x4 (&acc)[2][2][4][2], const Unit& u, int wr, int wc, int fr, int fq) const {
        const int row0 = u.pm * BM + wr * 64 + fr; const int col0 = u.pn * BM + wc * 32 + 8 * fq;
#pragma unroll
        for (int ai = 0; ai < 2; ++ai)
#pragma unroll
            for (int m = 0; m < 4; ++m) { bf16_t* rowp = O + (size_t)(row0 + ai * HALF + m * 16) * ldc + col0;
#pragma unroll
                for (int bj = 0; bj < 2; ++bj) { const f32x4 v0 = acc[ai][bj][m][0], v1 = acc[ai][bj][m][1];
                    u32x4 w; w.x = cvt_pk_bf16(v0[0], v0[1]); w.y = cvt_pk_bf16(v0[2], v0[3]); w.z = cvt_pk_bf16(v1[0], v1[1]); w.w = cvt_pk_bf16(v1[2], v1[3]);
                    *(u32x4*)(rowp + bj * HALF) = w; } }
    }
};
struct EpiRes {
    static constexpr bool PERM = false, AFTER_DRAIN = false;
    const float* xsrc; float* xdst; const float* csrc; float* cdst; const float* mod; int tpb;
    __device__ __forceinline__ void operator()(const f32x4 (&acc)[2][2][4][2], const Unit& u, int wr, int wc, int fr, int fq) const {
        const int b = u.pm / tpb, j = u.pm - b * tpb;
        const float* src; float* dst; const float* g;
        if (tpb == 9 && j == 0) { const size_t off = (size_t)b * 256 * 2048; src = csrc + off; dst = cdst + off; g = mod + 8 * 6144 + 4096; }
        else { const int jj = (tpb == 9) ? j - 1 : j; const size_t off = ((size_t)b * 2048 + (size_t)jj * 256) * 2048; src = xsrc + off; dst = xdst + off; g = mod + b * 6144 + 4096; }
        const int r0 = wr * 64 + fr, col0 = u.pn * BM + wc * 32 + 4 * fq;
        f32x4 gv[2][2];
#pragma unroll
        for (int bj = 0; bj < 2; ++bj)
#pragma unroll
            for (int n = 0; n < 2; ++n) gv[bj][n] = *(const f32x4*)(g + col0 + bj * HALF + n * 16);
#pragma unroll
        for (int ai = 0; ai < 2; ++ai)
#pragma unroll
            for (int m = 0; m < 4; ++m) { const size_t roff = (size_t)(r0 + ai * HALF + m * 16) * 2048 + col0;
#pragma unroll
                for (int bj = 0; bj < 2; ++bj)
#pragma unroll
                    for (int n = 0; n < 2; ++n) { const f32x4 s = *(const f32x4*)(src + roff + bj * HALF + n * 16); *(f32x4*)(dst + roff + bj * HALF + n * 16) = s + gv[bj][n] * acc[ai][bj][m][n]; }
                asm volatile("" ::: "memory"); }
    }
};

template <class Epi, class Sched, bool ALIGN_EPI = false, bool SP2 = false>
__device__ __forceinline__ void gemm_phase(PG8_LAS unsigned char* lds, const Gemm g, const Sched& S, const Epi& E) {
    const int tid = threadIdx.x, wid = __builtin_amdgcn_readfirstlane(tid >> 6), lane = tid & 63, wr = wid >> 2, wc = wid & 3, fr = lane & 15, fq = lane >> 4;
    const int K = g.K, nt = K / BK;
    unsigned voffA[2], voffB[2];
#pragma unroll
    for (int i = 0; i < 2; ++i) { int R, C; stage_rc(tid * 16 + i * 8192, R, C); const int Rb = Epi::PERM ? ((R & ~31) + perm32(R & 31)) : R;
        voffA[i] = (unsigned)(R * K + C) * 2u; voffB[i] = (unsigned)(Rb * K + C) * 2u; }
    const size_t kstep = (size_t)(BK * 2);
    const size_t hstep = (size_t)HALF * K * 2;
    const size_t tstep = 2 * hstep;
    const unsigned ldsw = (unsigned)wid * 1024u;
    const int aoff = lds_byte(wr * 64 + fr, fq * 8), boff = lds_byte(wc * 32 + fr, fq * 8);
#define PG8_SA(b, h) (((b) * 2 + (h)) * HTB)
#define PG8_SB(b, h) ((4 + (b) * 2 + (h)) * HTB)
#define PG8_STAGE(bufoff, gbase, voff) do { _Pragma("unroll") for (int _i = 0; _i < 2; ++_i) \
        __builtin_amdgcn_global_load_lds((const unsigned*)((const char*)(gbase) + (voff)[_i]), (PG8_LAS unsigned*)(lds + (bufoff) + ldsw + _i * 8192), 16, 0, 0); } while (0)
#define PG8_LDA(dst, b, h) do { _Pragma("unroll") for (int m = 0; m < 4; ++m) _Pragma("unroll") for (int k = 0; k < 2; ++k) dst[m][k] = *(const PG8_LAS bf16x8*)(lds + PG8_SA(b, h) + aoff + m * 2048 + k * 1024); } while (0)
#define PG8_LDB(dst, b, h) do { _Pragma("unroll") for (int n = 0; n < 2; ++n) _Pragma("unroll") for (int k = 0; k < 2; ++k) dst[n][k] = *(const PG8_LAS bf16x8*)(lds + PG8_SB(b, h) + boff + n * 2048 + k * 1024); } while (0)
#define PG8_MMA(ai, bj, At, Bt) do { __builtin_amdgcn_s_setprio(1); _Pragma("unroll") for (int m = 0; m < 4; ++m) _Pragma("unroll") for (int n = 0; n < 2; ++n) _Pragma("unroll") for (int k = 0; k < 2; ++k) \
        acc[ai][bj][m][n] = __builtin_amdgcn_mfma_f32_16x16x32_bf16(Bt[n][k], At[m][k], acc[ai][bj][m][n], 0, 0, 0); __builtin_amdgcn_s_setprio(0); } while (0)
#define PG8_WAIT_V(n) asm volatile("s_waitcnt vmcnt(" #n ")" ::: "memory")
#define PG8_WAIT_L(n) asm volatile("s_waitcnt lgkmcnt(" #n ")" ::: "memory")
#define PG8_BAR __builtin_amdgcn_s_barrier()
#define PG8_SCHED __builtin_amdgcn_sched_barrier(0)
    Unit cur, nxt; int ui = 0;
    if (!S.next(0, cur)) return;
    f32x4 acc[2][2][4][2];
#pragma unroll
    for (int a = 0; a < 2; ++a)
#pragma unroll
        for (int b = 0; b < 2; ++b)
#pragma unroll
            for (int m = 0; m < 4; ++m)
#pragma unroll
                for (int n = 0; n < 2; ++n) acc[a][b][m][n] = (f32x4){0.f, 0.f, 0.f, 0.f};
    bf16x8 At[4][2], B0[2][2], B1[2][2];
    const char* cA = (const char*)g.A + (size_t)cur.pm * tstep; const char* cB = (const char*)g.Bt + (size_t)cur.pn * tstep;
    S.a_ready(cur);
    if constexpr (SP2) {
        PG8_STAGE(PG8_SB(0, 0), cB, voffB); PG8_STAGE(PG8_SB(0, 1), cB + hstep, voffB); PG8_STAGE(PG8_SA(0, 0), cA, voffA); PG8_STAGE(PG8_SA(0, 1), cA + hstep, voffA);
        if (wr == 1) PG8_BAR;
        PG8_WAIT_V(2); PG8_BAR;
        PG8_STAGE(PG8_SB(1, 0), cB + kstep, voffB); PG8_STAGE(PG8_SA(1, 0), cA + kstep, voffA); PG8_STAGE(PG8_SB(1, 1), cB + hstep + kstep, voffB);
        PG8_WAIT_V(6); PG8_BAR;
    } else {
        PG8_STAGE(PG8_SB(0, 0), cB, voffB); PG8_STAGE(PG8_SA(0, 0), cA, voffA); PG8_STAGE(PG8_SB(0, 1), cB + hstep, voffB); PG8_STAGE(PG8_SA(0, 1), cA + hstep, voffA);
        if (wr == 1) PG8_BAR;
        PG8_WAIT_V(4); PG8_BAR;
        PG8_STAGE(PG8_SB(1, 0), cB + kstep, voffB); PG8_STAGE(PG8_SA(1, 0), cA + kstep, voffA); PG8_STAGE(PG8_SB(1, 1), cB + hstep + kstep, voffB);
        PG8_WAIT_V(6); PG8_BAR;
    }
    for (;;) {
        const bool has_next = S.next(ui + 1, nxt);
        const char* nA = has_next ? (const char*)g.A + (size_t)nxt.pm * tstep : cA; const char* nB = has_next ? (const char*)g.Bt + (size_t)nxt.pn * tstep : cB;
        for (int t = 0; t < nt; t += 2) {
            const bool last = (t == nt - 2);
            const char* a1 = cA + (size_t)(t + 1) * kstep;
            const char* a2 = last ? nA : cA + (size_t)(t + 2) * kstep; const char* b2 = last ? nB : cB + (size_t)(t + 2) * kstep;
            const char* a3 = a2 + kstep; const char* b3 = b2 + kstep;
            if (last && has_next) S.a_ready(nxt);
            if constexpr (SP2) {
            PG8_LDB(B0, 0, 0); PG8_LDB(B1, 0, 1); PG8_SCHED; PG8_LDA(At, 0, 0); PG8_STAGE(PG8_SA(1, 1), a1 + hstep, voffA);
            PG8_WAIT_V(8); PG8_WAIT_L(0); PG8_BAR; PG8_MMA(0, 0, At, B0); PG8_MMA(0, 1, At, B1); PG8_BAR; PG8_SCHED;
            PG8_LDA(At, 0, 1); PG8_STAGE(PG8_SB(0, 0), b2, voffB); PG8_STAGE(PG8_SB(0, 1), b2 + hstep, voffB); PG8_STAGE(PG8_SA(0, 0), a2, voffA);
            PG8_WAIT_V(8); PG8_WAIT_L(0); PG8_BAR; PG8_MMA(1, 0, At, B0); PG8_MMA(1, 1, At, B1); PG8_BAR; PG8_SCHED;
            PG8_LDB(B0, 1, 0); PG8_LDB(B1, 1, 1); PG8_SCHED; PG8_LDA(At, 1, 0); PG8_STAGE(PG8_SA(0, 1), a2 + hstep, voffA);
            PG8_WAIT_V(8); PG8_WAIT_L(0); PG8_BAR; PG8_MMA(0, 0, At, B0); PG8_MMA(0, 1, At, B1); PG8_BAR; PG8_SCHED;
            PG8_LDA(At, 1, 1); PG8_STAGE(PG8_SB(1, 0), b3, voffB); PG8_STAGE(PG8_SB(1, 1), b3 + hstep, voffB); PG8_STAGE(PG8_SA(1, 0), a3, voffA);
            PG8_WAIT_V(8); PG8_WAIT_L(0); PG8_BAR; PG8_MMA(1, 0, At, B0); PG8_MMA(1, 1, At, B1); PG8_BAR; PG8_SCHED;
            } else {
            PG8_LDB(B0, 0, 0); PG8_SCHED; PG8_LDA(At, 0, 0); PG8_STAGE(PG8_SA(1, 1), a1 + hstep, voffA);
            PG8_WAIT_L(8); PG8_BAR; PG8_WAIT_L(0); PG8_MMA(0, 0, At, B0); PG8_BAR; PG8_SCHED;
            PG8_LDB(B1, 0, 1); PG8_STAGE(PG8_SB(0, 0), b2, voffB);
            PG8_BAR; PG8_WAIT_L(0); PG8_MMA(0, 1, At, B1); PG8_BAR;
            PG8_LDA(At, 0, 1); PG8_STAGE(PG8_SA(0, 0), a2, voffA);
            PG8_BAR; PG8_WAIT_L(0); PG8_MMA(1, 0, At, B0); PG8_BAR; PG8_SCHED;
            PG8_STAGE(PG8_SB(0, 1), b2 + hstep, voffB);
            PG8_WAIT_V(6); PG8_BAR; PG8_MMA(1, 1, At, B1); PG8_BAR;
            PG8_LDB(B0, 1, 0); PG8_SCHED; PG8_LDA(At, 1, 0); PG8_STAGE(PG8_SA(0, 1), a2 + hstep, voffA);
            PG8_WAIT_L(8); PG8_BAR; PG8_WAIT_L(0); PG8_MMA(0, 0, At, B0); PG8_BAR; PG8_SCHED;
            PG8_LDB(B1, 1, 1); PG8_STAGE(PG8_SB(1, 0), b3, voffB);
            PG8_BAR; PG8_WAIT_L(0); PG8_MMA(0, 1, At, B1); PG8_BAR;
            PG8_LDA(At, 1, 1); PG8_STAGE(PG8_SA(1, 0), a3, voffA);
            PG8_BAR; PG8_WAIT_L(0); PG8_MMA(1, 0, At, B0); PG8_BAR; PG8_SCHED;
            PG8_STAGE(PG8_SB(1, 1), b3 + hstep, voffB);
            PG8_WAIT_V(6); PG8_BAR; PG8_MMA(1, 1, At, B1); PG8_BAR;
            }
        }
        if constexpr (ALIGN_EPI) { if (wr == 0) PG8_BAR; }
        if constexpr (!Epi::AFTER_DRAIN) { E(acc, cur, wr, wc, fr, fq); S.done(cur); }
        if (!has_next) break;
#pragma unroll
        for (int a = 0; a < 2; ++a)
#pragma unroll
            for (int b = 0; b < 2; ++b)
#pragma unroll
                for (int m = 0; m < 4; ++m)
#pragma unroll
                    for (int n = 0; n < 2; ++n) acc[a][b][m][n] = (f32x4){0.f, 0.f, 0.f, 0.f};
        cur = nxt; cA = nA; cB = nB; ++ui;
        if constexpr (ALIGN_EPI) { if (wr == 1) PG8_BAR; }
    }
    PG8_WAIT_V(0);
    if constexpr (!ALIGN_EPI) { if (wr == 0) PG8_BAR; }
    PG8_BAR;
    if constexpr (Epi::AFTER_DRAIN) { E.fused(acc, cur, wr, wc, fr, fq, lds, wid, lane); S.done(cur); }
#undef PG8_SA
#undef PG8_SB
#undef PG8_STAGE
#undef PG8_LDA
#undef PG8_LDB
#undef PG8_MMA
#undef PG8_WAIT_V
#undef PG8_WAIT_L
#undef PG8_BAR
#undef PG8_SCHED
}
}
namespace attn {
using bf16 = __hip_bfloat16;
constexpr int   D = 128, NW = 8, QBLK = 32, KVBLK = 64;
constexpr float SCALE = 0.088388347648318440f;
constexpr float THR = 8.f;
#ifndef ATT_SDEPTH
#define ATT_SDEPTH 1
#endif
constexpr int SDEPTH = ATT_SDEPTH;
constexpr int LDQ = 8192, LDK = 8192, LDO = 2048;
constexpr size_t SHM_V = KVBLK * D * 2, SHM_K = KVBLK * D * 2, SHM_ATTN = 2 * SHM_V + 2 * SHM_K + NW * 64 * 4;
using bf16x8 = __attribute__((ext_vector_type(8))) short;
using s16x4  = __attribute__((ext_vector_type(4))) short;
using f32x16 = __attribute__((ext_vector_type(16))) float;
using f32x8  = __attribute__((ext_vector_type(8))) float;
using u32x4  = __attribute__((ext_vector_type(4))) unsigned;
#define KSWZ(row, colB) ((row) * 256 + ((colB) ^ (((row) & 7) << 4)))
#define SBAR() __builtin_amdgcn_sched_barrier(0)
__device__ __forceinline__ int crow(int r, int hi) { return (r & 3) + 8 * (r >> 2) + 4 * hi; }
__device__ __forceinline__ unsigned cvtpk(float lo, float hi) {
  unsigned r; asm volatile("v_cvt_pk_bf16_f32 %0, %1, %2" : "=v"(r) : "v"(lo), "v"(hi)); return r;
}
template <typename TIn> struct Stage;
template <> struct Stage<bf16>  { using T = bf16x8;
  __device__ static __forceinline__ T ld8(const bf16* p) { return *reinterpret_cast<const bf16x8*>(p); }
  __device__ static __forceinline__ bf16x8 tobf(T x) { return x; } };
template <> struct Stage<float> { using T = f32x8;
  __device__ static __forceinline__ T ld8(const float* p) { return *reinterpret_cast<const f32x8*>(p); }
  __device__ static __forceinline__ bf16x8 tobf(T x) {
    u32x4 w = {cvtpk(x[0], x[1]), cvtpk(x[2], x[3]), cvtpk(x[4], x[5]), cvtpk(x[6], x[7])}; return *reinterpret_cast<bf16x8*>(&w); } };

__device__ __forceinline__ void partialSM(f32x16& p0, f32x16& p1, float& m_reg, float& mn, float& alpha) {
  constexpr float C = SCALE * 1.4426950408889634f;
  float pmax = p0[0]; for (int r = 1; r < 16; ++r) pmax = fmaxf(pmax, p0[r]); for (int r = 0; r < 16; ++r) pmax = fmaxf(pmax, p1[r]);
  { auto rr = __builtin_amdgcn_permlane32_swap(__float_as_uint(pmax), __float_as_uint(pmax), false, false);
    pmax = fmaxf(__uint_as_float(rr[0]), __uint_as_float(rr[1])); }
  if (__builtin_expect(__all(pmax - m_reg <= THR / SCALE), 1)) { mn = m_reg; alpha = 1.f; }
  else { mn = fmaxf(m_reg, pmax); alpha = __builtin_amdgcn_exp2f((m_reg - mn) * C); m_reg = mn; }
  float mnC = -mn * C;
  for (int r = 0; r < 16; ++r) p0[r] = fmaf(p0[r], C, mnC); for (int r = 0; r < 16; ++r) p1[r] = fmaf(p1[r], C, mnC);
  for (int r = 0; r < 16; ++r) p0[r] = __builtin_amdgcn_exp2f(p0[r]);
}
__device__ __forceinline__ void finishSM(f32x16& p0, f32x16& p1, float alpha, float& l_reg, bf16x8& pa0, bf16x8& pa1, bf16x8& pa2, bf16x8& pa3) {
  for (int r = 0; r < 16; ++r) p1[r] = __builtin_amdgcn_exp2f(p1[r]);
  float ps = 0; for (int r = 0; r < 16; ++r) ps += p0[r]; for (int r = 0; r < 16; ++r) ps += p1[r];
  { auto rr = __builtin_amdgcn_permlane32_swap(__float_as_uint(ps), __float_as_uint(ps), false, false);
    ps = __uint_as_float(rr[0]) + __uint_as_float(rr[1]); }
  l_reg = l_reg * alpha + ps;
#define PK4(P, BASE, OUT) do { unsigned a0 = cvtpk(P[BASE + 0], P[BASE + 1]), a1 = cvtpk(P[BASE + 2], P[BASE + 3]);   \
    unsigned b0 = cvtpk(P[BASE + 4], P[BASE + 5]), b1 = cvtpk(P[BASE + 6], P[BASE + 7]);                              \
    auto r0 = __builtin_amdgcn_permlane32_swap(a0, b0, false, false); auto r1 = __builtin_amdgcn_permlane32_swap(a1, b1, false, false); \
    u32x4 w = {r0[0], r1[0], r0[1], r1[1]}; OUT = *reinterpret_cast<bf16x8*>(&w); } while (0)
  PK4(p0, 0, pa0); PK4(p0, 8, pa1); PK4(p1, 0, pa2); PK4(p1, 8, pa3);
#undef PK4
}
__device__ __forceinline__ void qkt(f32x16& p0, f32x16& p1, const bf16* Ks, const bf16x8* qr, int r32, int hi) {
  p0 = f32x16{}; p1 = f32x16{};
  for (int d0 = 0; d0 < 8; ++d0) { int cb = (d0 * 16 + hi * 8) * 2;
    bf16x8 b0 = *reinterpret_cast<const bf16x8*>((const char*)Ks + KSWZ(r32, cb));
    bf16x8 b1 = *reinterpret_cast<const bf16x8*>((const char*)Ks + KSWZ(32 + r32, cb));
    p0 = __builtin_amdgcn_mfma_f32_32x32x16_bf16(b0, qr[d0], p0, 0, 0, 0);
    p1 = __builtin_amdgcn_mfma_f32_32x32x16_bf16(b1, qr[d0], p1, 0, 0, 0); }
}
__device__ __forceinline__ int v_st(int k, int c) { const int kk = (k & ~0xC) | ((k & 4) << 1) | ((k & 8) >> 1); return ((kk >> 3) * 4 + (c >> 5)) * 512 + ((kk & 7) * 32 + (c & 31)) * 2; }
__device__ __forceinline__ int v_rd_base(int lane) { return ((lane & 3) << 3) | (((lane >> 2) & 3) << 6) | (((lane >> 4) & 1) << 5) | (((lane >> 5) & 1) << 8); }
constexpr int v_rd_off(int d0, int ks, int half) { return d0 * 512 + ks * 4096 + half * 2048; }
template <int OFF> __device__ __forceinline__ s16x4 tr_read(int vb) {
  s16x4 r; asm volatile("ds_read_b64_tr_b16 %0, %1 offset:%2" : "=&v"(r) : "v"(vb), "i"(OFF) : "memory"); return r;
}
template <int D0> __device__ __forceinline__ void pv_one(f32x16& od, int vb, bf16x8 pa0, bf16x8 pa1, bf16x8 pa2, bf16x8 pa3) {
  const s16x4 l0 = tr_read<v_rd_off(D0, 0, 0)>(vb), h0 = tr_read<v_rd_off(D0, 0, 1)>(vb), l1 = tr_read<v_rd_off(D0, 1, 0)>(vb), h1 = tr_read<v_rd_off(D0, 1, 1)>(vb);
  const s16x4 l2 = tr_read<v_rd_off(D0, 2, 0)>(vb), h2 = tr_read<v_rd_off(D0, 2, 1)>(vb), l3 = tr_read<v_rd_off(D0, 3, 0)>(vb), h3 = tr_read<v_rd_off(D0, 3, 1)>(vb);
  asm volatile("s_waitcnt lgkmcnt(0)" ::: "memory"); SBAR();
#define PK(L, H) (bf16x8){L[0], L[1], L[2], L[3], H[0], H[1], H[2], H[3]}
  od = __builtin_amdgcn_mfma_f32_32x32x16_bf16(pa0, PK(l0, h0), od, 0, 0, 0);
  od = __builtin_amdgcn_mfma_f32_32x32x16_bf16(pa1, PK(l1, h1), od, 0, 0, 0);
  od = __builtin_amdgcn_mfma_f32_32x32x16_bf16(pa2, PK(l2, h2), od, 0, 0, 0);
  od = __builtin_amdgcn_mfma_f32_32x32x16_bf16(pa3, PK(l3, h3), od, 0, 0, 0);
#undef PK
}
__device__ __forceinline__ void pv_d0(f32x16* o, int vb, bf16x8 pa0, bf16x8 pa1, bf16x8 pa2, bf16x8 pa3) {
  pv_one<0>(o[0], vb, pa0, pa1, pa2, pa3); pv_one<1>(o[1], vb, pa0, pa1, pa2, pa3); pv_one<2>(o[2], vb, pa0, pa1, pa2, pa3); pv_one<3>(o[3], vb, pa0, pa1, pa2, pa3);
}

template <typename TQ>
__device__ __forceinline__ void attn_dense_body(const TQ* __restrict__ Qb, const bf16* __restrict__ Kh, const bf16* __restrict__ Vh,
                                                bf16* __restrict__ Ob, int seq, char* lds) {
  using St = Stage<bf16>; using SQ = Stage<TQ>;
  const int tid = threadIdx.x, wid = tid >> 6, lane = tid & 63, r32 = lane & 31, hi = lane >> 5;
  bf16* V_lds = (bf16*)lds; bf16* K_lds = (bf16*)(lds + 2 * SHM_V);
  float* ws = (float*)(lds + 2 * SHM_V + 2 * SHM_K) + wid * 64; float* li_l = ws; float* al_l = ws + 32;
  float m_reg = -1e30f, l_reg = 0; f32x16 o[4] = {}; bf16x8 qr[8];
  const TQ* Qw = Qb + (long)(wid * QBLK + r32) * LDQ + hi * 8;
#pragma unroll
  for (int d0 = 0; d0 < 8; ++d0) qr[d0] = SQ::tobf(SQ::ld8(Qw + d0 * 16));
  const int sr = tid >> 4, sc = (tid & 15) * 8, vst0 = v_st(sr, sc), vst1 = v_st(32 + sr, sc);
  const int vb0 = (int)(uintptr_t)V_lds + v_rd_base(lane);
  struct { typename St::T vs0, vs1, ks0, ks1; } sr_[SDEPTH];
  const unsigned so0 = (unsigned)(sr * LDK + sc) * 2u, so1 = (unsigned)((32 + sr) * LDK + sc) * 2u;
#define SLOAD(i, k0) do { const char* vt_ = (const char*)Vh + (size_t)(k0) * (LDK * 2); const char* kt_ = (const char*)Kh + (size_t)(k0) * (LDK * 2); \
    sr_[i].vs0 = *(const bf16x8*)(vt_ + so0); sr_[i].vs1 = *(const bf16x8*)(vt_ + so1); \
    sr_[i].ks0 = *(const bf16x8*)(kt_ + so0); sr_[i].ks1 = *(const bf16x8*)(kt_ + so1); } while (0)
#define SWRITE(b, i) do { *(bf16x8*)((char*)V_lds + (b) * SHM_V + vst0) = St::tobf(sr_[i].vs0);          \
    *(bf16x8*)((char*)V_lds + (b) * SHM_V + vst1) = St::tobf(sr_[i].vs1); int kc = sc * 2;               \
    *(bf16x8*)((char*)K_lds + (b) * SHM_K + KSWZ(sr, kc)) = St::tobf(sr_[i].ks0);                       \
    *(bf16x8*)((char*)K_lds + (b) * SHM_K + KSWZ(32 + sr, kc)) = St::tobf(sr_[i].ks1); } while (0)
#define SWAIT() do { if constexpr (SDEPTH == 2) asm volatile("s_waitcnt vmcnt(4)" ::: "memory"); else asm volatile("s_waitcnt vmcnt(0)" ::: "memory"); } while (0)
#define RESC(a) do { if (__any((a) < 1.f)) { if (hi == 0) al_l[r32] = (a); asm volatile("s_waitcnt lgkmcnt(0)" ::: "memory"); \
    for (int d = 0; d < 4; ++d) for (int r = 0; r < 16; ++r) o[d][r] *= al_l[crow(r, hi)]; } } while (0)
  f32x16 pA0, pA1, pB0, pB1; float mnA, mnB, alA, alB; bf16x8 pa0, pa1, pa2, pa3; const int NT = seq / KVBLK;
  constexpr int SE = 0, SO = SDEPTH - 1;
  SLOAD(SE, 0); asm volatile("s_waitcnt vmcnt(0)" ::: "memory"); SWRITE(0, SE); __syncthreads();
  qkt(pA0, pA1, K_lds, qr, r32, hi); partialSM(pA0, pA1, m_reg, mnA, alA);
  SLOAD(SO, KVBLK); if constexpr (SDEPTH == 2) { if (2 < NT) SLOAD(SE, 2 * KVBLK); }
  SWAIT(); SWRITE(1, SO); __syncthreads();
  for (int j = 1; j + 1 < NT; j += 2) {
    SBAR(); qkt(pB0, pB1, (bf16*)((char*)K_lds + SHM_K), qr, r32, hi);
    finishSM(pA0, pA1, alA, l_reg, pa0, pa1, pa2, pa3); SBAR();
    SLOAD(SO, (j + SDEPTH) * KVBLK); SBAR();
    pv_d0(o, vb0, pa0, pa1, pa2, pa3); partialSM(pB0, pB1, m_reg, mnB, alB);
    __syncthreads(); SWAIT(); SWRITE(0, SE);
    RESC(alB); __syncthreads();
    SBAR(); qkt(pA0, pA1, K_lds, qr, r32, hi);
    finishSM(pB0, pB1, alB, l_reg, pa0, pa1, pa2, pa3); SBAR();
    if (SDEPTH == 1 || j + 3 < NT) SLOAD(SE, (j + 1 + SDEPTH) * KVBLK); SBAR();
    pv_d0(o, vb0 + (int)SHM_V, pa0, pa1, pa2, pa3); partialSM(pA0, pA1, m_reg, mnA, alA);
    __syncthreads(); SWAIT(); SWRITE(1, SO);
    RESC(alA); __syncthreads();
  }
  SBAR(); qkt(pB0, pB1, (bf16*)((char*)K_lds + SHM_K), qr, r32, hi);
  finishSM(pA0, pA1, alA, l_reg, pa0, pa1, pa2, pa3); SBAR();
  pv_d0(o, vb0, pa0, pa1, pa2, pa3); partialSM(pB0, pB1, m_reg, mnB, alB);
  __syncthreads(); RESC(alB);
  finishSM(pB0, pB1, alB, l_reg, pa0, pa1, pa2, pa3); SBAR();
  pv_d0(o, vb0 + (int)SHM_V, pa0, pa1, pa2, pa3);
  if (hi == 0) li_l[r32] = l_reg; asm volatile("s_waitcnt lgkmcnt(0)" ::: "memory");
  float rli[16];
#pragma unroll
  for (int r = 0; r < 16; ++r) rli[r] = __builtin_amdgcn_rcpf(li_l[crow(r, hi)]);
  bf16* Ow = Ob + (long)(wid * QBLK) * LDO;
  const unsigned ob = (unsigned)(4 * hi * LDO + r32) * 2u;
#pragma unroll
  for (int r = 0; r < 16; ++r) {
    for (int d0 = 0; d0 < 4; ++d0) *(bf16*)((char*)Ow + ob + (unsigned)(((r & 3) + 8 * (r >> 2)) * LDO + d0 * 32) * 2u) = __float2bfloat16(o[d0][r] * rli[r]); }
#undef SLOAD
#undef SWRITE
#undef SWAIT
#undef RESC
}

}

constexpr int NWAVES = 8;
#ifndef MK_ONE_LAUNCH
#define MK_ONE_LAUNCH 1
#endif
constexpr int NB = 8, SEQ = 2048, NCTX = 256, LTOK = SEQ + NCTX, DM = 2048;
constexpr int MROWS = NB * LTOK;
constexpr int MLAT = NB * SEQ;
constexpr int NE_SRC = 8224, NP = 8192;
constexpr float EPS = 1e-6f;
constexpr int EC_AQ = 0, EC_AFF = 1024, EC_AFB = 2048, EC_AI = 3072, EC_BQ = 4096, EC_BK = 4608, EC_BV = 5120, EC_GATE = 6144;
constexpr int OC_Q = 0, OC_K = 2048, OC_V = 4096, OC_GATE = 6144;
constexpr float LAM_INIT1 = 0.35550906759f;

constexpr size_t MiB = 1u << 20;
constexpr size_t WS_CTL = 0, CTL_ZERO_BYTES = 1 * MiB;
constexpr size_t WS_MOD = 1 * MiB;
constexpr size_t WS_WZ = 2 * MiB;
constexpr size_t WS_Z = 3 * MiB;
constexpr size_t WS_WOO = 8 * MiB;
constexpr size_t WS_WIE = 16 * MiB;
constexpr size_t WS_WOE = 48 * MiB;
constexpr size_t WS_WIO = 56 * MiB;
constexpr size_t WS_H = 88 * MiB;
constexpr size_t WS_P = 160 * MiB;
constexpr size_t WS_CTX1 = 448 * MiB;
constexpr size_t WS_END = 464 * MiB;
constexpr size_t WS_O0 = 16 * MiB, WS_O1 = 80 * MiB;
static_assert(WS_O1 + (size_t)MLAT * DM * 2 <= WS_P, "attention output overlay");

constexpr int LDS_BYTES = 147456;
constexpr int LDSCTL_OFF = 131072, MISC_OFF = LDSCTL_OFF + 320;
constexpr int CW_BAR = 4096;

#define GAS __attribute__((address_space(1)))
#define LAS __attribute__((address_space(3)))
typedef unsigned short bf16;
typedef unsigned v4u __attribute__((ext_vector_type(4)));
typedef unsigned v2u __attribute__((ext_vector_type(2)));
typedef float f32x4 __attribute__((ext_vector_type(4)));
typedef short bf16x8 __attribute__((ext_vector_type(8)));

__device__ __forceinline__ unsigned f2bf(float f) { unsigned u = __builtin_bit_cast(unsigned, f); return (u + 0x7fffu + ((u >> 16) & 1u)) >> 16; }
__device__ __forceinline__ unsigned pk2(float lo, float hi) { return f2bf(lo) | (f2bf(hi) << 16); }
__device__ __forceinline__ float bf2f(unsigned short v) { return __uint_as_float((unsigned)v << 16); }
__device__ __forceinline__ float bflo(unsigned w) { return __uint_as_float(w << 16); }
__device__ __forceinline__ float bfhi(unsigned w) { return __uint_as_float(w & 0xffff0000u); }
__device__ __forceinline__ void unpack8(const v4u w, float (&x)[8]) { x[0] = bflo(w.x); x[1] = bfhi(w.x); x[2] = bflo(w.y); x[3] = bfhi(w.y); x[4] = bflo(w.z); x[5] = bfhi(w.z); x[6] = bflo(w.w); x[7] = bfhi(w.w); }
__device__ __forceinline__ v4u pack8(const float (&x)[8]) { v4u w; w.x = pk2(x[0], x[1]); w.y = pk2(x[2], x[3]); w.z = pk2(x[4], x[5]); w.w = pk2(x[6], x[7]); return w; }
__device__ __forceinline__ float wave_sum(float v) {
#pragma unroll
    for (int o = 1; o < 64; o <<= 1) v += __shfl_xor(v, o);
    return v;
}
__device__ __forceinline__ float sigmoidf_(float x) { return 1.f / (1.f + __expf(-x)); }
__device__ __forceinline__ float siluf_(float x) { return x / (1.f + __expf(-x)); }
__device__ __forceinline__ float logsigmoidf_(float x) { return fminf(x, 0.f) - log1pf(__expf(-fabsf(x))); }
__device__ __forceinline__ void sincos_(float x, float& s, float& c) {
    const float k = rintf(x * 0.63661977236758134f);
    float r = fmaf(-k, 1.5707962512969971f, x); r = fmaf(-k, 7.5497894158615964e-8f, r);
    const float r2 = r * r;
    float sp = fmaf(r2, 2.7557314297e-6f, -1.9841270114e-4f); sp = fmaf(sp, r2, 8.3333337680e-3f); sp = fmaf(sp, r2, -1.6666667163e-1f); sp = fmaf(sp * r2, r, r);
    float cp = fmaf(r2, 2.4801587642e-5f, -1.3888889225e-3f); cp = fmaf(cp, r2, 4.1666667908e-2f); cp = fmaf(cp, r2, -0.5f); cp = fmaf(cp, r2, 1.0f);
    const int q = (int)k & 3;
    const float ss = (q & 1) ? cp : sp, cc = (q & 1) ? sp : cp;
    s = (q & 2) ? -ss : ss; c = ((q + 1) & 2) ? -cc : cc;
}

#define XB_TMO      128
#define XB_XCNT(j)  (256  + 64 * (j))
#define XB_XSUB(j)  (1280 + 64 * (j))
#define XB_XGEN(j)  (2304 + 64 * (j))
#define XB_TOP      3328
#define XB_TOPGEN   3392
#define XCD_BAR_WORDS 3456
#define XB_SPIN_CAP (1u << 18)

__device__ __forceinline__ unsigned xb_ld(unsigned* p)              { return __hip_atomic_load(p, __ATOMIC_RELAXED, __HIP_MEMORY_SCOPE_AGENT); }
__device__ __forceinline__ unsigned xb_add(unsigned* p, unsigned v) { return __hip_atomic_fetch_add(p, v, __ATOMIC_RELAXED, __HIP_MEMORY_SCOPE_AGENT); }
__device__ __forceinline__ unsigned xb_xcc_id() { return (unsigned)__builtin_amdgcn_s_getreg((3 << 11) | 20) & 0xFu; }
#define XB_SPIN(cond, bar) do { unsigned _sp = 0; while (cond) { __builtin_amdgcn_s_sleep(1); \
    if ((++_sp & 255u) == 0u) { if (xb_ld(&(bar)[XB_TMO])) break; if (_sp > XB_SPIN_CAP) { atomicAdd(&(bar)[XB_TMO], 1u); break; } } } } while (0)

struct XcdBarrier {
    unsigned* bar; unsigned x;
    volatile LAS unsigned* st;
};

__device__ __forceinline__ XcdBarrier xcd_barrier_post(unsigned* bar, volatile LAS unsigned* st) {
    XcdBarrier b; b.bar = bar; b.x = xb_xcc_id(); b.st = st;
    if (threadIdx.x == 0) (void)xb_add(&bar[XB_XCNT(b.x)], 1u);
    return b;
}
__device__ __forceinline__ void xcd_barrier_complete(unsigned* bar, unsigned x, unsigned& nloc, unsigned& nx) {
    const unsigned G = gridDim.x * gridDim.y * gridDim.z;
    unsigned sum, cnt, mine, sp = 0u;
    for (;;) {
        sum = 0u; cnt = 0u; mine = 0u;
#pragma unroll
        for (unsigned j = 0; j < 16; ++j) { const unsigned c = xb_ld(&bar[XB_XCNT(j)]); sum += c; cnt += (c > 0u) ? 1u : 0u; mine = (j == x) ? c : mine; }
        if (sum == G) break;
        __builtin_amdgcn_s_sleep(1);
        if ((++sp & 255u) == 0u) { if (xb_ld(&bar[XB_TMO])) break; if (sp > XB_SPIN_CAP) { atomicAdd(&bar[XB_TMO], 1u); break; } }
    }
    nloc = mine > 0u ? mine : 1u; nx = cnt > 0u ? cnt : 1u;
}

__device__ __forceinline__ void xcd_barrier(const XcdBarrier& b) {
    asm volatile("s_waitcnt vmcnt(0)" ::: "memory");
    __syncthreads();
    if (threadIdx.x == 0) {
        unsigned* bar = b.bar;
        __builtin_amdgcn_s_waitcnt(0);
        unsigned nloc = b.st[0], nx = b.st[1];
        if (nloc == 0u) { xcd_barrier_complete(bar, b.x, nloc, nx); b.st[0] = nloc; b.st[1] = nx; }
        const unsigned old = xb_add(&bar[XB_XSUB(b.x)], 1u);
        const unsigned gen = old / nloc;
        if (old + 1u == (gen + 1u) * nloc) {
            __builtin_amdgcn_fence(__ATOMIC_RELEASE, "agent");
            asm volatile("s_waitcnt vmcnt(0)" ::: "memory");
            const unsigned og = xb_add(&bar[XB_TOP], 1u);
            const unsigned tg = og / nx;
            if (og + 1u == (tg + 1u) * nx) xb_add(&bar[XB_TOPGEN], 1u);
            else XB_SPIN(xb_ld(&bar[XB_TOPGEN]) == tg, bar);
            __builtin_amdgcn_fence(__ATOMIC_ACQUIRE, "agent");
            xb_add(&bar[XB_XGEN(b.x)], 1u);
            asm volatile("s_waitcnt vmcnt(0)" ::: "memory");
        } else {
            XB_SPIN(xb_ld(&bar[XB_XGEN(b.x)]) == gen, bar);
            __builtin_amdgcn_fence(__ATOMIC_ACQUIRE, "agent");
            asm volatile("s_waitcnt vmcnt(0)" ::: "memory");
        }
    }
    __syncthreads();
}

struct Args { const float* in[20]; float* out; unsigned char* ws; int ph_lo, ph_hi; };
__device__ __forceinline__ int tid_() { int t = threadIdx.x; asm volatile("" : "+v"(t)); return t; }
struct Frame {
    LAS unsigned char* lds;
    int tid, lane, wave, G;
    const float* in[20]; float* out; unsigned char* ws;
    __device__ __forceinline__ void ids() { tid = tid_(); lane = tid & 63; wave = __builtin_amdgcn_readfirstlane(tid >> 6); }
};
enum { I_X = 0, I_C, I_CTX, I_CCTX, I_NG, I_WADA, I_BADA, I_LB, I_WINE, I_WA2, I_BA2, I_AG, I_BG, I_WOE, I_WINO, I_QG, I_KG, I_LQK, I_CG, I_WOO };

__device__ __forceinline__ void p0_transpose_item(const float* W, int N, int k0, int n0, bf16* WT, int drow0, LAS float* scr, int lane) {
#pragma unroll 8
    for (int i = 0; i < 32; ++i) { const int kk = 2 * i + (lane >> 5); scr[kk * 33 + (lane & 31)] = W[(size_t)(k0 + kk) * N + n0 + (lane & 31)]; }
    asm volatile("s_waitcnt lgkmcnt(0)" ::: "memory");
    const int c = lane & 7;
#pragma unroll
    for (int j = 0; j < 4; ++j) { const int n = (lane >> 3) + 8 * j; const LAS float* s = scr + (8 * c) * 33 + n;
        v4u o; o.x = pk2(s[0 * 33], s[1 * 33]); o.y = pk2(s[2 * 33], s[3 * 33]); o.z = pk2(s[4 * 33], s[5 * 33]); o.w = pk2(s[6 * 33], s[7 * 33]);
        *(GAS v4u*)(WT + (size_t)(drow0 + n) * 2048 + k0 + 8 * c) = o; }
    asm volatile("s_waitcnt lgkmcnt(0)" ::: "memory");
}
__device__ __forceinline__ void p0_prologue(Frame& F) {
    if (blockIdx.x < 192) {
        const int l = blockIdx.x / 96, n0 = (blockIdx.x % 96) * 64;
        LAS float* sc = (LAS float*)F.lds;
        LAS float* red = (LAS float*)(F.lds + 9 * 2048 * 4);
        for (int i = F.tid; i < 9 * 2048; i += 512) { const int r = i >> 11, k = i & 2047; const float c = (r < 8) ? F.in[I_C][r * 2048 + k] : F.in[I_CCTX][k]; sc[i] = siluf_(c); }
        __syncthreads();
        const float* w = F.in[I_WADA] + (size_t)l * 2048 * 6144 + n0 + F.lane;
        float acc[9];
#pragma unroll
        for (int r = 0; r < 9; ++r) acc[r] = 0.f;
        const int kb = F.wave * 256;
#pragma unroll 2
        for (int k = 0; k < 256; k += 4) {
            float wv[4];
#pragma unroll
            for (int i = 0; i < 4; ++i) wv[i] = w[(size_t)(kb + k + i) * 6144];
#pragma unroll
            for (int r = 0; r < 9; ++r) { const f32x4 s = *(const LAS f32x4*)(sc + r * 2048 + kb + k); acc[r] += s[0] * wv[0] + s[1] * wv[1] + s[2] * wv[2] + s[3] * wv[3]; }
        }
#pragma unroll
        for (int r = 0; r < 9; ++r) red[(F.wave * 9 + r) * 64 + F.lane] = acc[r];
        __syncthreads();
        for (int t = F.tid; t < 576; t += 512) { const int r = t >> 6, c = t & 63; float s = 0.f;
#pragma unroll
            for (int wv = 0; wv < 8; ++wv) s += red[(wv * 9 + r) * 64 + c];
            ((float*)(F.ws + WS_MOD))[(size_t)(l * 9 + r) * 6144 + n0 + c] = s + F.in[I_BADA][l * 6144 + n0 + c]; }
        __syncthreads();
    }
    LAS float* scr = (LAS float*)(F.lds + F.wave * 16384);
    const int gw = blockIdx.x * NWAVES + F.wave, NGW = F.G * NWAVES;
    constexpr int I_E = 32 * 257, I_S = 32 * 64, I_O = 32 * 256;
    for (int it = gw; it < I_E + I_S + I_O + I_S; it += NGW) {
        int r = it;
        if (r < I_E) { const int kb = r / 257, nb = r % 257;
            if (nb < 192) p0_transpose_item(F.in[I_WINE], NE_SRC, 64 * kb, 32 * nb, (bf16*)(F.ws + WS_WIE), 32 * nb, scr, F.lane);
            else if (nb == 192) p0_transpose_item(F.in[I_WINE], NE_SRC, 64 * kb, 32 * nb, (bf16*)(F.ws + WS_WZ), 0, scr, F.lane);
            else p0_transpose_item(F.in[I_WINE], NE_SRC, 64 * kb, 32 * nb, (bf16*)(F.ws + WS_WIE), 32 * nb - 32, scr, F.lane);
            continue; }
        r -= I_E;
        if (r < I_S) { p0_transpose_item(F.in[I_WOE], 2048, 64 * (r / 64), 32 * (r % 64), (bf16*)(F.ws + WS_WOE), 32 * (r % 64), scr, F.lane); continue; }
        r -= I_S;
        if (r < I_O) { p0_transpose_item(F.in[I_WINO], 8192, 64 * (r / 256), 32 * (r % 256), (bf16*)(F.ws + WS_WIO), 32 * (r % 256), scr, F.lane); continue; }
        r -= I_O;
        p0_transpose_item(F.in[I_WOO], 2048, 64 * (r / 64), 32 * (r % 64), (bf16*)(F.ws + WS_WOO), 32 * (r % 64), scr, F.lane);
    }
}

__device__ __forceinline__ void modulate_phase(Frame& F, int l, const float* xsrc, const float* csrc) {
    const int gw = blockIdx.x * NWAVES + F.wave, NGW = F.G * NWAVES;
    const float* gain = F.in[I_NG] + l * 2048;
    bf16* H = (bf16*)(F.ws + WS_H);
    for (int m = gw; m < MROWS; m += NGW) {
        const int b = m / LTOK, t = m - b * LTOK;
        const float* src = (t < NCTX) ? csrc + ((size_t)b * NCTX + t) * DM : xsrc + ((size_t)b * SEQ + (t - NCTX)) * DM;
        const float* mod = (const float*)(F.ws + WS_MOD) + (size_t)(l * 9 + ((t < NCTX) ? 8 : b)) * 6144;
        f32x4 v[8]; float ss = 0.f;
#pragma unroll
        for (int j = 0; j < 8; ++j) { v[j] = *(const f32x4*)(src + (F.lane + 64 * j) * 4); ss += (v[j].x * v[j].x + v[j].y * v[j].y) + (v[j].z * v[j].z + v[j].w * v[j].w); }
        const float rstd = rsqrtf(wave_sum(ss) * (1.f / DM) + EPS);
#pragma unroll
        for (int j = 0; j < 8; ++j) { const int col = (F.lane + 64 * j) * 4;
            const f32x4 g = *(const f32x4*)(gain + col), sh = *(const f32x4*)(mod + col), sl = *(const f32x4*)(mod + 2048 + col);
            const f32x4 y = (v[j] * rstd) * g * (sl + 1.f) + sh;
            v2u o; o.x = pk2(y.x, y.y); o.y = pk2(y.z, y.w);
            *(v2u*)(H + (size_t)m * DM + col) = o; }
    }
}

__device__ __forceinline__ void zgemm_phase(Frame& F) {
    const int gw = blockIdx.x * NWAVES + F.wave, NGW = F.G * NWAVES;
    const bf16* H = (const bf16*)(F.ws + WS_H); const bf16* WZ = (const bf16*)(F.ws + WS_WZ); float* Z = (float*)(F.ws + WS_Z);
    const int fr = F.lane & 15, fq = F.lane >> 4;
    for (int u = gw; u < MROWS / 16; u += NGW) {
        const bf16* ap = H + (size_t)(u * 16 + fr) * DM + 8 * fq; const bf16* b0p = WZ + (size_t)fr * DM + 8 * fq; const bf16* b1p = WZ + (size_t)(16 + fr) * DM + 8 * fq;
        f32x4 a0 = {0.f, 0.f, 0.f, 0.f}, a1 = {0.f, 0.f, 0.f, 0.f};
#pragma unroll 4
        for (int k0 = 0; k0 < DM; k0 += 32) {
            const bf16x8 a = *(const bf16x8*)(ap + k0), b0 = *(const bf16x8*)(b0p + k0), b1 = *(const bf16x8*)(b1p + k0);
            a0 = __builtin_amdgcn_mfma_f32_16x16x32_bf16(a, b0, a0, 0, 0, 0); a1 = __builtin_amdgcn_mfma_f32_16x16x32_bf16(a, b1, a1, 0, 0, 0);
        }
#pragma unroll
        for (int i = 0; i < 4; ++i) { float* zr = Z + (size_t)(u * 16 + fq * 4 + i) * 32; zr[fr] = a0[i]; zr[16 + fr] = a1[i]; }
    }
}

__device__ __forceinline__ void scan_phase_v1(Frame& F, bf16* OF, bf16* OB) {
    const bf16* P = (const bf16*)(F.ws + WS_P); const float* Z = (const float*)(F.ws + WS_Z);
    LAS float* qs = (LAS float*)(F.lds + F.wave * 12800); LAS float* ks = qs + 1024; LAS float* as = qs + 2048; LAS float* vs = qs + 3072;
    const int gw = blockIdx.x * NWAVES + F.wave, NGW = F.G * NWAVES;
    const int c = F.lane & 15, dq = F.lane >> 4;
    const int ps = F.lane >> 4, pd0 = (F.lane & 15) * 8;
    for (int u = gw; u < 2048; u += NGW) {
        const bool isA = u < 1024; const int uu = isA ? u : u - 1024;
        int b, h, dir, slice;
        if (isA) { const int seq = uu >> 3; slice = uu & 7; b = seq >> 4; h = (seq >> 1) & 7; dir = seq & 1; }
        else { const int seq = uu >> 4; slice = uu & 15; b = seq >> 3; h = (seq >> 1) & 3; dir = seq & 1; }
        const int qcol = isA ? EC_AQ + h * 128 : EC_BQ + h * 128;
        const int kcol = isA ? (dir ? EC_AFB : EC_AFF) + h * 128 : EC_BK + h * 128;
        const int vcol = isA ? EC_AI + h * 128 + slice * 16 + c : EC_BV + h * 256 + slice * 16 + c;
        const int ocol = isA ? h * 128 + slice * 16 + c : 1024 + h * 256 + slice * 16 + c;
        bf16* OUT = dir ? OB : OF;
        float lbv[8];
        if (isA) {
#pragma unroll
            for (int e = 0; e < 8; ++e) { const int cc = h * 128 + pd0 + e; const float l0 = F.in[I_LB][cc], l1 = F.in[I_LB][1024 + cc], l2 = F.in[I_LB][2048 + cc];
                const float mx = fmaxf(l0, fmaxf(l1, l2)); const float e0 = __expf(l0 - mx), e1 = __expf(l1 - mx), e2 = __expf(l2 - mx); lbv[e] = e0 / (e0 + e1 + e2); }
        } else {
#pragma unroll
            for (int e = 0; e < 8; ++e) lbv[e] = F.in[I_BA2][dir * 512 + h * 128 + pd0 + e];
        }
        const float* wa2 = F.in[I_WA2] + (size_t)dir * 16 * 512 + h * 128 + pd0;
        float S[32];
#pragma unroll
        for (int i = 0; i < 32; ++i) S[i] = 0.f;
        const size_t rowb = (size_t)b * LTOK;
        for (int ch = 0; ch < LTOK / 8; ++ch) {
            const int i0 = ch * 8;
            int tbase, tstep;
            if (!dir) { tbase = i0; tstep = 1; } else { tbase = (i0 < NCTX) ? (NCTX - 1 - i0) : (LTOK - 1 - (i0 - NCTX)); tstep = -1; }
#pragma unroll
            for (int k2 = 0; k2 < 2; ++k2) { const int idx = F.lane + 64 * k2, s = idx >> 4, cc = idx & 15; vs[idx] = bf2f(P[(rowb + tbase + tstep * s) * NP + vcol - c + cc]); }
#pragma unroll
            for (int half = 0; half < 2; ++half) {
                const int s = ps + 4 * half; const size_t row = rowb + tbase + tstep * s;
                float q8[8], k8[8], a8[8];
                { const v4u w = *(const v4u*)(P + row * NP + qcol + pd0); unpack8(w, q8); }
                { const v4u w = *(const v4u*)(P + row * NP + kcol + pd0); unpack8(w, k8); }
                if (isA) {
#pragma unroll
                    for (int e = 0; e < 8; ++e) { q8[e] = siluf_(q8[e]); const float f = lbv[e] + (1.f - lbv[e]) * sigmoidf_(k8[e]); a8[e] = f; k8[e] = 1.f - f; }
                } else {
                    float ar[8];
#pragma unroll
                    for (int e = 0; e < 8; ++e) ar[e] = lbv[e];
#pragma unroll 2
                    for (int r = 0; r < 16; ++r) { const float zr = Z[row * 32 + dir * 16 + r]; const f32x4 w0 = *(const f32x4*)(wa2 + r * 512), w1 = *(const f32x4*)(wa2 + r * 512 + 4);
                        ar[0] = fmaf(zr, w0[0], ar[0]); ar[1] = fmaf(zr, w0[1], ar[1]); ar[2] = fmaf(zr, w0[2], ar[2]); ar[3] = fmaf(zr, w0[3], ar[3]);
                        ar[4] = fmaf(zr, w1[0], ar[4]); ar[5] = fmaf(zr, w1[1], ar[5]); ar[6] = fmaf(zr, w1[2], ar[6]); ar[7] = fmaf(zr, w1[3], ar[7]); }
#pragma unroll
                    for (int e = 0; e < 8; ++e) { a8[e] = __expf(logsigmoidf_(ar[e]) * (1.f / 16.f)); q8[e] *= 0.088388347648318440f; }
                }
                *(LAS f32x4*)(qs + s * 128 + pd0) = (f32x4){q8[0], q8[1], q8[2], q8[3]}; *(LAS f32x4*)(qs + s * 128 + pd0 + 4) = (f32x4){q8[4], q8[5], q8[6], q8[7]};
                *(LAS f32x4*)(ks + s * 128 + pd0) = (f32x4){k8[0], k8[1], k8[2], k8[3]}; *(LAS f32x4*)(ks + s * 128 + pd0 + 4) = (f32x4){k8[4], k8[5], k8[6], k8[7]};
                *(LAS f32x4*)(as + s * 128 + pd0) = (f32x4){a8[0], a8[1], a8[2], a8[3]}; *(LAS f32x4*)(as + s * 128 + pd0 + 4) = (f32x4){a8[4], a8[5], a8[6], a8[7]};
            }
            asm volatile("s_waitcnt lgkmcnt(0)" ::: "memory");
#pragma unroll 1
            for (int s = 0; s < 8; ++s) {
                float o = 0.f; const float v = vs[s * 16 + c];
#pragma unroll
                for (int i4 = 0; i4 < 8; ++i4) {
                    const f32x4 q4 = *(const LAS f32x4*)(qs + s * 128 + dq * 32 + i4 * 4), k4 = *(const LAS f32x4*)(ks + s * 128 + dq * 32 + i4 * 4), a4 = *(const LAS f32x4*)(as + s * 128 + dq * 32 + i4 * 4);
#pragma unroll
                    for (int e = 0; e < 4; ++e) { const float sn = fmaf(a4[e], S[i4 * 4 + e], k4[e] * v); S[i4 * 4 + e] = sn; o = fmaf(q4[e], sn, o); }
                }
                o += __shfl_xor(o, 16); o += __shfl_xor(o, 32);
                if (dq == 0) OUT[(rowb + tbase + tstep * s) * DM + ocol] = (bf16)f2bf(o);
            }
            asm volatile("s_waitcnt lgkmcnt(0)" ::: "memory");
        }
    }
}

__device__ __forceinline__ void evengate_phase(Frame& F, const bf16* OF) {
    const int gw = blockIdx.x * NWAVES + F.wave, NGW = F.G * NWAVES;
    bf16* Y = (bf16*)(F.ws + WS_H); const bf16* P = (const bf16*)(F.ws + WS_P);
    for (int m = gw; m < MROWS; m += NGW) {
#pragma unroll
        for (int j = 0; j < 4; ++j) {
            const int col = j * 512 + F.lane * 8;
            float a[8], bb[8], g[8];
            unpack8(*(const v4u*)(OF + (size_t)m * DM + col), a); unpack8(*(const v4u*)(Y + (size_t)m * DM + col), bb); unpack8(*(const v4u*)(P + (size_t)m * NP + EC_GATE + col), g);
            float ss = 0.f;
#pragma unroll
            for (int e = 0; e < 8; ++e) { a[e] += bb[e]; ss += a[e] * a[e]; }
            ss += __shfl_xor(ss, 1); ss += __shfl_xor(ss, 2); ss += __shfl_xor(ss, 4); ss += __shfl_xor(ss, 8);
            float rstd; const float* gn;
            if (j < 2) { rstd = rsqrtf(ss * (1.f / 128.f) + EPS); gn = F.in[I_AG] + (col & 127); }
            else { ss += __shfl_xor(ss, 16); rstd = rsqrtf(ss * (1.f / 256.f) + EPS); gn = F.in[I_BG] + (col & 255); }
            float y[8];
#pragma unroll
            for (int e = 0; e < 8; ++e) y[e] = a[e] * rstd * gn[e] * siluf_(g[e]);
            *(v4u*)(Y + (size_t)m * DM + col) = pack8(y);
        }
    }
}

__device__ __forceinline__ void qknorm_rope_phase(Frame& F) {
    const int gw = blockIdx.x * NWAVES + F.wave, NGW = F.G * NWAVES;
    bf16* P = (bf16*)(F.ws + WS_P);
    const int l16 = F.lane & 15;
    float gq[8], gk[8], inv[8];
#pragma unroll
    for (int e = 0; e < 8; ++e) { gq[e] = F.in[I_QG][l16 * 8 + e]; gk[e] = F.in[I_KG][l16 * 8 + e]; inv[e] = exp2f(-(float)((F.lane & 3) * 8 + e) * (13.287712379549449f / 32.f)); }
    for (int m = gw; m < MROWS; m += NGW) {
        const int b = m / LTOK, t = m - b * LTOK; const bool lat = t >= NCTX; const int pos = t - NCTX;
        const float p = (float)((F.lane & 8) ? (pos & 63) : (pos >> 6));
        float cs[8], sn[8];
#pragma unroll
        for (int e = 0; e < 8; ++e) { if (lat) sincos_(p * inv[e], sn[e], cs[e]); else { sn[e] = 0.f; cs[e] = 1.f; } }
#pragma unroll
        for (int sect = 0; sect < 2; ++sect) {
            if (sect == 0 && !lat) continue;
#pragma unroll
            for (int j = 0; j < 4; ++j) {
                bf16* ptr = P + (size_t)m * NP + sect * 2048 + j * 512 + F.lane * 8;
                float x[8]; unpack8(*(const v4u*)ptr, x);
                float ss = 0.f;
#pragma unroll
                for (int e = 0; e < 8; ++e) ss += x[e] * x[e];
                ss += __shfl_xor(ss, 1); ss += __shfl_xor(ss, 2); ss += __shfl_xor(ss, 4); ss += __shfl_xor(ss, 8);
                const float rstd = rsqrtf(ss * (1.f / 128.f) + EPS);
                float y[8];
#pragma unroll
                for (int e = 0; e < 8; ++e) { x[e] = x[e] * rstd * (sect ? gk[e] : gq[e]); }
#pragma unroll
                for (int e = 0; e < 8; ++e) { const float o = __shfl_xor(x[e], 4); y[e] = (F.lane & 4) ? fmaf(o, sn[e], x[e] * cs[e]) : fmaf(-o, sn[e], x[e] * cs[e]); }
                *(v4u*)ptr = pack8(y);
            }
        }
    }
}

__device__ __forceinline__ void diffcombine_phase(Frame& F) {
    const int gw = blockIdx.x * NWAVES + F.wave, NGW = F.G * NWAVES;
    bf16* O0 = (bf16*)(F.ws + WS_O0); const bf16* O1 = (const bf16*)(F.ws + WS_O1); const bf16* P = (const bf16*)(F.ws + WS_P);
    const float* lq = F.in[I_LQK];
    const float d01 = wave_sum(lq[F.lane] * lq[128 + F.lane] + lq[64 + F.lane] * lq[192 + F.lane]);
    const float d23 = wave_sum(lq[256 + F.lane] * lq[384 + F.lane] + lq[320 + F.lane] * lq[448 + F.lane]);
    const float lam = expf(d01) - expf(d23) + LAM_INIT1;
    for (int m = gw; m < MLAT; m += NGW) {
        const int b = m / SEQ, s = m - b * SEQ; const size_t prow = (size_t)b * LTOK + NCTX + s;
#pragma unroll
        for (int j = 0; j < 4; ++j) {
            const int col = j * 512 + F.lane * 8;
            float a[8], bb[8], g[8];
            unpack8(*(const v4u*)(O0 + (size_t)m * DM + col), a); unpack8(*(const v4u*)(O1 + (size_t)m * DM + col), bb); unpack8(*(const v4u*)(P + prow * NP + OC_GATE + col), g);
            float ss = 0.f;
#pragma unroll
            for (int e = 0; e < 8; ++e) { a[e] = fmaf(-lam, bb[e], a[e]); ss += a[e] * a[e]; }
            ss += __shfl_xor(ss, 1); ss += __shfl_xor(ss, 2); ss += __shfl_xor(ss, 4); ss += __shfl_xor(ss, 8); ss += __shfl_xor(ss, 16);
            const float rstd = rsqrtf(ss * (1.f / 256.f) + EPS) * (1.f - LAM_INIT1);
            const float* gn = F.in[I_CG] + (col & 255);
            float y[8];
#pragma unroll
            for (int e = 0; e < 8; ++e) y[e] = a[e] * rstd * gn[e] * siluf_(g[e]);
            *(v4u*)(O0 + (size_t)m * DM + col) = pack8(y);
        }
    }
}

__device__ __forceinline__ void attn_phase_v1(Frame& F, char* lds) {
    const attn::bf16* P = (const attn::bf16*)(F.ws + WS_P);
    for (int u = blockIdx.x; u < 2048; u += F.G) {
        const int qb = u & 7, e = (u >> 3) & 1, mp = (u >> 4) & 1, h = (u >> 5) & 7, b = u >> 8;
        const attn::bf16* Q = P + ((size_t)b * LTOK + NCTX + qb * 256) * NP + OC_Q + h * 256 + mp * 128;
        const attn::bf16* K = P + ((size_t)b * LTOK) * NP + OC_K + h * 256 + mp * 128;
        const attn::bf16* V = P + ((size_t)b * LTOK) * NP + OC_V + h * 256 + e * 128;
        attn::bf16* O = (attn::bf16*)(F.ws + (mp ? WS_O1 : WS_O0)) + ((size_t)b * SEQ + qb * 256) * DM + h * 256 + e * 128;
        attn::attn_dense_body<attn::bf16>(Q, K, V, O, LTOK, lds);
        __syncthreads();
    }
}

__global__ void __launch_bounds__(NWAVES * 64, 2) mega_fwd(Args args) {
    extern __shared__ __attribute__((aligned(16))) unsigned char lds[];
    Frame F;
    F.lds = (LAS unsigned char*)lds;
    F.ids(); F.G = gridDim.x;
#if MK_ONE_LAUNCH
    for (int u = F.tid; u < (LDS_BYTES - LDSCTL_OFF) / 4; u += NWAVES * 64) ((LAS unsigned*)(F.lds + LDSCTL_OFF))[u] = 0u;
    __syncthreads();
    const XcdBarrier bar = xcd_barrier_post((unsigned*)(args.ws + WS_CTL) + CW_BAR, (volatile LAS unsigned*)(F.lds + MISC_OFF) + 8);
#endif
#pragma unroll
    for (int i = 0; i < 20; ++i) F.in[i] = args.in[i];
    F.out = args.out; F.ws = args.ws;
    const int lo = args.ph_lo, hi = args.ph_hi;
#define IN(k) (lo <= (k) && (k) < hi)
#if MK_ONE_LAUNCH
#define SEAM(k) do { if (IN(k) && IN((k) + 1)) { if ((k) == 0) cg::this_grid().sync(); else xcd_barrier(bar); } } while (0)
#else
#define SEAM(k) do { } while (0)
#endif
    unsigned char* ws = args.ws;
    bf16* Hb = (bf16*)(ws + WS_H); bf16* Pb = (bf16*)(ws + WS_P);
    const float* mod0 = (const float*)(ws + WS_MOD); const float* mod1 = mod0 + 9 * 6144;
    float* ctx1 = (float*)(ws + WS_CTX1);

    if (IN(0)) { F.ids(); p0_prologue(F); } SEAM(0);
    if (IN(1)) { F.ids(); modulate_phase(F, 0, F.in[I_X], F.in[I_CTX]); } SEAM(1);
    if (IN(2)) { F.ids();
        zgemm_phase(F);
        pg8::Gemm g{Hb, (const bf16*)(ws + WS_WIE), MROWS, NP, DM}; pg8::StaticOrder S; S.init(MROWS, NP, F.G, (int)blockIdx.x);
        pg8::EpiStoreBf16 E{Pb, NP};
        pg8::gemm_phase<pg8::EpiStoreBf16, pg8::StaticOrder, true, true>(F.lds, g, S, E);
    } SEAM(2);
    if (IN(3)) { F.ids(); scan_phase_v1(F, (bf16*)F.out, Hb); } SEAM(3);
    if (IN(4)) { F.ids(); evengate_phase(F, (const bf16*)F.out); } SEAM(4);
    if (IN(5)) { F.ids();
        pg8::Gemm g{Hb, (const bf16*)(ws + WS_WOE), MROWS, DM, DM}; pg8::StaticOrder S; S.init(MROWS, DM, F.G, (int)blockIdx.x);
        pg8::EpiRes E{F.in[I_X], F.out, F.in[I_CTX], ctx1, mod0, 9};
        pg8::gemm_phase<pg8::EpiRes, pg8::StaticOrder, true, true>(F.lds, g, S, E);
    } SEAM(5);
    if (IN(6)) { F.ids(); modulate_phase(F, 1, F.out, ctx1); } SEAM(6);
    if (IN(7)) { F.ids();
        pg8::Gemm g{Hb, (const bf16*)(ws + WS_WIO), MROWS, NP, DM}; pg8::StaticOrder S; S.init(MROWS, NP, F.G, (int)blockIdx.x);
        pg8::EpiStoreBf16 E{Pb, NP};
        pg8::gemm_phase<pg8::EpiStoreBf16, pg8::StaticOrder, true, true>(F.lds, g, S, E);
    } SEAM(7);
    if (IN(8)) { F.ids(); qknorm_rope_phase(F); } SEAM(8);
    if (IN(9)) { F.ids(); attn_phase_v1(F, (char*)lds); } SEAM(9);
    if (IN(10)) { F.ids(); diffcombine_phase(F); } SEAM(10);
    if (IN(11)) { F.ids();
        pg8::Gemm g{(const bf16*)(ws + WS_O0), (const bf16*)(ws + WS_WOO), MLAT, DM, DM}; pg8::StaticOrder S; S.init(MLAT, DM, F.G, (int)blockIdx.x);
        pg8::EpiRes E{F.out, F.out, nullptr, nullptr, mod1, 8};
        pg8::gemm_phase<pg8::EpiRes, pg8::StaticOrder, true, true>(F.lds, g, S, E);
    }
#undef IN
#undef SEAM
}
constexpr int N_PHASES = 12;

extern "C" void kernel_launch(void* const* d_in, const int* in_sizes, int n_in, void* d_out, int out_size, void* d_ws, size_t ws_size, hipStream_t stream) {
    static int grid = 0;
    if (grid == 0) {
        if (n_in != 20 || in_sizes[0] != MLAT * DM || out_size != MLAT * DM || ws_size < WS_END) {
            fprintf(stderr, "kernel_launch: unexpected shapes: n_in %d in0 %d out %d ws %zu (need >= %zu)\n", n_in, n_in > 0 ? in_sizes[0] : -1, out_size, ws_size, (size_t)WS_END); grid = -1; return; }
        int dev = 0, cus = 0, per_cu = 0;
        if (hipGetDevice(&dev) != hipSuccess || hipDeviceGetAttribute(&cus, hipDeviceAttributeMultiprocessorCount, dev) != hipSuccess) { grid = -1; return; }
        if (hipFuncSetAttribute((const void*)mega_fwd, hipFuncAttributeMaxDynamicSharedMemorySize, LDS_BYTES) != hipSuccess) { fprintf(stderr, "kernel_launch: hipFuncSetAttribute failed\n"); grid = -1; return; }
        if (hipOccupancyMaxActiveBlocksPerMultiprocessor(&per_cu, (const void*)mega_fwd, NWAVES * 64, LDS_BYTES) != hipSuccess || per_cu < 1) { fprintf(stderr, "kernel_launch: occupancy query says %d blocks per CU\n", per_cu); (void)hipGetLastError(); grid = -1; return; }
        grid = cus;
    }
    if (grid < 0) return;
    Args a{};
    for (int i = 0; i < 20; ++i) a.in[i] = (const float*)d_in[i];
    a.out = (float*)d_out; a.ws = (unsigned char*)d_ws;
#if MK_ONE_LAUNCH
    if (hipMemsetAsync((char*)d_ws + WS_CTL, 0, CTL_ZERO_BYTES, stream) != hipSuccess) { fprintf(stderr, "kernel_launch: hipMemsetAsync failed\n"); return; }
    a.ph_lo = 0; a.ph_hi = N_PHASES;
    void* kargs[] = {&a};
    const hipError_t e = hipLaunchCooperativeKernel((const void*)mega_fwd, dim3(grid), dim3(NWAVES * 64), kargs, LDS_BYTES, stream);
    if (e != hipSuccess) fprintf(stderr, "kernel_launch: cooperative launch failed: %s (grid %d)\n", hipGetErrorString(e), grid);
#else
    for (int p = 0; p < N_PHASES; ++p) {
        a.ph_lo = p; a.ph_hi = p + 1;
        hipLaunchKernelGGL(mega_fwd, dim3(grid), dim3(NWAVES * 64), LDS_BYTES, stream, a);
    }
    const hipError_t le = hipPeekAtLastError();
    if (le != hipSuccess) fprintf(stderr, "kernel_launch: launch failed: %s\n", hipGetErrorName(le));
#endif
}
```

```cpp
#include <hip/hip_runtime.h>
#include <hip/hip_bf16.h>
#include <hip/hip_cooperative_groups.h>
#include <cstdio>
#include <cstdint>
#include <cmath>
namespace cg = cooperative_groups;

namespace pg8 {
#define PG8_LAS __attribute__((address_space(3)))
typedef unsigned short bf16_t;
typedef short bf16x8 __attribute__((ext_vector_type(8)));
typedef float f32x4 __attribute__((ext_vector_type(4)));
typedef unsigned u32x4 __attribute__((ext_vector_type(4)));
constexpr int BM = 256, BK = 64, HALF = 128, HTB = HALF * BK * 2  , STAGE_BYTES = 8 * HTB, NXCD = 8, WGM = 8;

__host__ __device__ __forceinline__ int lds_byte(int r, int c) { const int st = (r >> 4) * 2 + (c >> 5), rr = r & 15, cc = c & 31, ob = rr * 64 + cc * 2; return st * 1024 + (ob ^ (((ob >> 9) & 1) << 5)); }
__host__ __device__ __forceinline__ void stage_rc(int b, int& R, int& C) { const int st = b / 1024, sb = b % 1024, swz = sb ^ (((sb >> 9) & 1) << 5); R = (st >> 1) * 16 + swz / 64; C = (st & 1) * 32 + (swz % 64) / 2; }
__host__ __device__ __forceinline__ int perm32(int rho) { const int n = rho >> 4, i = rho & 15; return 8 * (i >> 2) + 4 * n + (i & 3); }

struct Unit { int pm, pn; };
struct Gemm { const bf16_t* A; const bf16_t* Bt; int M, N, K; };

struct StaticOrder {
    int nM, nN, nwg, G, c;
    __host__ __device__ void init(int M, int N, int G_, int c_) { nM = M / BM; nN = N / BM; nwg = nM * nN; G = G_; c = c_; }
    __host__ __device__ bool next(int i, Unit& u) const {
        const long L = (long)i * G + c; if (L >= nwg) return false;
        int wgid = (int)L; { const int q = nwg / NXCD, r = nwg % NXCD, xcd = wgid % NXCD, off = wgid / NXCD; wgid = (xcd < r ? xcd * (q + 1) : r * (q + 1) + (xcd - r) * q) + off; }
        const int nig = WGM * nN, gid = wgid / nig, fm = gid * WGM, gsz = (nM - fm) < WGM ? (nM - fm) : WGM;
        u.pm = fm + ((wgid % nig) % gsz); u.pn = (wgid % nig) / gsz; return true;
    }
    __device__ __forceinline__ void a_ready(const Unit&) const {}
    __device__ __forceinline__ void done(const Unit&) const {}
};

__device__ __forceinline__ unsigned cvt_pk_bf16(float lo, float hi) { unsigned r; asm volatile("v_cvt_pk_bf16_f32 %0, %1, %2" : "=v"(r) : "v"(lo), "v"(hi)); return r; }
struct EpiStoreBf16 {
    static constexpr bool PERM = true, AFTER_DRAIN = false;
    bf16_t* O; int ldc;
    __device__ __forceinline__ void operator()(const f32x4 (&acc)[2][2][4][2], const Unit& u, int wr, int wc, int fr, int fq) const {
        const int row0 = u.pm * BM + wr * 64 + fr; const int col0 = u.pn * BM + wc * 32 + 8 * fq;
#pragma unroll
        for (int ai = 0; ai < 2; ++ai)
#pragma unroll
            for (int m = 0; m < 4; ++m) { bf16_t* rowp = O + (size_t)(row0 + ai * HALF + m * 16) * ldc + col0;
#pragma unroll
                for (int bj = 0; bj < 2; ++bj) { const f32x4 v0 = acc[ai][bj][m][0], v1 = acc[ai][bj][m][1];
                    u32x4 w; w.x = cvt_pk_bf16(v0[0], v0[1]); w.y = cvt_pk_bf16(v0[2], v0[3]); w.z = cvt_pk_bf16(v1[0], v1[1]); w.w = cvt_pk_bf16(v1[2], v1[3]);
                    *(u32x4*)(rowp + bj * HALF) = w; } }
    }
};
struct EpiRes {
    static constexpr bool PERM = false, AFTER_DRAIN = false;
    const float* xsrc; float* xdst; const float* csrc; float* cdst; const float* mod; int tpb;
    __device__ __forceinline__ void operator()(const f32x4 (&acc)[2][2][4][2], const Unit& u, int wr, int wc, int fr, int fq) const {
        const int b = u.pm / tpb, j = u.pm - b * tpb;
        const float* src; float* dst; const float* g;
        if (tpb == 9 && j == 0) { const size_t off = (size_t)b * 256 * 2048; src = csrc + off; dst = cdst + off; g = mod + 8 * 6144 + 4096; }
        else { const int jj = (tpb == 9) ? j - 1 : j; const size_t off = ((size_t)b * 2048 + (size_t)jj * 256) * 2048; src = xsrc + off; dst = xdst + off; g = mod + b * 6144 + 4096; }
        const int r0 = wr * 64 + fr, col0 = u.pn * BM + wc * 32 + 4 * fq;
        f32x4 gv[2][2];
#pragma unroll
        for (int bj = 0; bj < 2; ++bj)
#pragma unroll
            for (int n = 0; n < 2; ++n) gv[bj][n] = *(const f32x4*)(g + col0 + bj * HALF + n * 16);
#pragma unroll
        for (int ai = 0; ai < 2; ++ai)
#pragma unroll
            for (int m = 0; m < 4; ++m) { const size_t roff = (size_t)(r0 + ai * HALF + m * 16) * 2048 + col0;
#pragma unroll
                for (int bj = 0; bj < 2; ++bj)
#pragma unroll
                    for (int n = 0; n < 2; ++n) { const f32x4 s = *(const f32x4*)(src + roff + bj * HALF + n * 16); *(f32x4*)(dst + roff + bj * HALF + n * 16) = s + gv[bj][n] * acc[ai][bj][m][n]; }
                asm volatile("" ::: "memory"); }
    }
};

template <class Epi, class Sched, bool ALIGN_EPI = false, bool SP2 = false>
__device__ __forceinline__ void gemm_phase(PG8_LAS unsigned char* lds, const Gemm g, const Sched& S, const Epi& E) {
    const int tid = threadIdx.x, wid = __builtin_amdgcn_readfirstlane(tid >> 6), lane = tid & 63, wr = wid >> 2, wc = wid & 3, fr = lane & 15, fq = lane >> 4;
    const int K = g.K, nt = K / BK;
    unsigned voffA[2], voffB[2];
#pragma unroll
    for (int i = 0; i < 2; ++i) { int R, C; stage_rc(tid * 16 + i * 8192, R, C); const int Rb = Epi::PERM ? ((R & ~31) + perm32(R & 31)) : R;
        voffA[i] = (unsigned)(R * K + C) * 2u; voffB[i] = (unsigned)(Rb * K + C) * 2u; }
    const size_t kstep = (size_t)(BK * 2);
    const size_t hstep = (size_t)HALF * K * 2;
    const size_t tstep = 2 * hstep;
    const unsigned ldsw = (unsigned)wid * 1024u;
    const int aoff = lds_byte(wr * 64 + fr, fq * 8), boff = lds_byte(wc * 32 + fr, fq * 8);
#define PG8_SA(b, h) (((b) * 2 + (h)) * HTB)
#define PG8_SB(b, h) ((4 + (b) * 2 + (h)) * HTB)
#define PG8_STAGE(bufoff, gbase, voff) do { _Pragma("unroll") for (int _i = 0; _i < 2; ++_i) \
        __builtin_amdgcn_global_load_lds((const unsigned*)((const char*)(gbase) + (voff)[_i]), (PG8_LAS unsigned*)(lds + (bufoff) + ldsw + _i * 8192), 16, 0, 0); } while (0)
#define PG8_LDA(dst, b, h) do { _Pragma("unroll") for (int m = 0; m < 4; ++m) _Pragma("unroll") for (int k = 0; k < 2; ++k) dst[m][k] = *(const PG8_LAS bf16x8*)(lds + PG8_SA(b, h) + aoff + m * 2048 + k * 1024); } while (0)
#define PG8_LDB(dst, b, h) do { _Pragma("unroll") for (int n = 0; n < 2; ++n) _Pragma("unroll") for (int k = 0; k < 2; ++k) dst[n][k] = *(const PG8_LAS bf16x8*)(lds + PG8_SB(b, h) + boff + n * 2048 + k * 1024); } while (0)
#define PG8_MMA(ai, bj, At, Bt) do { __builtin_amdgcn_s_setprio(1); _Pragma("unroll") for (int m = 0; m < 4; ++m) _Pragma("unroll") for (int n = 0; n < 2; ++n) _Pragma("unroll") for (int k = 0; k < 2; ++k) \
        acc[ai][bj][m][n] = __builtin_amdgcn_mfma_f32_16x16x32_bf16(Bt[n][k], At[m][k], acc[ai][bj][m][n], 0, 0, 0); __builtin_amdgcn_s_setprio(0); } while (0)
#define PG8_WAIT_V(n) asm volatile("s_waitcnt vmcnt(" #n ")" ::: "memory")
#define PG8_WAIT_L(n) asm volatile("s_waitcnt lgkmcnt(" #n ")" ::: "memory")
#define PG8_BAR __builtin_amdgcn_s_barrier()
#define PG8_SCHED __builtin_amdgcn_sched_barrier(0)
    Unit cur, nxt; int ui = 0;
    if (!S.next(0, cur)) return;
    f32x4 acc[2][2][4][2];
#pragma unroll
    for (int a = 0; a < 2; ++a)
#pragma unroll
        for (int b = 0; b < 2; ++b)
#pragma unroll
            for (int m = 0; m < 4; ++m)
#pragma unroll
                for (int n = 0; n < 2; ++n) acc[a][b][m][n] = (f32x4){0.f, 0.f, 0.f, 0.f};
    bf16x8 At[4][2], B0[2][2], B1[2][2];
    const char* cA = (const char*)g.A + (size_t)cur.pm * tstep; const char* cB = (const char*)g.Bt + (size_t)cur.pn * tstep;
    S.a_ready(cur);
    if constexpr (SP2) {
        PG8_STAGE(PG8_SB(0, 0), cB, voffB); PG8_STAGE(PG8_SB(0, 1), cB + hstep, voffB); PG8_STAGE(PG8_SA(0, 0), cA, voffA); PG8_STAGE(PG8_SA(0, 1), cA + hstep, voffA);
        if (wr == 1) PG8_BAR;
        PG8_WAIT_V(2); PG8_BAR;
        PG8_STAGE(PG8_SB(1, 0), cB + kstep, voffB); PG8_STAGE(PG8_SA(1, 0), cA + kstep, voffA); PG8_STAGE(PG8_SB(1, 1), cB + hstep + kstep, voffB);
        PG8_WAIT_V(6); PG8_BAR;
    } else {
        PG8_STAGE(PG8_SB(0, 0), cB, voffB); PG8_STAGE(PG8_SA(0, 0), cA, voffA); PG8_STAGE(PG8_SB(0, 1), cB + hstep, voffB); PG8_STAGE(PG8_SA(0, 1), cA + hstep, voffA);
        if (wr == 1) PG8_BAR;
        PG8_WAIT_V(4); PG8_BAR;
        PG8_STAGE(PG8_SB(1, 0), cB + kstep, voffB); PG8_STAGE(PG8_SA(1, 0), cA + kstep, voffA); PG8_STAGE(PG8_SB(1, 1), cB + hstep + kstep, voffB);
        PG8_WAIT_V(6); PG8_BAR;
    }
    for (;;) {
        const bool has_next = S.next(ui + 1, nxt);
        const char* nA = has_next ? (const char*)g.A + (size_t)nxt.pm * tstep : cA; const char* nB = has_next ? (const char*)g.Bt + (size_t)nxt.pn * tstep : cB;
        for (int t = 0; t < nt; t += 2) {
            const bool last = (t == nt - 2);
            const char* a1 = cA + (size_t)(t + 1) * kstep;
            const char* a2 = last ? nA : cA + (size_t)(t + 2) * kstep; const char* b2 = last ? nB : cB + (size_t)(t + 2) * kstep;
            const char* a3 = a2 + kstep; const char* b3 = b2 + kstep;
            if (last && has_next) S.a_ready(nxt);
            if constexpr (SP2) {
            PG8_LDB(B0, 0, 0); PG8_LDB(B1, 0, 1); PG8_SCHED; PG8_LDA(At, 0, 0); PG8_STAGE(PG8_SA(1, 1), a1 + hstep, voffA);
            PG8_WAIT_V(8); PG8_WAIT_L(0); PG8_BAR; PG8_MMA(0, 0, At, B0); PG8_MMA(0, 1, At, B1); PG8_BAR; PG8_SCHED;
            PG8_LDA(At, 0, 1); PG8_STAGE(PG8_SB(0, 0), b2, voffB); PG8_STAGE(PG8_SB(0, 1), b2 + hstep, voffB); PG8_STAGE(PG8_SA(0, 0), a2, voffA);
            PG8_WAIT_V(8); PG8_WAIT_L(0); PG8_BAR; PG8_MMA(1, 0, At, B0); PG8_MMA(1, 1, At, B1); PG8_BAR; PG8_SCHED;
            PG8_LDB(B0, 1, 0); PG8_LDB(B1, 1, 1); PG8_SCHED; PG8_LDA(At, 1, 0); PG8_STAGE(PG8_SA(0, 1), a2 + hstep, voffA);
            PG8_WAIT_V(8); PG8_WAIT_L(0); PG8_BAR; PG8_MMA(0, 0, At, B0); PG8_MMA(0, 1, At, B1); PG8_BAR; PG8_SCHED;
            PG8_LDA(At, 1, 1); PG8_STAGE(PG8_SB(1, 0), b3, voffB); PG8_STAGE(PG8_SB(1, 1), b3 + hstep, voffB); PG8_STAGE(PG8_SA(1, 0), a3, voffA);
            PG8_WAIT_V(8); PG8_WAIT_L(0); PG8_BAR; PG8_MMA(1, 0, At, B0); PG8_MMA(1, 1, At, B1); PG8_BAR; PG8_SCHED;
            } else {
            PG8_LDB(B0, 0, 0); PG8_SCHED; PG8_LDA(At, 0, 0); PG8_STAGE(PG8_SA(1, 1), a1 + hstep, voffA);
            PG8_WAIT_L(8); PG8_BAR; PG8_WAIT_L(0); PG8_MMA(0, 0, At, B0); PG8_BAR; PG8_SCHED;
            PG8_LDB(B1, 0, 1); PG8_STAGE(PG8_SB(0, 0), b2, voffB);
            PG8_BAR; PG8_WAIT_L(0); PG8_MMA(0, 1, At, B1); PG8_BAR;
            PG8_LDA(At, 0, 1); PG8_STAGE(PG8_SA(0, 0), a2, voffA);
            PG8_BAR; PG8_WAIT_L(0); PG8_MMA(1, 0, At, B0); PG8_BAR; PG8_SCHED;
            PG8_STAGE(PG8_SB(0, 1), b2 + hstep, voffB);
            PG8_WAIT_V(6); PG8_BAR; PG8_MMA(1, 1, At, B1); PG8_BAR;
            PG8_LDB(B0, 1, 0); PG8_SCHED; PG8_LDA(At, 1, 0); PG8_STAGE(PG8_SA(0, 1), a2 + hstep, voffA);
            PG8_WAIT_L(8); PG8_BAR; PG8_WAIT_L(0); PG8_MMA(0, 0, At, B0); PG8_BAR; PG8_SCHED;
            PG8_LDB(B1, 1, 1); PG8_STAGE(PG8_SB(1, 0), b3, voffB);
            PG8_BAR; PG8_WAIT_L(0); PG8_MMA(0, 1, At, B1); PG8_BAR;
            PG8_LDA(At, 1, 1); PG8_STAGE(PG8_SA(1, 0), a3, voffA);
            PG8_BAR; PG8_WAIT_L(0); PG8_MMA(1, 0, At, B0); PG8_BAR; PG8_SCHED;
            PG8_STAGE(PG8_SB(1, 1), b3 + hstep, voffB);
            PG8_WAIT_V(6); PG8_BAR; PG8_MMA(1, 1, At, B1); PG8_BAR;
            }
        }
        if constexpr (ALIGN_EPI) { if (wr == 0) PG8_BAR; }
        if constexpr (!Epi::AFTER_DRAIN) { E(acc, cur, wr, wc, fr, fq); S.done(cur); }
        if (!has_next) break;
#pragma unroll
        for (int a = 0; a < 2; ++a)
#pragma unroll
            for (int b = 0; b < 2; ++b)
#pragma unroll
                for (int m = 0; m < 4; ++m)
#pragma unroll
                    for (int n = 0; n < 2; ++n) acc[a][b][m][n] = (f32x4){0.f, 0.f, 0.f, 0.f};
        cur = nxt; cA = nA; cB = nB; ++ui;
        if constexpr (ALIGN_EPI) { if (wr == 1) PG8_BAR; }
    }
    PG8_WAIT_V(0);
    if constexpr (!ALIGN_EPI) { if (wr == 0) PG8_BAR; }
    PG8_BAR;
    if constexpr (Epi::AFTER_DRAIN) { E.fused(acc, cur, wr, wc, fr, fq, lds, wid, lane); S.done(cur); }
#undef PG8_SA
#undef PG8_SB
#undef PG8_STAGE
#undef PG8_LDA
#undef PG8_LDB
#undef PG8_MMA
#undef PG8_WAIT_V
#undef PG8_WAIT_L
#undef PG8_BAR
#undef PG8_SCHED
}
}
namespace attn {
using bf16 = __hip_bfloat16;
constexpr int   D = 128, NW = 8, QBLK = 32, KVBLK = 64;
constexpr float SCALE = 0.088388347648318440f;
constexpr float THR = 8.f;
#ifndef ATT_SDEPTH
#define ATT_SDEPTH 1
#endif
constexpr int SDEPTH = ATT_SDEPTH;
constexpr int LDQ = 8192, LDK = 8192, LDO = 2048;
constexpr size_t SHM_V = KVBLK * D * 2, SHM_K = KVBLK * D * 2, SHM_ATTN = 2 * SHM_V + 2 * SHM_K + NW * 64 * 4;
using bf16x8 = __attribute__((ext_vector_type(8))) short;
using s16x4  = __attribute__((ext_vector_type(4))) short;
using f32x16 = __attribute__((ext_vector_type(16))) float;
using f32x8  = __attribute__((ext_vector_type(8))) float;
using u32x4  = __attribute__((ext_vector_type(4))) unsigned;
#define KSWZ(row, colB) ((row) * 256 + ((colB) ^ (((row) & 7) << 4)))
#define SBAR() __builtin_amdgcn_sched_barrier(0)
__device__ __forceinline__ int crow(int r, int hi) { return (r & 3) + 8 * (r >> 2) + 4 * hi; }
__device__ __forceinline__ unsigned cvtpk(float lo, float hi) {
  unsigned r; asm volatile("v_cvt_pk_bf16_f32 %0, %1, %2" : "=v"(r) : "v"(lo), "v"(hi)); return r;
}
template <typename TIn> struct Stage;
template <> struct Stage<bf16>  { using T = bf16x8;
  __device__ static __forceinline__ T ld8(const bf16* p) { return *reinterpret_cast<const bf16x8*>(p); }
  __device__ static __forceinline__ bf16x8 tobf(T x) { return x; } };
template <> struct Stage<float> { using T = f32x8;
  __device__ static __forceinline__ T ld8(const float* p) { return *reinterpret_cast<const f32x8*>(p); }
  __device__ static __forceinline__ bf16x8 tobf(T x) {
    u32x4 w = {cvtpk(x[0], x[1]), cvtpk(x[2], x[3]), cvtpk(x[4], x[5]), cvtpk(x[6], x[7])}; return *reinterpret_cast<bf16x8*>(&w); } };

__device__ __forceinline__ void partialSM(f32x16& p0, f32x16& p1, float& m_reg, float& mn, float& alpha) {
  constexpr float C = SCALE * 1.4426950408889634f;
  float pmax = p0[0]; for (int r = 1; r < 16; ++r) pmax = fmaxf(pmax, p0[r]); for (int r = 0; r < 16; ++r) pmax = fmaxf(pmax, p1[r]);
  { auto rr = __builtin_amdgcn_permlane32_swap(__float_as_uint(pmax), __float_as_uint(pmax), false, false);
    pmax = fmaxf(__uint_as_float(rr[0]), __uint_as_float(rr[1])); }
  if (__builtin_expect(__all(pmax - m_reg <= THR / SCALE), 1)) { mn = m_reg; alpha = 1.f; }
  else { mn = fmaxf(m_reg, pmax); alpha = __builtin_amdgcn_exp2f((m_reg - mn) * C); m_reg = mn; }
  float mnC = -mn * C;
  for (int r = 0; r < 16; ++r) p0[r] = fmaf(p0[r], C, mnC); for (int r = 0; r < 16; ++r) p1[r] = fmaf(p1[r], C, mnC);
  for (int r = 0; r < 16; ++r) p0[r] = __builtin_amdgcn_exp2f(p0[r]);
}
__device__ __forceinline__ void finishSM(f32x16& p0, f32x16& p1, float alpha, float& l_reg, bf16x8& pa0, bf16x8& pa1, bf16x8& pa2, bf16x8& pa3) {
  for (int r = 0; r < 16; ++r) p1[r] = __builtin_amdgcn_exp2f(p1[r]);
  float ps = 0; for (int r = 0; r < 16; ++r) ps += p0[r]; for (int r = 0; r < 16; ++r) ps += p1[r];
  { auto rr = __builtin_amdgcn_permlane32_swap(__float_as_uint(ps), __float_as_uint(ps), false, false);
    ps = __uint_as_float(rr[0]) + __uint_as_float(rr[1]); }
  l_reg = l_reg * alpha + ps;
#define PK4(P, BASE, OUT) do { unsigned a0 = cvtpk(P[BASE + 0], P[BASE + 1]), a1 = cvtpk(P[BASE + 2], P[BASE + 3]);   \
    unsigned b0 = cvtpk(P[BASE + 4], P[BASE + 5]), b1 = cvtpk(P[BASE + 6], P[BASE + 7]);                              \
    auto r0 = __builtin_amdgcn_permlane32_swap(a0, b0, false, false); auto r1 = __builtin_amdgcn_permlane32_swap(a1, b1, false, false); \
    u32x4 w = {r0[0], r1[0], r0[1], r1[1]}; OUT = *reinterpret_cast<bf16x8*>(&w); } while (0)
  PK4(p0, 0, pa0); PK4(p0, 8, pa1); PK4(p1, 0, pa2); PK4(p1, 8, pa3);
#undef PK4
}
__device__ __forceinline__ void qkt(f32x16& p0, f32x16& p1, const bf16* Ks, const bf16x8* qr, int r32, int hi) {
  p0 = f32x16{}; p1 = f32x16{};
  for (int d0 = 0; d0 < 8; ++d0) { int cb = (d0 * 16 + hi * 8) * 2;
    bf16x8 b0 = *reinterpret_cast<const bf16x8*>((const char*)Ks + KSWZ(r32, cb));
    bf16x8 b1 = *reinterpret_cast<const bf16x8*>((const char*)Ks + KSWZ(32 + r32, cb));
    p0 = __builtin_amdgcn_mfma_f32_32x32x16_bf16(b0, qr[d0], p0, 0, 0, 0);
    p1 = __builtin_amdgcn_mfma_f32_32x32x16_bf16(b1, qr[d0], p1, 0, 0, 0); }
}
__device__ __forceinline__ int v_st(int k, int c) { const int kk = (k & ~0xC) | ((k & 4) << 1) | ((k & 8) >> 1); return ((kk >> 3) * 4 + (c >> 5)) * 512 + ((kk & 7) * 32 + (c & 31)) * 2; }
__device__ __forceinline__ int v_rd_base(int lane) { return ((lane & 3) << 3) | (((lane >> 2) & 3) << 6) | (((lane >> 4) & 1) << 5) | (((lane >> 5) & 1) << 8); }
constexpr int v_rd_off(int d0, int ks, int half) { return d0 * 512 + ks * 4096 + half * 2048; }
template <int OFF> __device__ __forceinline__ s16x4 tr_read(int vb) {
  s16x4 r; asm volatile("ds_read_b64_tr_b16 %0, %1 offset:%2" : "=&v"(r) : "v"(vb), "i"(OFF) : "memory"); return r;
}
template <int D0> __device__ __forceinline__ void pv_one(f32x16& od, int vb, bf16x8 pa0, bf16x8 pa1, bf16x8 pa2, bf16x8 pa3) {
  const s16x4 l0 = tr_read<v_rd_off(D0, 0, 0)>(vb), h0 = tr_read<v_rd_off(D0, 0, 1)>(vb), l1 = tr_read<v_rd_off(D0, 1, 0)>(vb), h1 = tr_read<v_rd_off(D0, 1, 1)>(vb);
  const s16x4 l2 = tr_read<v_rd_off(D0, 2, 0)>(vb), h2 = tr_read<v_rd_off(D0, 2, 1)>(vb), l3 = tr_read<v_rd_off(D0, 3, 0)>(vb), h3 = tr_read<v_rd_off(D0, 3, 1)>(vb);
  asm volatile("s_waitcnt lgkmcnt(0)" ::: "memory"); SBAR();
#define PK(L, H) (bf16x8){L[0], L[1], L[2], L[3], H[0], H[1], H[2], H[3]}
  od = __builtin_amdgcn_mfma_f32_32x32x16_bf16(pa0, PK(l0, h0), od, 0, 0, 0);
  od = __builtin_amdgcn_mfma_f32_32x32x16_bf16(pa1, PK(l1, h1), od, 0, 0, 0);
  od = __builtin_amdgcn_mfma_f32_32x32x16_bf16(pa2, PK(l2, h2), od, 0, 0, 0);
  od = __builtin_amdgcn_mfma_f32_32x32x16_bf16(pa3, PK(l3, h3), od, 0, 0, 0);
#undef PK
}
__device__ __forceinline__ void pv_d0(f32x16* o, int vb, bf16x8 pa0, bf16x8 pa1, bf16x8 pa2, bf16x8 pa3) {
  pv_one<0>(o[0], vb, pa0, pa1, pa2, pa3); pv_one<1>(o[1], vb, pa0, pa1, pa2, pa3); pv_one<2>(o[2], vb, pa0, pa1, pa2, pa3); pv_one<3>(o[3], vb, pa0, pa1, pa2, pa3);
}

template <typename TQ>
__device__ __forceinline__ void attn_dense_body(const TQ* __restrict__ Qb, const bf16* __restrict__ Kh, const bf16* __restrict__ Vh,
                                                bf16* __restrict__ Ob, int seq, char* lds) {
  using St = Stage<bf16>; using SQ = Stage<TQ>;
  const int tid = threadIdx.x, wid = tid >> 6, lane = tid & 63, r32 = lane & 31, hi = lane >> 5;
  bf16* V_lds = (bf16*)lds; bf16* K_lds = (bf16*)(lds + 2 * SHM_V);
  float* ws = (float*)(lds + 2 * SHM_V + 2 * SHM_K) + wid * 64; float* li_l = ws; float* al_l = ws + 32;
  float m_reg = -1e30f, l_reg = 0; f32x16 o[4] = {}; bf16x8 qr[8];
  const TQ* Qw = Qb + (long)(wid * QBLK + r32) * LDQ + hi * 8;
#pragma unroll
  for (int d0 = 0; d0 < 8; ++d0) qr[d0] = SQ::tobf(SQ::ld8(Qw + d0 * 16));
  const int sr = tid >> 4, sc = (tid & 15) * 8, vst0 = v_st(sr, sc), vst1 = v_st(32 + sr, sc);
  const int vb0 = (int)(uintptr_t)V_lds + v_rd_base(lane);
  struct { typename St::T vs0, vs1, ks0, ks1; } sr_[SDEPTH];
  const unsigned so0 = (unsigned)(sr * LDK + sc) * 2u, so1 = (unsigned)((32 + sr) * LDK + sc) * 2u;
#define SLOAD(i, k0) do { const char* vt_ = (const char*)Vh + (size_t)(k0) * (LDK * 2); const char* kt_ = (const char*)Kh + (size_t)(k0) * (LDK * 2); \
    sr_[i].vs0 = *(const bf16x8*)(vt_ + so0); sr_[i].vs1 = *(const bf16x8*)(vt_ + so1); \
    sr_[i].ks0 = *(const bf16x8*)(kt_ + so0); sr_[i].ks1 = *(const bf16x8*)(kt_ + so1); } while (0)
#define SWRITE(b, i) do { *(bf16x8*)((char*)V_lds + (b) * SHM_V + vst0) = St::tobf(sr_[i].vs0);          \
    *(bf16x8*)((char*)V_lds + (b) * SHM_V + vst1) = St::tobf(sr_[i].vs1); int kc = sc * 2;               \
    *(bf16x8*)((char*)K_lds + (b) * SHM_K + KSWZ(sr, kc)) = St::tobf(sr_[i].ks0);                       \
    *(bf16x8*)((char*)K_lds + (b) * SHM_K + KSWZ(32 + sr, kc)) = St::tobf(sr_[i].ks1); } while (0)
#define SWAIT() do { if constexpr (SDEPTH == 2) asm volatile("s_waitcnt vmcnt(4)" ::: "memory"); else asm volatile("s_waitcnt vmcnt(0)" ::: "memory"); } while (0)
#define RESC(a) do { if (__any((a) < 1.f)) { if (hi == 0) al_l[r32] = (a); asm volatile("s_waitcnt lgkmcnt(0)" ::: "memory"); \
    for (int d = 0; d < 4; ++d) for (int r = 0; r < 16; ++r) o[d][r] *= al_l[crow(r, hi)]; } } while (0)
  f32x16 pA0, pA1, pB0, pB1; float mnA, mnB, alA, alB; bf16x8 pa0, pa1, pa2, pa3; const int NT = seq / KVBLK;
  constexpr int SE = 0, SO = SDEPTH - 1;
  SLOAD(SE, 0); asm volatile("s_waitcnt vmcnt(0)" ::: "memory"); SWRITE(0, SE); __syncthreads();
  qkt(pA0, pA1, K_lds, qr, r32, hi); partialSM(pA0, pA1, m_reg, mnA, alA);
  SLOAD(SO, KVBLK); if constexpr (SDEPTH == 2) { if (2 < NT) SLOAD(SE, 2 * KVBLK); }
  SWAIT(); SWRITE(1, SO); __syncthreads();
  for (int j = 1; j + 1 < NT; j += 2) {
    SBAR(); qkt(pB0, pB1, (bf16*)((char*)K_lds + SHM_K), qr, r32, hi);
    finishSM(pA0, pA1, alA, l_reg, pa0, pa1, pa2, pa3); SBAR();
    SLOAD(SO, (j + SDEPTH) * KVBLK); SBAR();
    pv_d0(o, vb0, pa0, pa1, pa2, pa3); partialSM(pB0, pB1, m_reg, mnB, alB);
    __syncthreads(); SWAIT(); SWRITE(0, SE);
    RESC(alB); __syncthreads();
    SBAR(); qkt(pA0, pA1, K_lds, qr, r32, hi);
    finishSM(pB0, pB1, alB, l_reg, pa0, pa1, pa2, pa3); SBAR();
    if (SDEPTH == 1 || j + 3 < NT) SLOAD(SE, (j + 1 + SDEPTH) * KVBLK); SBAR();
    pv_d0(o, vb0 + (int)SHM_V, pa0, pa1, pa2, pa3); partialSM(pA0, pA1, m_reg, mnA, alA);
    __syncthreads(); SWAIT(); SWRITE(1, SO);
    RESC(alA); __syncthreads();
  }
  SBAR(); qkt(pB0, pB1, (bf16*)((char*)K_lds + SHM_K), qr, r32, hi);
  finishSM(pA0, pA1, alA, l_reg, pa0, pa1, pa2, pa3); SBAR();
  pv_d0(o, vb0, pa0, pa1, pa2, pa3); partialSM(pB0, pB1, m_reg, mnB, alB);
  __syncthreads(); RESC(alB);
  finishSM(pB0, pB1, alB, l_reg, pa0, pa1, pa2, pa3); SBAR();
  pv_d0(o, vb0 + (int)SHM_V, pa0, pa1, pa2, pa3);
  if (hi == 0) li_l[r32] = l_reg; asm volatile("s_waitcnt lgkmcnt(0)" ::: "memory");
  float rli[16];
#pragma unroll
  for (int r = 0; r < 16; ++r) rli[r] = __builtin_amdgcn_rcpf(li_l[crow(r, hi)]);
  bf16* Ow = Ob + (long)(wid * QBLK) * LDO;
  const unsigned ob = (unsigned)(4 * hi * LDO + r32) * 2u;
#pragma unroll
  for (int r = 0; r < 16; ++r) {
    for (int d0 = 0; d0 < 4; ++d0) *(bf16*)((char*)Ow + ob + (unsigned)(((r & 3) + 8 * (r >> 2)) * LDO + d0 * 32) * 2u) = __float2bfloat16(o[d0][r] * rli[r]); }
#undef SLOAD
#undef SWRITE
#undef SWAIT
#undef RESC
}

}

constexpr int NWAVES = 8;
#ifndef MK_ONE_LAUNCH
#define MK_ONE_LAUNCH 1
#endif
constexpr int NB = 8, SEQ = 2048, NCTX = 256, LTOK = SEQ + NCTX, DM = 2048;
constexpr int MROWS = NB * LTOK;
constexpr int MLAT = NB * SEQ;
constexpr int NE_SRC = 8224, NP = 8192;
constexpr float EPS = 1e-6f;
constexpr int EC_AQ = 0, EC_AFF = 1024, EC_AFB = 2048, EC_AI = 3072, EC_BQ = 4096, EC_BK = 4608, EC_BV = 5120, EC_GATE = 6144;
constexpr int OC_Q = 0, OC_K = 2048, OC_V = 4096, OC_GATE = 6144;
constexpr float LAM_INIT1 = 0.35550906759f;

constexpr size_t MiB = 1u << 20;
constexpr size_t WS_CTL = 0, CTL_ZERO_BYTES = 1 * MiB;
constexpr size_t WS_MOD = 1 * MiB;
constexpr size_t WS_WZ = 2 * MiB;
constexpr size_t WS_Z = 3 * MiB;
constexpr size_t WS_WOO = 8 * MiB;
constexpr size_t WS_WIE = 16 * MiB;
constexpr size_t WS_WOE = 48 * MiB;
constexpr size_t WS_WIO = 56 * MiB;
constexpr size_t WS_H = 88 * MiB;
constexpr size_t WS_P = 160 * MiB;
constexpr size_t WS_CTX1 = 448 * MiB;
constexpr size_t WS_END = 464 * MiB;
constexpr size_t WS_O0 = 16 * MiB, WS_O1 = 80 * MiB;
static_assert(WS_O1 + (size_t)MLAT * DM * 2 <= WS_P, "attention output overlay");

constexpr int LDS_BYTES = 147456;
constexpr int LDSCTL_OFF = 131072, MISC_OFF = LDSCTL_OFF + 320;
constexpr int CW_BAR = 4096;

#define GAS __attribute__((address_space(1)))
#define LAS __attribute__((address_space(3)))
typedef unsigned short bf16;
typedef unsigned v4u __attribute__((ext_vector_type(4)));
typedef unsigned v2u __attribute__((ext_vector_type(2)));
typedef float f32x4 __attribute__((ext_vector_type(4)));
typedef short bf16x8 __attribute__((ext_vector_type(8)));

__device__ __forceinline__ unsigned f2bf(float f) { unsigned u = __builtin_bit_cast(unsigned, f); return (u + 0x7fffu + ((u >> 16) & 1u)) >> 16; }
__device__ __forceinline__ unsigned pk2(float lo, float hi) { return f2bf(lo) | (f2bf(hi) << 16); }
__device__ __forceinline__ float bf2f(unsigned short v) { return __uint_as_float((unsigned)v << 16); }
__device__ __forceinline__ float bflo(unsigned w) { return __uint_as_float(w << 16); }
__device__ __forceinline__ float bfhi(unsigned w) { return __uint_as_float(w & 0xffff0000u); }
__device__ __forceinline__ void unpack8(const v4u w, float (&x)[8]) { x[0] = bflo(w.x); x[1] = bfhi(w.x); x[2] = bflo(w.y); x[3] = bfhi(w.y); x[4] = bflo(w.z); x[5] = bfhi(w.z); x[6] = bflo(w.w); x[7] = bfhi(w.w); }
__device__ __forceinline__ v4u pack8(const float (&x)[8]) { v4u w; w.x = pk2(x[0], x[1]); w.y = pk2(x[2], x[3]); w.z = pk2(x[4], x[5]); w.w = pk2(x[6], x[7]); return w; }
__device__ __forceinline__ float wave_sum(float v) {
#pragma unroll
    for (int o = 1; o < 64; o <<= 1) v += __shfl_xor(v, o);
    return v;
}
__device__ __forceinline__ float sigmoidf_(float x) { return 1.f / (1.f + __expf(-x)); }
__device__ __forceinline__ float siluf_(float x) { return x / (1.f + __expf(-x)); }
__device__ __forceinline__ float logsigmoidf_(float x) { return fminf(x, 0.f) - log1pf(__expf(-fabsf(x))); }
__device__ __forceinline__ void sincos_(float x, float& s, float& c) {
    const float k = rintf(x * 0.63661977236758134f);
    float r = fmaf(-k, 1.5707962512969971f, x); r = fmaf(-k, 7.5497894158615964e-8f, r);
    const float r2 = r * r;
    float sp = fmaf(r2, 2.7557314297e-6f, -1.9841270114e-4f); sp = fmaf(sp, r2, 8.3333337680e-3f); sp = fmaf(sp, r2, -1.6666667163e-1f); sp = fmaf(sp * r2, r, r);
    float cp = fmaf(r2, 2.4801587642e-5f, -1.3888889225e-3f); cp = fmaf(cp, r2, 4.1666667908e-2f); cp = fmaf(cp, r2, -0.5f); cp = fmaf(cp, r2, 1.0f);
    const int q = (int)k & 3;
    const float ss = (q & 1) ? cp : sp, cc = (q & 1) ? sp : cp;
    s = (q & 2) ? -ss : ss; c = ((q + 1) & 2) ? -cc : cc;
}

#define XB_TMO      128
#define XB_XCNT(j)  (256  + 64 * (j))
#define XB_XSUB(j)  (1280 + 64 * (j))
#define XB_XGEN(j)  (2304 + 64 * (j))
#define XB_TOP      3328
#define XB_TOPGEN   3392
#define XCD_BAR_WORDS 3456
#define XB_SPIN_CAP (1u << 18)

__device__ __forceinline__ unsigned xb_ld(unsigned* p)              { return __hip_atomic_load(p, __ATOMIC_RELAXED, __HIP_MEMORY_SCOPE_AGENT); }
__device__ __forceinline__ unsigned xb_add(unsigned* p, unsigned v) { return __hip_atomic_fetch_add(p, v, __ATOMIC_RELAXED, __HIP_MEMORY_SCOPE_AGENT); }
__device__ __forceinline__ unsigned xb_xcc_id() { return (unsigned)__builtin_amdgcn_s_getreg((3 << 11) | 20) & 0xFu; }
#define XB_SPIN(cond, bar) do { unsigned _sp = 0; while (cond) { __builtin_amdgcn_s_sleep(1); \
    if ((++_sp & 255u) == 0u) { if (xb_ld(&(bar)[XB_TMO])) break; if (_sp > XB_SPIN_CAP) { atomicAdd(&(bar)[XB_TMO], 1u); break; } } } } while (0)

struct XcdBarrier {
    unsigned* bar; unsigned x;
    volatile LAS unsigned* st;
};

__device__ __forceinline__ XcdBarrier xcd_barrier_post(unsigned* bar, volatile LAS unsigned* st) {
    XcdBarrier b; b.bar = bar; b.x = xb_xcc_id(); b.st = st;
    if (threadIdx.x == 0) (void)xb_add(&bar[XB_XCNT(b.x)], 1u);
    return b;
}
__device__ __forceinline__ void xcd_barrier_complete(unsigned* bar, unsigned x, unsigned& nloc, unsigned& nx) {
    const unsigned G = gridDim.x * gridDim.y * gridDim.z;
    unsigned sum, cnt, mine, sp = 0u;
    for (;;) {
        sum = 0u; cnt = 0u; mine = 0u;
#pragma unroll
        for (unsigned j = 0; j < 16; ++j) { const unsigned c = xb_ld(&bar[XB_XCNT(j)]); sum += c; cnt += (c > 0u) ? 1u : 0u; mine = (j == x) ? c : mine; }
        if (sum == G) break;
        __builtin_amdgcn_s_sleep(1);
        if ((++sp & 255u) == 0u) { if (xb_ld(&bar[XB_TMO])) break; if (sp > XB_SPIN_CAP) { atomicAdd(&bar[XB_TMO], 1u); break; } }
    }
    nloc = mine > 0u ? mine : 1u; nx = cnt > 0u ? cnt : 1u;
}

__device__ __forceinline__ void xcd_barrier(const XcdBarrier& b) {
    asm volatile("s_waitcnt vmcnt(0)" ::: "memory");
    __syncthreads();
    if (threadIdx.x == 0) {
        unsigned* bar = b.bar;
        __builtin_amdgcn_s_waitcnt(0);
        unsigned nloc = b.st[0], nx = b.st[1];
        if (nloc == 0u) { xcd_barrier_complete(bar, b.x, nloc, nx); b.st[0] = nloc; b.st[1] = nx; }
        const unsigned old = xb_add(&bar[XB_XSUB(b.x)], 1u);
        const unsigned gen = old / nloc;
        if (old + 1u == (gen + 1u) * nloc) {
            __builtin_amdgcn_fence(__ATOMIC_RELEASE, "agent");
            asm volatile("s_waitcnt vmcnt(0)" ::: "memory");
            const unsigned og = xb_add(&bar[XB_TOP], 1u);
            const unsigned tg = og / nx;
            if (og + 1u == (tg + 1u) * nx) xb_add(&bar[XB_TOPGEN], 1u);
            else XB_SPIN(xb_ld(&bar[XB_TOPGEN]) == tg, bar);
            __builtin_amdgcn_fence(__ATOMIC_ACQUIRE, "agent");
            xb_add(&bar[XB_XGEN(b.x)], 1u);
            asm volatile("s_waitcnt vmcnt(0)" ::: "memory");
        } else {
            XB_SPIN(xb_ld(&bar[XB_XGEN(b.x)]) == gen, bar);
            __builtin_amdgcn_fence(__ATOMIC_ACQUIRE, "agent");
            asm volatile("s_waitcnt vmcnt(0)" ::: "memory");
        }
    }
    __syncthreads();
}

struct Args { const float* in[20]; float* out; unsigned char* ws; int ph_lo, ph_hi; };
__device__ __forceinline__ int tid_() { int t = threadIdx.x; asm volatile("" : "+v"(t)); return t; }
__device__ __forceinline__ const float* argp(int i) {
    const __attribute__((address_space(4))) char* ka = (const __attribute__((address_space(4))) char*)__builtin_amdgcn_kernarg_segment_ptr();
    int off = i * 8; asm volatile("" : "+s"(off));
    return *(const float* const __attribute__((address_space(4)))*)(ka + off);
}
struct Frame {
    LAS unsigned char* lds;
    int tid, lane, wave, G;
    float* out; unsigned char* ws;
    __device__ __forceinline__ void ids() { tid = tid_(); lane = tid & 63; wave = __builtin_amdgcn_readfirstlane(tid >> 6); }
};
enum { I_X = 0, I_C, I_CTX, I_CCTX, I_NG, I_WADA, I_BADA, I_LB, I_WINE, I_WA2, I_BA2, I_AG, I_BG, I_WOE, I_WINO, I_QG, I_KG, I_LQK, I_CG, I_WOO };

__device__ __forceinline__ void p0_transpose_item(const float* W, int N, int k0, int n0, bf16* WT, int drow0, LAS float* scr, int lane) {
#pragma unroll 8
    for (int i = 0; i < 32; ++i) { const int kk = 2 * i + (lane >> 5); scr[kk * 33 + (lane & 31)] = W[(size_t)(k0 + kk) * N + n0 + (lane & 31)]; }
    asm volatile("s_waitcnt lgkmcnt(0)" ::: "memory");
    const int c = lane & 7;
#pragma unroll
    for (int j = 0; j < 4; ++j) { const int n = (lane >> 3) + 8 * j; const LAS float* s = scr + (8 * c) * 33 + n;
        v4u o; o.x = pk2(s[0 * 33], s[1 * 33]); o.y = pk2(s[2 * 33], s[3 * 33]); o.z = pk2(s[4 * 33], s[5 * 33]); o.w = pk2(s[6 * 33], s[7 * 33]);
        *(GAS v4u*)(WT + (size_t)(drow0 + n) * 2048 + k0 + 8 * c) = o; }
    asm volatile("s_waitcnt lgkmcnt(0)" ::: "memory");
}
__device__ __forceinline__ void p0_prologue(Frame& F) {
    if (blockIdx.x < 192) {
        const int l = blockIdx.x / 96, n0 = (blockIdx.x % 96) * 64;
        LAS float* sc = (LAS float*)F.lds;
        LAS float* red = (LAS float*)(F.lds + 9 * 2048 * 4);
        const float* cin_ = argp(I_C); const float* ccx_ = argp(I_CCTX); const float* bada_ = argp(I_BADA);
        for (int i = F.tid; i < 9 * 2048; i += 512) { const int r = i >> 11, k = i & 2047; const float c = (r < 8) ? cin_[r * 2048 + k] : ccx_[k]; sc[i] = siluf_(c); }
        __syncthreads();
        const float* w = argp(I_WADA) + (size_t)l * 2048 * 6144 + n0 + F.lane;
        float acc[9];
#pragma unroll
        for (int r = 0; r < 9; ++r) acc[r] = 0.f;
        const int kb = F.wave * 256;
#pragma unroll 2
        for (int k = 0; k < 256; k += 4) {
            float wv[4];
#pragma unroll
            for (int i = 0; i < 4; ++i) wv[i] = w[(size_t)(kb + k + i) * 6144];
#pragma unroll
            for (int r = 0; r < 9; ++r) { const f32x4 s = *(const LAS f32x4*)(sc + r * 2048 + kb + k); acc[r] += s[0] * wv[0] + s[1] * wv[1] + s[2] * wv[2] + s[3] * wv[3]; }
        }
#pragma unroll
        for (int r = 0; r < 9; ++r) red[(F.wave * 9 + r) * 64 + F.lane] = acc[r];
        __syncthreads();
        for (int t = F.tid; t < 576; t += 512) { const int r = t >> 6, c = t & 63; float s = 0.f;
#pragma unroll
            for (int wv = 0; wv < 8; ++wv) s += red[(wv * 9 + r) * 64 + c];
            ((float*)(F.ws + WS_MOD))[(size_t)(l * 9 + r) * 6144 + n0 + c] = s + bada_[l * 6144 + n0 + c]; }
        __syncthreads();
    }
    LAS float* scr = (LAS float*)(F.lds + F.wave * 16384);
    const int gw = blockIdx.x * NWAVES + F.wave, NGW = F.G * NWAVES;
    const float* wine_ = argp(I_WINE); const float* woe_ = argp(I_WOE); const float* wino_ = argp(I_WINO); const float* woo_ = argp(I_WOO);
    constexpr int I_E = 32 * 257, I_S = 32 * 64, I_O = 32 * 256;
    for (int it = gw; it < I_E + I_S + I_O + I_S; it += NGW) {
        int r = it;
        if (r < I_E) { const int kb = r / 257, nb = r % 257;
            if (nb < 192) p0_transpose_item(wine_, NE_SRC, 64 * kb, 32 * nb, (bf16*)(F.ws + WS_WIE), 32 * nb, scr, F.lane);
            else if (nb == 192) p0_transpose_item(wine_, NE_SRC, 64 * kb, 32 * nb, (bf16*)(F.ws + WS_WZ), 0, scr, F.lane);
            else p0_transpose_item(wine_, NE_SRC, 64 * kb, 32 * nb, (bf16*)(F.ws + WS_WIE), 32 * nb - 32, scr, F.lane);
            continue; }
        r -= I_E;
        if (r < I_S) { p0_transpose_item(woe_, 2048, 64 * (r / 64), 32 * (r % 64), (bf16*)(F.ws + WS_WOE), 32 * (r % 64), scr, F.lane); continue; }
        r -= I_S;
        if (r < I_O) { p0_transpose_item(wino_, 8192, 64 * (r / 256), 32 * (r % 256), (bf16*)(F.ws + WS_WIO), 32 * (r % 256), scr, F.lane); continue; }
        r -= I_O;
        p0_transpose_item(woo_, 2048, 64 * (r / 64), 32 * (r % 64), (bf16*)(F.ws + WS_WOO), 32 * (r % 64), scr, F.lane);
    }
}

__device__ __forceinline__ void modulate_phase(Frame& F, int l, const float* xsrc, const float* csrc) {
    const int gw = blockIdx.x * NWAVES + F.wave, NGW = F.G * NWAVES;
    const float* gain = argp(I_NG) + l * 2048;
    bf16* H = (bf16*)(F.ws + WS_H);
    for (int m = gw; m < MROWS; m += NGW) {
        const int b = m / LTOK, t = m - b * LTOK;
        const float* src = (t < NCTX) ? csrc + ((size_t)b * NCTX + t) * DM : xsrc + ((size_t)b * SEQ + (t - NCTX)) * DM;
        const float* mod = (const float*)(F.ws + WS_MOD) + (size_t)(l * 9 + ((t < NCTX) ? 8 : b)) * 6144;
        f32x4 v[8]; float ss = 0.f;
#pragma unroll
        for (int j = 0; j < 8; ++j) { v[j] = *(const f32x4*)(src + (F.lane + 64 * j) * 4); ss += (v[j].x * v[j].x + v[j].y * v[j].y) + (v[j].z * v[j].z + v[j].w * v[j].w); }
        const float rstd = rsqrtf(wave_sum(ss) * (1.f / DM) + EPS);
#pragma unroll
        for (int j = 0; j < 8; ++j) { const int col = (F.lane + 64 * j) * 4;
            const f32x4 g = *(const f32x4*)(gain + col), sh = *(const f32x4*)(mod + col), sl = *(const f32x4*)(mod + 2048 + col);
            const f32x4 y = (v[j] * rstd) * g * (sl + 1.f) + sh;
            v2u o; o.x = pk2(y.x, y.y); o.y = pk2(y.z, y.w);
            *(v2u*)(H + (size_t)m * DM + col) = o; }
    }
}

__device__ __forceinline__ void zgemm_phase(Frame& F) {
    const int gw = blockIdx.x * NWAVES + F.wave, NGW = F.G * NWAVES;
    const bf16* H = (const bf16*)(F.ws + WS_H); const bf16* WZ = (const bf16*)(F.ws + WS_WZ); float* Z = (float*)(F.ws + WS_Z);
    const int fr = F.lane & 15, fq = F.lane >> 4;
    for (int u = gw; u < MROWS / 16; u += NGW) {
        const bf16* ap = H + (size_t)(u * 16 + fr) * DM + 8 * fq; const bf16* b0p = WZ + (size_t)fr * DM + 8 * fq; const bf16* b1p = WZ + (size_t)(16 + fr) * DM + 8 * fq;
        f32x4 a0 = {0.f, 0.f, 0.f, 0.f}, a1 = {0.f, 0.f, 0.f, 0.f};
#pragma unroll 4
        for (int k0 = 0; k0 < DM; k0 += 32) {
            const bf16x8 a = *(const bf16x8*)(ap + k0), b0 = *(const bf16x8*)(b0p + k0), b1 = *(const bf16x8*)(b1p + k0);
            a0 = __builtin_amdgcn_mfma_f32_16x16x32_bf16(a, b0, a0, 0, 0, 0); a1 = __builtin_amdgcn_mfma_f32_16x16x32_bf16(a, b1, a1, 0, 0, 0);
        }
#pragma unroll
        for (int i = 0; i < 4; ++i) { float* zr = Z + (size_t)(u * 16 + fq * 4 + i) * 32; zr[fr] = a0[i]; zr[16 + fr] = a1[i]; }
    }
}

__device__ __forceinline__ void scan_phase_v1(Frame& F, bf16* OF, bf16* OB) {
    const bf16* P = (const bf16*)(F.ws + WS_P); const float* Z = (const float*)(F.ws + WS_Z);
    LAS float* qs = (LAS float*)(F.lds + F.wave * 12800); LAS float* ks = qs + 1024; LAS float* as = qs + 2048; LAS float* vs = qs + 3072;
    const int gw = blockIdx.x * NWAVES + F.wave, NGW = F.G * NWAVES;
    const int c = F.lane & 15, dq = F.lane >> 4;
    const int ps = F.lane >> 4, pd0 = (F.lane & 15) * 8;
    const float* lbp_ = argp(I_LB); const float* ba2p_ = argp(I_BA2); const float* wa2p_ = argp(I_WA2);
    for (int u = gw; u < 2048; u += NGW) {
        const bool isA = u < 1024; const int uu = isA ? u : u - 1024;
        int b, h, dir, slice;
        if (isA) { const int seq = uu >> 3; slice = uu & 7; b = seq >> 4; h = (seq >> 1) & 7; dir = seq & 1; }
        else { const int seq = uu >> 4; slice = uu & 15; b = seq >> 3; h = (seq >> 1) & 3; dir = seq & 1; }
        const int qcol = isA ? EC_AQ + h * 128 : EC_BQ + h * 128;
        const int kcol = isA ? (dir ? EC_AFB : EC_AFF) + h * 128 : EC_BK + h * 128;
        const int vcol = isA ? EC_AI + h * 128 + slice * 16 + c : EC_BV + h * 256 + slice * 16 + c;
        const int ocol = isA ? h * 128 + slice * 16 + c : 1024 + h * 256 + slice * 16 + c;
        bf16* OUT = dir ? OB : OF;
        float lbv[8];
        if (isA) {
#pragma unroll
            for (int e = 0; e < 8; ++e) { const int cc = h * 128 + pd0 + e; const float l0 = lbp_[cc], l1 = lbp_[1024 + cc], l2 = lbp_[2048 + cc];
                const float mx = fmaxf(l0, fmaxf(l1, l2)); const float e0 = __expf(l0 - mx), e1 = __expf(l1 - mx), e2 = __expf(l2 - mx); lbv[e] = e0 / (e0 + e1 + e2); }
        } else {
#pragma unroll
            for (int e = 0; e < 8; ++e) lbv[e] = ba2p_[dir * 512 + h * 128 + pd0 + e];
        }
        const float* wa2 = wa2p_ + (size_t)dir * 16 * 512 + h * 128 + pd0;
        float S[32];
#pragma unroll
        for (int i = 0; i < 32; ++i) S[i] = 0.f;
        const size_t rowb = (size_t)b * LTOK;
        for (int ch = 0; ch < LTOK / 8; ++ch) {
            const int i0 = ch * 8;
            int tbase, tstep;
            if (!dir) { tbase = i0; tstep = 1; } else { tbase = (i0 < NCTX) ? (NCTX - 1 - i0) : (LTOK - 1 - (i0 - NCTX)); tstep = -1; }
#pragma unroll
            for (int k2 = 0; k2 < 2; ++k2) { const int idx = F.lane + 64 * k2, s = idx >> 4, cc = idx & 15; vs[idx] = bf2f(P[(rowb + tbase + tstep * s) * NP + vcol - c + cc]); }
#pragma unroll
            for (int half = 0; half < 2; ++half) {
                const int s = ps + 4 * half; const size_t row = rowb + tbase + tstep * s;
                float q8[8], k8[8], a8[8];
                { const v4u w = *(const v4u*)(P + row * NP + qcol + pd0); unpack8(w, q8); }
                { const v4u w = *(const v4u*)(P + row * NP + kcol + pd0); unpack8(w, k8); }
                if (isA) {
#pragma unroll
                    for (int e = 0; e < 8; ++e) { q8[e] = siluf_(q8[e]); const float f = lbv[e] + (1.f - lbv[e]) * sigmoidf_(k8[e]); a8[e] = f; k8[e] = 1.f - f; }
                } else {
                    float ar[8];
#pragma unroll
                    for (int e = 0; e < 8; ++e) ar[e] = lbv[e];
#pragma unroll 2
                    for (int r = 0; r < 16; ++r) { const float zr = Z[row * 32 + dir * 16 + r]; const f32x4 w0 = *(const f32x4*)(wa2 + r * 512), w1 = *(const f32x4*)(wa2 + r * 512 + 4);
                        ar[0] = fmaf(zr, w0[0], ar[0]); ar[1] = fmaf(zr, w0[1], ar[1]); ar[2] = fmaf(zr, w0[2], ar[2]); ar[3] = fmaf(zr, w0[3], ar[3]);
                        ar[4] = fmaf(zr, w1[0], ar[4]); ar[5] = fmaf(zr, w1[1], ar[5]); ar[6] = fmaf(zr, w1[2], ar[6]); ar[7] = fmaf(zr, w1[3], ar[7]); }
#pragma unroll
                    for (int e = 0; e < 8; ++e) { a8[e] = __expf(logsigmoidf_(ar[e]) * (1.f / 16.f)); q8[e] *= 0.088388347648318440f; }
                }
                *(LAS f32x4*)(qs + s * 128 + pd0) = (f32x4){q8[0], q8[1], q8[2], q8[3]}; *(LAS f32x4*)(qs + s * 128 + pd0 + 4) = (f32x4){q8[4], q8[5], q8[6], q8[7]};
                *(LAS f32x4*)(ks + s * 128 + pd0) = (f32x4){k8[0], k8[1], k8[2], k8[3]}; *(LAS f32x4*)(ks + s * 128 + pd0 + 4) = (f32x4){k8[4], k8[5], k8[6], k8[7]};
                *(LAS f32x4*)(as + s * 128 + pd0) = (f32x4){a8[0], a8[1], a8[2], a8[3]}; *(LAS f32x4*)(as + s * 128 + pd0 + 4) = (f32x4){a8[4], a8[5], a8[6], a8[7]};
            }
            asm volatile("s_waitcnt lgkmcnt(0)" ::: "memory");
#pragma unroll 1
            for (int s = 0; s < 8; ++s) {
                float o = 0.f; const float v = vs[s * 16 + c];
#pragma unroll
                for (int i4 = 0; i4 < 8; ++i4) {
                    const f32x4 q4 = *(const LAS f32x4*)(qs + s * 128 + dq * 32 + i4 * 4), k4 = *(const LAS f32x4*)(ks + s * 128 + dq * 32 + i4 * 4), a4 = *(const LAS f32x4*)(as + s * 128 + dq * 32 + i4 * 4);
#pragma unroll
                    for (int e = 0; e < 4; ++e) { const float sn = fmaf(a4[e], S[i4 * 4 + e], k4[e] * v); S[i4 * 4 + e] = sn; o = fmaf(q4[e], sn, o); }
                }
                o += __shfl_xor(o, 16); o += __shfl_xor(o, 32);
                if (dq == 0) OUT[(rowb + tbase + tstep * s) * DM + ocol] = (bf16)f2bf(o);
            }
            asm volatile("s_waitcnt lgkmcnt(0)" ::: "memory");
        }
    }
}

namespace sc2 {
constexpr int QD_OFF = 0, KI_OFF = 8704, KT_OFF = 17408, VT_OFF = 25600, DEC_OFF = 33792, BUF_BYTES = 34816, W_OFF = 2 * BUF_BYTES, C_OFF = W_OFF + 8192;
constexpr int ROWB = 272;
typedef float f32x16 __attribute__((ext_vector_type(16)));
typedef short s16x4 __attribute__((ext_vector_type(4)));
__device__ __forceinline__ int crow(int r, int hi) { return (r & 3) + 8 * (r >> 2) + 4 * hi; }
template <int OFF> __device__ __forceinline__ s16x4 tr_read(unsigned a) { s16x4 r; asm volatile("ds_read_b64_tr_b16 %0, %1 offset:%2" : "=&v"(r) : "v"(a), "i"(OFF) : "memory"); return r; }
struct Raw { v4u q, k, v; f32x4 z0, z1, z2, z3; };
}
__device__ __forceinline__ void scan_phase_v2(Frame& F, bf16* OF, bf16* OB) {
    using namespace sc2;
    const bf16* P = (const bf16*)(F.ws + WS_P); const float* Z = (const float*)(F.ws + WS_Z);
    const int lane = F.lane, wave = F.wave;
    const int r = lane & 31, h = lane >> 5;
    const float* lbp_ = argp(I_LB); const float* ba2p_ = argp(I_BA2); const float* wa2p_ = argp(I_WA2);
    for (int u = blockIdx.x; u < 256; u += F.G) {
        const bool isA = u < 128; const int uu = isA ? u : u - 128;
        int b, hd, dir, vh;
        if (isA) { b = uu >> 4; hd = (uu >> 1) & 7; dir = uu & 1; vh = 0; } else { b = uu >> 4; hd = (uu >> 2) & 3; dir = (uu >> 1) & 1; vh = uu & 1; }
        const int qcol = isA ? EC_AQ + hd * 128 : EC_BQ + hd * 128;
        const int kcol = isA ? (dir ? EC_AFB : EC_AFF) + hd * 128 : EC_BK + hd * 128;
        const int vcol = isA ? EC_AI + hd * 128 : EC_BV + hd * 256 + vh * 128;
        const int ocol = isA ? hd * 128 : 1024 + hd * 256 + vh * 128;
        bf16* OUT = dir ? OB : OF;
        const size_t rowb = (size_t)b * LTOK;
        if (!isA) {
            LAS float* wl = (LAS float*)(F.lds + W_OFF);
            for (int i = F.tid; i < 2048; i += 512) wl[i] = wa2p_[(size_t)dir * 16 * 512 + (i >> 7) * 512 + hd * 128 + (i & 127)];
        }
        {
            LAS float* cl = (LAS float*)(F.lds + C_OFF);
            const int t_ = F.tid;
            if (t_ < 128) { const int cc = hd * 128 + t_; float cv;
                if (isA) { const float l0 = lbp_[cc], l1 = lbp_[1024 + cc], l2 = lbp_[2048 + cc]; const float mx = fmaxf(l0, fmaxf(l1, l2));
                    const float e0 = __expf(l0 - mx), e1 = __expf(l1 - mx), e2 = __expf(l2 - mx); cv = e0 / (e0 + e1 + e2); }
                else cv = ba2p_[dir * 512 + cc];
                cl[t_] = cv; }
        }
        __syncthreads();
#define SC2_TOK(ch, tb, ts) do { const int i0_ = (ch) * 32; if (!dir) { tb = i0_; ts = 1; } else { tb = (i0_ < NCTX) ? (NCTX - 1 - i0_) : (LTOK - 1 - (i0_ - NCTX)); ts = -1; } } while (0)
        if (wave >= 4) {
            const int pw = wave - 4;
            Raw cur[2];
#define SC2_LOAD(dst, ch) do { int tb_, ts_; SC2_TOK(ch, tb_, ts_); const size_t row_ = rowb + tb_ + ts_ * r; \
                _Pragma("unroll") for (int ps = 0; ps < 2; ++ps) { const int d0 = (pw * 4 + ps * 2 + h) * 8; \
                    dst[ps].q = *(const v4u*)(P + row_ * NP + qcol + d0); dst[ps].k = *(const v4u*)(P + row_ * NP + kcol + d0); dst[ps].v = *(const v4u*)(P + row_ * NP + vcol + d0); } \
                if (!isA) { const f32x4* zp_ = (const f32x4*)(Z + row_ * 32 + dir * 16); dst[0].z0 = zp_[0]; dst[0].z1 = zp_[1]; dst[0].z2 = zp_[2]; dst[0].z3 = zp_[3]; } } while (0)
#define SC2_FILL(src, bi) do { LAS unsigned char* bb_ = F.lds + (bi) * BUF_BYTES; \
                _Pragma("unroll") for (int ps = 0; ps < 2; ++ps) { const int dg = pw * 4 + ps * 2 + h, d0 = dg * 8; \
                    float q8[8], k8[8], la[8]; unpack8(src[ps].q, q8); unpack8(src[ps].k, k8); \
                    float cst_[8]; { const f32x4 c0_ = *(const LAS f32x4*)(F.lds + C_OFF + d0 * 4), c1_ = *(const LAS f32x4*)(F.lds + C_OFF + d0 * 4 + 16); cst_[0] = c0_[0]; cst_[1] = c0_[1]; cst_[2] = c0_[2]; cst_[3] = c0_[3]; cst_[4] = c1_[0]; cst_[5] = c1_[1]; cst_[6] = c1_[2]; cst_[7] = c1_[3]; } \
                    if (isA) { _Pragma("unroll") for (int e = 0; e < 8; ++e) { const float lbv = cst_[e]; const float sg = __builtin_amdgcn_rcpf(1.f + __expf(-k8[e])); const float f = fmaf(1.f - lbv, sg, lbv); \
                            la[e] = __logf(f); k8[e] = 1.f - f; q8[e] = q8[e] * __builtin_amdgcn_rcpf(1.f + __expf(-q8[e])); } } \
                    else { float ar[8]; _Pragma("unroll") for (int e = 0; e < 8; ++e) ar[e] = cst_[e]; \
                        const LAS float* wl_ = (const LAS float*)(F.lds + W_OFF) + d0; \
                        const float zz[16] = {src[0].z0[0], src[0].z0[1], src[0].z0[2], src[0].z0[3], src[0].z1[0], src[0].z1[1], src[0].z1[2], src[0].z1[3], src[0].z2[0], src[0].z2[1], src[0].z2[2], src[0].z2[3], src[0].z3[0], src[0].z3[1], src[0].z3[2], src[0].z3[3]}; \
                        _Pragma("unroll") for (int rr = 0; rr < 16; ++rr) { const f32x4 w0 = *(const LAS f32x4*)(wl_ + rr * 128), w1 = *(const LAS f32x4*)(wl_ + rr * 128 + 4); \
                            ar[0] = fmaf(zz[rr], w0[0], ar[0]); ar[1] = fmaf(zz[rr], w0[1], ar[1]); ar[2] = fmaf(zz[rr], w0[2], ar[2]); ar[3] = fmaf(zz[rr], w0[3], ar[3]); \
                            ar[4] = fmaf(zz[rr], w1[0], ar[4]); ar[5] = fmaf(zz[rr], w1[1], ar[5]); ar[6] = fmaf(zz[rr], w1[2], ar[6]); ar[7] = fmaf(zz[rr], w1[3], ar[7]); } \
                        _Pragma("unroll") for (int e = 0; e < 8; ++e) { la[e] = (fminf(ar[e], 0.f) - __logf(1.f + __expf(-fabsf(ar[e])))) * (1.f / 16.f); q8[e] *= 0.088388347648318440f; } } \
                      \
                    _Pragma("unroll") for (int off = 1; off < 32; off <<= 1) { _Pragma("unroll") for (int e = 0; e < 8; ++e) { const float t_ = __shfl_up(la[e], off, 32); if (r >= off) la[e] += t_; } } \
                    float qd[8], ki[8], kt[8]; \
                    _Pragma("unroll") for (int e = 0; e < 8; ++e) { const float bl = __shfl(la[e], 31, 32); const float eb = __expf(la[e]); qd[e] = q8[e] * eb; ki[e] = k8[e] * __expf(-la[e]); kt[e] = k8[e] * __expf(bl - la[e]); \
                        if (r == 31) *(LAS float*)(bb_ + DEC_OFF + (d0 + e) * 4) = eb; } \
                    *(LAS v4u*)(bb_ + QD_OFF + r * ROWB + d0 * 2) = pack8(qd); *(LAS v4u*)(bb_ + KI_OFF + r * ROWB + d0 * 2) = pack8(ki); \
                    *(LAS v4u*)(bb_ + KT_OFF + (dg >> 2) * 2048 + r * 64 + (dg & 3) * 16) = pack8(kt); \
                    *(LAS v4u*)(bb_ + VT_OFF + (dg >> 2) * 2048 + r * 64 + (dg & 3) * 16) = src[ps].v; __builtin_amdgcn_sched_barrier(0); } } while (0)
            SC2_LOAD(cur, 0);
            SC2_FILL(cur, 0);
            SC2_LOAD(cur, 1);
            __syncthreads();
            for (int ch = 0; ch < LTOK / 32; ++ch) {
                if (ch + 1 < LTOK / 32) {
                    SC2_FILL(cur, (ch + 1) & 1);
                    if (ch + 2 < LTOK / 32) SC2_LOAD(cur, ch + 2);
                }
                __syncthreads();
            }
#undef SC2_LOAD
#undef SC2_FILL
        } else {
            const int cw = wave;
            f32x16 S[4];
#pragma unroll
            for (int dt = 0; dt < 4; ++dt) S[dt] = (f32x16){};
            const int q4 = (lane & 15) >> 2, p4 = lane & 3, blk = (lane >> 4) & 1;
            const unsigned trl = (unsigned)(q4 * 64 + (16 * blk + 4 * p4) * 2);
            __syncthreads();
            for (int ch = 0; ch < LTOK / 32; ++ch) {
                LAS unsigned char* bb = F.lds + (ch & 1) * BUF_BYTES;
                const unsigned bba = (unsigned)(size_t)bb;
                f32x16 X = (f32x16){};
#pragma unroll
                for (int kk = 0; kk < 8; ++kk) {
                    const bf16x8 a = *(const LAS bf16x8*)(bb + KI_OFF + r * ROWB + (16 * kk + 8 * h) * 2), bq = *(const LAS bf16x8*)(bb + QD_OFF + r * ROWB + (16 * kk + 8 * h) * 2);
                    X = __builtin_amdgcn_mfma_f32_32x32x16_bf16(a, bq, X, 0, 0, 0);
                }
#pragma unroll
                for (int g = 0; g < 16; ++g) X[g] = (r >= crow(g, h)) ? X[g] : 0.f;
                v4u xa0, xa1;
                xa0.x = pg8::cvt_pk_bf16(X[0], X[1]); xa0.y = pg8::cvt_pk_bf16(X[2], X[3]); xa0.z = pg8::cvt_pk_bf16(X[4], X[5]); xa0.w = pg8::cvt_pk_bf16(X[6], X[7]);
                xa1.x = pg8::cvt_pk_bf16(X[8], X[9]); xa1.y = pg8::cvt_pk_bf16(X[10], X[11]); xa1.z = pg8::cvt_pk_bf16(X[12], X[13]); xa1.w = pg8::cvt_pk_bf16(X[14], X[15]);
                const unsigned vta = bba + VT_OFF + cw * 2048 + trl;
                s16x4 vp00 = tr_read<0>(vta + (4 * h) * 64), vp01 = tr_read<0>(vta + (8 + 4 * h) * 64), vp10 = tr_read<0>(vta + (16 + 4 * h) * 64), vp11 = tr_read<0>(vta + (24 + 4 * h) * 64);
                s16x4 vn00 = tr_read<0>(vta + (8 * h) * 64), vn01 = tr_read<0>(vta + (8 * h + 4) * 64), vn10 = tr_read<0>(vta + (16 + 8 * h) * 64), vn11 = tr_read<0>(vta + (16 + 8 * h + 4) * 64);
                asm volatile("s_waitcnt lgkmcnt(0)" ::: "memory"); __builtin_amdgcn_sched_barrier(0);
#define SC2_PK(L, H) (bf16x8){L[0], L[1], L[2], L[3], H[0], H[1], H[2], H[3]}
                f32x16 o = (f32x16){};
                o = __builtin_amdgcn_mfma_f32_32x32x16_bf16(__builtin_bit_cast(bf16x8, xa0), SC2_PK(vp00, vp01), o, 0, 0, 0);
                o = __builtin_amdgcn_mfma_f32_32x32x16_bf16(__builtin_bit_cast(bf16x8, xa1), SC2_PK(vp10, vp11), o, 0, 0, 0);
#pragma unroll
                for (int dt = 0; dt < 4; ++dt)
#pragma unroll
                    for (int ks = 0; ks < 2; ++ks) {
                        const LAS unsigned char* qp = bb + QD_OFF + r * ROWB + (32 * dt + 16 * ks + 4 * h) * 2;
                        const s16x4 a0 = *(const LAS s16x4*)qp, a1 = *(const LAS s16x4*)(qp + 16);
                        v4u sb; sb.x = pg8::cvt_pk_bf16(S[dt][8 * ks + 0], S[dt][8 * ks + 1]); sb.y = pg8::cvt_pk_bf16(S[dt][8 * ks + 2], S[dt][8 * ks + 3]);
                        sb.z = pg8::cvt_pk_bf16(S[dt][8 * ks + 4], S[dt][8 * ks + 5]); sb.w = pg8::cvt_pk_bf16(S[dt][8 * ks + 6], S[dt][8 * ks + 7]);
                        o = __builtin_amdgcn_mfma_f32_32x32x16_bf16(SC2_PK(a0, a1), __builtin_bit_cast(bf16x8, sb), o, 0, 0, 0);
                    }
#pragma unroll
                for (int dt = 0; dt < 4; ++dt) {
                    const unsigned kta = bba + KT_OFF + dt * 2048 + trl;
                    s16x4 k00 = tr_read<0>(kta + (8 * h) * 64), k01 = tr_read<0>(kta + (8 * h + 4) * 64), k10 = tr_read<0>(kta + (16 + 8 * h) * 64), k11 = tr_read<0>(kta + (16 + 8 * h + 4) * 64);
#pragma unroll
                    for (int g = 0; g < 4; ++g) { const f32x4 dc = *(const LAS f32x4*)(bb + DEC_OFF + (32 * dt + 8 * g + 4 * h) * 4);
                        S[dt][4 * g + 0] *= dc[0]; S[dt][4 * g + 1] *= dc[1]; S[dt][4 * g + 2] *= dc[2]; S[dt][4 * g + 3] *= dc[3]; }
                    asm volatile("s_waitcnt lgkmcnt(0)" ::: "memory"); __builtin_amdgcn_sched_barrier(0);
                    S[dt] = __builtin_amdgcn_mfma_f32_32x32x16_bf16(SC2_PK(k00, k01), SC2_PK(vn00, vn01), S[dt], 0, 0, 0);
                    S[dt] = __builtin_amdgcn_mfma_f32_32x32x16_bf16(SC2_PK(k10, k11), SC2_PK(vn10, vn11), S[dt], 0, 0, 0);
                }
#undef SC2_PK
                int tb, ts; SC2_TOK(ch, tb, ts);
#pragma unroll
                for (int g = 0; g < 16; ++g) { const size_t row = rowb + tb + ts * crow(g, h); OUT[row * DM + ocol + cw * 32 + r] = (bf16)f2bf(o[g]); }
                __syncthreads();
            }
        }
#undef SC2_TOK
        __syncthreads();
    }
}

__device__ __forceinline__ void evengate_phase(Frame& F, const bf16* OF) {
    const int gw = blockIdx.x * NWAVES + F.wave, NGW = F.G * NWAVES;
    bf16* Y = (bf16*)(F.ws + WS_H); const bf16* P = (const bf16*)(F.ws + WS_P);
    const float* agp_ = argp(I_AG); const float* bgp_ = argp(I_BG);
    for (int m = gw; m < MROWS; m += NGW) {
#pragma unroll
        for (int j = 0; j < 4; ++j) {
            const int col = j * 512 + F.lane * 8;
            float a[8], bb[8], g[8];
            unpack8(*(const v4u*)(OF + (size_t)m * DM + col), a); unpack8(*(const v4u*)(Y + (size_t)m * DM + col), bb); unpack8(*(const v4u*)(P + (size_t)m * NP + EC_GATE + col), g);
            float ss = 0.f;
#pragma unroll
            for (int e = 0; e < 8; ++e) { a[e] += bb[e]; ss += a[e] * a[e]; }
            ss += __shfl_xor(ss, 1); ss += __shfl_xor(ss, 2); ss += __shfl_xor(ss, 4); ss += __shfl_xor(ss, 8);
            float rstd; const float* gn;
            if (j < 2) { rstd = rsqrtf(ss * (1.f / 128.f) + EPS); gn = agp_ + (col & 127); }
            else { ss += __shfl_xor(ss, 16); rstd = rsqrtf(ss * (1.f / 256.f) + EPS); gn = bgp_ + (col & 255); }
            float y[8];
#pragma unroll
            for (int e = 0; e < 8; ++e) y[e] = a[e] * rstd * gn[e] * siluf_(g[e]);
            *(v4u*)(Y + (size_t)m * DM + col) = pack8(y);
        }
    }
}

__device__ __forceinline__ void qknorm_rope_phase(Frame& F) {
    const int gw = blockIdx.x * NWAVES + F.wave, NGW = F.G * NWAVES;
    bf16* P = (bf16*)(F.ws + WS_P);
    const int l16 = F.lane & 15;
    float gq[8], gk[8], inv[8];
    const float* qgp_ = argp(I_QG); const float* kgp_ = argp(I_KG);
#pragma unroll
    for (int e = 0; e < 8; ++e) { gq[e] = qgp_[l16 * 8 + e]; gk[e] = kgp_[l16 * 8 + e]; inv[e] = exp2f(-(float)((F.lane & 3) * 8 + e) * (13.287712379549449f / 32.f)); }
    for (int m = gw; m < MROWS; m += NGW) {
        const int b = m / LTOK, t = m - b * LTOK; const bool lat = t >= NCTX; const int pos = t - NCTX;
        const float p = (float)((F.lane & 8) ? (pos & 63) : (pos >> 6));
        float cs[8], sn[8];
#pragma unroll
        for (int e = 0; e < 8; ++e) { if (lat) sincos_(p * inv[e], sn[e], cs[e]); else { sn[e] = 0.f; cs[e] = 1.f; } }
#pragma unroll
        for (int sect = 0; sect < 2; ++sect) {
            if (sect == 0 && !lat) continue;
#pragma unroll
            for (int j = 0; j < 4; ++j) {
                bf16* ptr = P + (size_t)m * NP + sect * 2048 + j * 512 + F.lane * 8;
                float x[8]; unpack8(*(const v4u*)ptr, x);
                float ss = 0.f;
#pragma unroll
                for (int e = 0; e < 8; ++e) ss += x[e] * x[e];
                ss += __shfl_xor(ss, 1); ss += __shfl_xor(ss, 2); ss += __shfl_xor(ss, 4); ss += __shfl_xor(ss, 8);
                const float rstd = rsqrtf(ss * (1.f / 128.f) + EPS);
                float y[8];
#pragma unroll
                for (int e = 0; e < 8; ++e) { x[e] = x[e] * rstd * (sect ? gk[e] : gq[e]); }
#pragma unroll
                for (int e = 0; e < 8; ++e) { const float o = __shfl_xor(x[e], 4); y[e] = (F.lane & 4) ? fmaf(o, sn[e], x[e] * cs[e]) : fmaf(-o, sn[e], x[e] * cs[e]); }
                *(v4u*)ptr = pack8(y);
            }
        }
    }
}

__device__ __forceinline__ void diffcombine_phase(Frame& F) {
    const int gw = blockIdx.x * NWAVES + F.wave, NGW = F.G * NWAVES;
    bf16* O0 = (bf16*)(F.ws + WS_O0); const bf16* O1 = (const bf16*)(F.ws + WS_O1); const bf16* P = (const bf16*)(F.ws + WS_P);
    const float* lq = argp(I_LQK); const float* cgp_ = argp(I_CG);
    const float d01 = wave_sum(lq[F.lane] * lq[128 + F.lane] + lq[64 + F.lane] * lq[192 + F.lane]);
    const float d23 = wave_sum(lq[256 + F.lane] * lq[384 + F.lane] + lq[320 + F.lane] * lq[448 + F.lane]);
    const float lam = expf(d01) - expf(d23) + LAM_INIT1;
    for (int m = gw; m < MLAT; m += NGW) {
        const int b = m / SEQ, s = m - b * SEQ; const size_t prow = (size_t)b * LTOK + NCTX + s;
#pragma unroll
        for (int j = 0; j < 4; ++j) {
            const int col = j * 512 + F.lane * 8;
            float a[8], bb[8], g[8];
            unpack8(*(const v4u*)(O0 + (size_t)m * DM + col), a); unpack8(*(const v4u*)(O1 + (size_t)m * DM + col), bb); unpack8(*(const v4u*)(P + prow * NP + OC_GATE + col), g);
            float ss = 0.f;
#pragma unroll
            for (int e = 0; e < 8; ++e) { a[e] = fmaf(-lam, bb[e], a[e]); ss += a[e] * a[e]; }
            ss += __shfl_xor(ss, 1); ss += __shfl_xor(ss, 2); ss += __shfl_xor(ss, 4); ss += __shfl_xor(ss, 8); ss += __shfl_xor(ss, 16);
            const float rstd = rsqrtf(ss * (1.f / 256.f) + EPS) * (1.f - LAM_INIT1);
            const float* gn = cgp_ + (col & 255);
            float y[8];
#pragma unroll
            for (int e = 0; e < 8; ++e) y[e] = a[e] * rstd * gn[e] * siluf_(g[e]);
            *(v4u*)(O0 + (size_t)m * DM + col) = pack8(y);
        }
    }
}

__device__ __forceinline__ void attn_phase_v1(Frame& F, char* lds) {
    const attn::bf16* P = (const attn::bf16*)(F.ws + WS_P);
    for (int u = blockIdx.x; u < 2048; u += F.G) {
        const int qb = u & 7, e = (u >> 3) & 1, mp = (u >> 4) & 1, h = (u >> 5) & 7, b = u >> 8;
        const attn::bf16* Q = P + ((size_t)b * LTOK + NCTX + qb * 256) * NP + OC_Q + h * 256 + mp * 128;
        const attn::bf16* K = P + ((size_t)b * LTOK) * NP + OC_K + h * 256 + mp * 128;
        const attn::bf16* V = P + ((size_t)b * LTOK) * NP + OC_V + h * 256 + e * 128;
        attn::bf16* O = (attn::bf16*)(F.ws + (mp ? WS_O1 : WS_O0)) + ((size_t)b * SEQ + qb * 256) * DM + h * 256 + e * 128;
        attn::attn_dense_body<attn::bf16>(Q, K, V, O, LTOK, lds);
        __syncthreads();
    }
}

__global__ void __launch_bounds__(NWAVES * 64, 2) mega_fwd(Args args) {
    extern __shared__ __attribute__((aligned(16))) unsigned char lds[];
    Frame F;
    F.lds = (LAS unsigned char*)lds;
    F.ids(); F.G = gridDim.x;
#if MK_ONE_LAUNCH
    for (int u = F.tid; u < (LDS_BYTES - LDSCTL_OFF) / 4; u += NWAVES * 64) ((LAS unsigned*)(F.lds + LDSCTL_OFF))[u] = 0u;
    __syncthreads();
    const XcdBarrier bar = xcd_barrier_post((unsigned*)(args.ws + WS_CTL) + CW_BAR, (volatile LAS unsigned*)(F.lds + MISC_OFF) + 8);
#endif
    F.out = args.out; F.ws = args.ws;
    const int lo = args.ph_lo, hi = args.ph_hi;
#define IN(k) (lo <= (k) && (k) < hi)
#if MK_ONE_LAUNCH
#define SEAM(k) do { if (IN(k) && IN((k) + 1)) { if ((k) == 0) cg::this_grid().sync(); else xcd_barrier(bar); } } while (0)
#else
#define SEAM(k) do { } while (0)
#endif
    unsigned char* ws = args.ws;
    bf16* Hb = (bf16*)(ws + WS_H); bf16* Pb = (bf16*)(ws + WS_P);
    const float* mod0 = (const float*)(ws + WS_MOD); const float* mod1 = mod0 + 9 * 6144;
    float* ctx1 = (float*)(ws + WS_CTX1);

    if (IN(0)) { F.ids(); p0_prologue(F); } SEAM(0);
    if (IN(1)) { F.ids(); modulate_phase(F, 0, argp(I_X), argp(I_CTX)); } SEAM(1);
    if (IN(2)) { F.ids();
        zgemm_phase(F);
        pg8::Gemm g{Hb, (const bf16*)(ws + WS_WIE), MROWS, NP, DM}; pg8::StaticOrder S; S.init(MROWS, NP, F.G, (int)blockIdx.x);
        pg8::EpiStoreBf16 E{Pb, NP};
        pg8::gemm_phase<pg8::EpiStoreBf16, pg8::StaticOrder, true, true>(F.lds, g, S, E);
    } SEAM(2);
    #ifdef SCAN_V1
    if (IN(3)) { F.ids(); scan_phase_v1(F, (bf16*)F.out, Hb); } SEAM(3);
#else
    if (IN(3)) { F.ids(); scan_phase_v2(F, (bf16*)F.out, Hb); } SEAM(3);
#endif
    if (IN(4)) { F.ids(); evengate_phase(F, (const bf16*)F.out); } SEAM(4);
    if (IN(5)) { F.ids();
        pg8::Gemm g{Hb, (const bf16*)(ws + WS_WOE), MROWS, DM, DM}; pg8::StaticOrder S; S.init(MROWS, DM, F.G, (int)blockIdx.x);
        pg8::EpiRes E{argp(I_X), F.out, argp(I_CTX), ctx1, mod0, 9};
        pg8::gemm_phase<pg8::EpiRes, pg8::StaticOrder, true, true>(F.lds, g, S, E);
    } SEAM(5);
    if (IN(6)) { F.ids(); modulate_phase(F, 1, F.out, ctx1); } SEAM(6);
    if (IN(7)) { F.ids();
        pg8::Gemm g{Hb, (const bf16*)(ws + WS_WIO), MROWS, NP, DM}; pg8::StaticOrder S; S.init(MROWS, NP, F.G, (int)blockIdx.x);
        pg8::EpiStoreBf16 E{Pb, NP};
        pg8::gemm_phase<pg8::EpiStoreBf16, pg8::StaticOrder, true, true>(F.lds, g, S, E);
    } SEAM(7);
    if (IN(8)) { F.ids(); qknorm_rope_phase(F); } SEAM(8);
    if (IN(9)) { F.ids(); attn_phase_v1(F, (char*)lds); } SEAM(9);
    if (IN(10)) { F.ids(); diffcombine_phase(F); } SEAM(10);
    if (IN(11)) { F.ids();
        pg8::Gemm g{(const bf16*)(ws + WS_O0), (const bf16*)(ws + WS_WOO), MLAT, DM, DM}; pg8::StaticOrder S; S.init(MLAT, DM, F.G, (int)blockIdx.x);
        pg8::EpiRes E{F.out, F.out, nullptr, nullptr, mod1, 8};
        pg8::gemm_phase<pg8::EpiRes, pg8::StaticOrder, true, true>(F.lds, g, S, E);
    }
#undef IN
#undef SEAM
}
constexpr int N_PHASES = 12;

extern "C" void kernel_launch(void* const* d_in, const int* in_sizes, int n_in, void* d_out, int out_size, void* d_ws, size_t ws_size, hipStream_t stream) {
    static int grid = 0;
    if (grid == 0) {
        if (n_in != 20 || in_sizes[0] != MLAT * DM || out_size != MLAT * DM || ws_size < WS_END) {
            fprintf(stderr, "kernel_launch: unexpected shapes: n_in %d in0 %d out %d ws %zu (need >= %zu)\n", n_in, n_in > 0 ? in_sizes[0] : -1, out_size, ws_size, (size_t)WS_END); grid = -1; return; }
        int dev = 0, cus = 0, per_cu = 0;
        if (hipGetDevice(&dev) != hipSuccess || hipDeviceGetAttribute(&cus, hipDeviceAttributeMultiprocessorCount, dev) != hipSuccess) { grid = -1; return; }
        if (hipFuncSetAttribute((const void*)mega_fwd, hipFuncAttributeMaxDynamicSharedMemorySize, LDS_BYTES) != hipSuccess) { fprintf(stderr, "kernel_launch: hipFuncSetAttribute failed\n"); grid = -1; return; }
        if (hipOccupancyMaxActiveBlocksPerMultiprocessor(&per_cu, (const void*)mega_fwd, NWAVES * 64, LDS_BYTES) != hipSuccess || per_cu < 1) { fprintf(stderr, "kernel_launch: occupancy query says %d blocks per CU\n", per_cu); (void)hipGetLastError(); grid = -1; return; }
        grid = cus;
    }
    if (grid < 0) return;
    Args a{};
    for (int i = 0; i < 20; ++i) a.in[i] = (const float*)d_in[i];
    a.out = (float*)d_out; a.ws = (unsigned char*)d_ws;
#if MK_ONE_LAUNCH
    if (hipMemsetAsync((char*)d_ws + WS_CTL, 0, CTL_ZERO_BYTES, stream) != hipSuccess) { fprintf(stderr, "kernel_launch: hipMemsetAsync failed\n"); return; }
    a.ph_lo = 0; a.ph_hi = N_PHASES;
    void* kargs[] = {&a};
    const hipError_t e = hipLaunchCooperativeKernel((const void*)mega_fwd, dim3(grid), dim3(NWAVES * 64), kargs, LDS_BYTES, stream);
    if (e != hipSuccess) fprintf(stderr, "kernel_launch: cooperative launch failed: %s (grid %d)\n", hipGetErrorString(e), grid);
#else
    for (int p = 0; p < N_PHASES; ++p) {
        a.ph_lo = p; a.ph_hi = p + 1;
        hipLaunchKernelGGL(mega_fwd, dim3(grid), dim3(NWAVES * 64), LDS_BYTES, stream, a);
    }
    const hipError_t le = hipPeekAtLastError();
    if (le != hipSuccess) fprintf(stderr, "kernel_launch: launch failed: %s\n", hipGetErrorName(le));
#endif
}
```

```cpp
#include <hip/hip_runtime.h>
#include <hip/hip_bf16.h>
#include <hip/hip_cooperative_groups.h>
#include <cstdio>
#include <cstdint>
#include <cmath>
namespace cg = cooperative_groups;

namespace pg8 {
#define PG8_LAS __attribute__((address_space(3)))
typedef unsigned short bf16_t;
typedef short bf16x8 __attribute__((ext_vector_type(8)));
typedef float f32x4 __attribute__((ext_vector_type(4)));
typedef unsigned u32x4 __attribute__((ext_vector_type(4)));
constexpr int BM = 256, BK = 64, HALF = 128, HTB = HALF * BK * 2  , STAGE_BYTES = 8 * HTB, NXCD = 8, WGM = 8;

__host__ __device__ __forceinline__ int lds_byte(int r, int c) { const int st = (r >> 4) * 2 + (c >> 5), rr = r & 15, cc = c & 31, ob = rr * 64 + cc * 2; return st * 1024 + (ob ^ (((ob >> 9) & 1) << 5)); }
__host__ __device__ __forceinline__ void stage_rc(int b, int& R, int& C) { const int st = b / 1024, sb = b % 1024, swz = sb ^ (((sb >> 9) & 1) << 5); R = (st >> 1) * 16 + swz / 64; C = (st & 1) * 32 + (swz % 64) / 2; }
__host__ __device__ __forceinline__ int perm32(int rho) { const int n = rho >> 4, i = rho & 15; return 8 * (i >> 2) + 4 * n + (i & 3); }

struct Unit { int pm, pn; };
struct Gemm { const bf16_t* A; const bf16_t* Bt; int M, N, K; };

struct StaticOrder {
    int nM, nN, nwg, G, c;
    __host__ __device__ void init(int M, int N, int G_, int c_) { nM = M / BM; nN = N / BM; nwg = nM * nN; G = G_; c = c_; }
    __host__ __device__ bool next(int i, Unit& u) const {
        const long L = (long)i * G + c; if (L >= nwg) return false;
        int wgid = (int)L; { const int q = nwg / NXCD, r = nwg % NXCD, xcd = wgid % NXCD, off = wgid / NXCD; wgid = (xcd < r ? xcd * (q + 1) : r * (q + 1) + (xcd - r) * q) + off; }
        const int nig = WGM * nN, gid = wgid / nig, fm = gid * WGM, gsz = (nM - fm) < WGM ? (nM - fm) : WGM;
        u.pm = fm + ((wgid % nig) % gsz); u.pn = (wgid % nig) / gsz; return true;
    }
    __device__ __forceinline__ void a_ready(const Unit&) const {}
    __device__ __forceinline__ void done(const Unit&) const {}
};

struct RangeOrder : StaticOrder {
    int pm0;
    __host__ __device__ bool next(int i, Unit& u) const { if (!StaticOrder::next(i, u)) return false; u.pm += pm0; return true; }
};

__device__ __forceinline__ unsigned cvt_pk_bf16(float lo, float hi) { unsigned r; asm volatile("v_cvt_pk_bf16_f32 %0, %1, %2" : "=v"(r) : "v"(lo), "v"(hi)); return r; }
struct EpiStoreBf16 {
    static constexpr bool PERM = true, AFTER_DRAIN = false;
    bf16_t* O; int ldc;
    __device__ __forceinline__ void operator()(const f32x4 (&acc)[2][2][4][2], const Unit& u, int wr, int wc, int fr, int fq) const {
        const int row0 = u.pm * BM + wr * 64 + fr; const int col0 = u.pn * BM + wc * 32 + 8 * fq;
#pragma unroll
        for (int ai = 0; ai < 2; ++ai)
#pragma unroll
            for (int m = 0; m < 4; ++m) { bf16_t* rowp = O + (size_t)(row0 + ai * HALF + m * 16) * ldc + col0;
#pragma unroll
                for (int bj = 0; bj < 2; ++bj) { const f32x4 v0 = acc[ai][bj][m][0], v1 = acc[ai][bj][m][1];
                    u32x4 w; w.x = cvt_pk_bf16(v0[0], v0[1]); w.y = cvt_pk_bf16(v0[2], v0[3]); w.z = cvt_pk_bf16(v1[0], v1[1]); w.w = cvt_pk_bf16(v1[2], v1[3]);
                    *(u32x4*)(rowp + bj * HALF) = w; } }
    }
};
struct EpiEven {
    static constexpr bool PERM = true, AFTER_DRAIN = false;
    bf16_t* O; int ldc; const float* lb;
    __device__ __forceinline__ void operator()(const f32x4 (&acc)[2][2][4][2], const Unit& u, int wr, int wc, int fr, int fq) const {
        const int row0 = u.pm * BM + wr * 64 + fr; const int col0 = u.pn * BM + wc * 32 + 8 * fq;
        const int kind = u.pn < 4 ? 1 : (u.pn < 12 ? 2 : ((u.pn == 16 || u.pn == 17) ? 3 : 0));
        float lbv[2][8];
        if (kind == 2) {
#pragma unroll
            for (int bj = 0; bj < 2; ++bj) { const f32x4 a = *(const f32x4*)(lb + ((col0 + bj * HALF - 1024) & 1023)), b = *(const f32x4*)(lb + ((col0 + bj * HALF - 1024) & 1023) + 4);
                lbv[bj][0] = a[0]; lbv[bj][1] = a[1]; lbv[bj][2] = a[2]; lbv[bj][3] = a[3]; lbv[bj][4] = b[0]; lbv[bj][5] = b[1]; lbv[bj][6] = b[2]; lbv[bj][7] = b[3]; }
        }
#pragma unroll
        for (int ai = 0; ai < 2; ++ai)
#pragma unroll
            for (int m = 0; m < 4; ++m) { bf16_t* rowp = O + (size_t)(row0 + ai * HALF + m * 16) * ldc + col0;
#pragma unroll
                for (int bj = 0; bj < 2; ++bj) { float v[8] = {acc[ai][bj][m][0][0], acc[ai][bj][m][0][1], acc[ai][bj][m][0][2], acc[ai][bj][m][0][3], acc[ai][bj][m][1][0], acc[ai][bj][m][1][1], acc[ai][bj][m][1][2], acc[ai][bj][m][1][3]};
                    u32x4 w;
                    if (kind == 2) {
                        typedef _Float16 h8 __attribute__((ext_vector_type(8))); h8 hv;
#pragma unroll
                        for (int e = 0; e < 8; ++e) { const float sg = __builtin_amdgcn_rcpf(1.f + __expf(-v[e])); hv[e] = (_Float16)__builtin_amdgcn_logf(__builtin_fmaf(1.f - lbv[bj][e], sg, lbv[bj][e])); }
                        w = __builtin_bit_cast(u32x4, hv);
                    } else {
                        if (kind == 1) {
#pragma unroll
                            for (int e = 0; e < 8; ++e) v[e] = v[e] * __builtin_amdgcn_rcpf(1.f + __expf(-v[e]));
                        } else if (kind == 3) {
#pragma unroll
                            for (int e = 0; e < 8; ++e) v[e] *= 0.088388347648318440f;
                        }
                        w.x = cvt_pk_bf16(v[0], v[1]); w.y = cvt_pk_bf16(v[2], v[3]); w.z = cvt_pk_bf16(v[4], v[5]); w.w = cvt_pk_bf16(v[6], v[7]);
                    }
                    *(u32x4*)(rowp + bj * HALF) = w; } }
    }
};

struct EpiOdd {
    static constexpr bool PERM = true, AFTER_DRAIN = false;
    bf16_t* O; int ldc; const float* qg; const float* kg; const float* rope; PG8_LAS float* part; float qscale;
    __device__ __forceinline__ void operator()(const f32x4 (&acc)[2][2][4][2], const Unit& u, int wr, int wc, int fr, int fq) const {
        const int row0 = u.pm * BM + wr * 64 + fr; const int col0 = u.pn * BM + wc * 32 + 8 * fq;
        if (u.pn >= 16) {
#pragma unroll
            for (int ai = 0; ai < 2; ++ai)
#pragma unroll
                for (int m = 0; m < 4; ++m) { bf16_t* rowp = O + (size_t)(row0 + ai * HALF + m * 16) * ldc + col0;
#pragma unroll
                    for (int bj = 0; bj < 2; ++bj) { const f32x4 v0 = acc[ai][bj][m][0], v1 = acc[ai][bj][m][1];
                        u32x4 w; w.x = cvt_pk_bf16(v0[0], v0[1]); w.y = cvt_pk_bf16(v0[2], v0[3]); w.z = cvt_pk_bf16(v1[0], v1[1]); w.w = cvt_pk_bf16(v1[2], v1[3]);
                        *(u32x4*)(rowp + bj * HALF) = w; } }
            return;
        }
        const bool isq = u.pn < 8;
        const int B = wc >> 1, i0 = (wc & 1) * 16 + 4 * fq;
#pragma unroll
        for (int ai = 0; ai < 2; ++ai)
#pragma unroll
            for (int m = 0; m < 4; ++m)
#pragma unroll
                for (int bj = 0; bj < 2; ++bj) { const f32x4 a = acc[ai][bj][m][0], b = acc[ai][bj][m][1];
                    float s = (a[0] * a[0] + a[1] * a[1]) + (a[2] * a[2] + a[3] * a[3]) + (b[0] * b[0] + b[1] * b[1]) + (b[2] * b[2] + b[3] * b[3]);
                    s += __shfl_xor(s, 16); s += __shfl_xor(s, 32);
                    if (fq == 0) part[((ai * HALF + wr * 64 + m * 16 + fr) * 2 + bj) * 4 + wc] = s; }
        asm volatile("s_waitcnt lgkmcnt(0)" ::: "memory"); __builtin_amdgcn_s_barrier(); asm volatile("" ::: "memory");
        const int jt = u.pm % 9; const bool lat = jt != 0;
        float g[8];
        { const float* gp = (isq ? qg : kg) + B * 64 + i0; const f32x4 g0 = *(const f32x4*)gp, g1 = *(const f32x4*)(gp + 32); const float sc = isq ? qscale : 1.f;
          g[0] = g0[0] * sc; g[1] = g1[0] * sc; g[2] = g0[1] * sc; g[3] = g1[1] * sc; g[4] = g0[2] * sc; g[5] = g1[2] * sc; g[6] = g0[3] * sc; g[7] = g1[3] * sc; }
#pragma unroll
        for (int ai = 0; ai < 2; ++ai)
#pragma unroll
            for (int m = 0; m < 4; ++m) { const int rt = ai * HALF + wr * 64 + m * 16 + fr;
                f32x4 cs0 = {1.f, 0.f, 1.f, 0.f}, cs1 = {1.f, 0.f, 1.f, 0.f};
                if (lat) { const int ptok = (jt - 1) * 256 + rt; const int pos = B ? (ptok & 63) : (ptok >> 6); const float* tp = rope + (pos * 32 + i0) * 2; cs0 = *(const f32x4*)tp; cs1 = *(const f32x4*)(tp + 4); }
                bf16_t* rowp = O + (size_t)(row0 + ai * HALF + m * 16) * ldc + col0;
#pragma unroll
                for (int bj = 0; bj < 2; ++bj) { const f32x4 p4 = *(const PG8_LAS f32x4*)(part + (rt * 2 + bj) * 4);
                    const float rstd = __builtin_amdgcn_rsqf(((p4[0] + p4[1]) + (p4[2] + p4[3])) * (1.f / 128.f) + 1e-6f);
                    const f32x4 a = acc[ai][bj][m][0], b = acc[ai][bj][m][1];
                    const float x[8] = {a[0] * rstd * g[0], a[1] * rstd * g[1], a[2] * rstd * g[2], a[3] * rstd * g[3], b[0] * rstd * g[4], b[1] * rstd * g[5], b[2] * rstd * g[6], b[3] * rstd * g[7]};
                    const float c[4] = {cs0[0], cs0[2], cs1[0], cs1[2]}, sn[4] = {cs0[1], cs0[3], cs1[1], cs1[3]};
                    float y[8];
#pragma unroll
                    for (int j = 0; j < 4; ++j) { y[2 * j] = x[2 * j] * c[j] - x[2 * j + 1] * sn[j]; y[2 * j + 1] = x[2 * j + 1] * c[j] + x[2 * j] * sn[j]; }
                    u32x4 w; w.x = cvt_pk_bf16(y[0], y[1]); w.y = cvt_pk_bf16(y[2], y[3]); w.z = cvt_pk_bf16(y[4], y[5]); w.w = cvt_pk_bf16(y[6], y[7]);
                    *(u32x4*)(rowp + bj * HALF) = w; }
                asm volatile("" ::: "memory"); }
    }
};

struct EpiResL0 {
    static constexpr bool PERM = false, AFTER_DRAIN = false;
    const float* xsrc; const float* csrc; bf16_t* xa; bf16_t* xb; bf16_t* cb; const float* mod;
    __device__ __forceinline__ void operator()(const f32x4 (&acc)[2][2][4][2], const Unit& u, int wr, int wc, int fr, int fq) const {
        const int b = u.pm / 9, j = u.pm - b * 9;
        const float* src; bf16_t* dst; const float* g;
        if (j == 0) { const size_t off = (size_t)b * 256 * 2048; src = csrc + off; dst = cb + off; g = mod + 8 * 6144 + 4096; }
        else { const int lt = b * 8 + (j - 1); src = xsrc + (size_t)lt * 256 * 2048; dst = (lt < 32 ? xa : xb) + (size_t)(lt & 31) * 256 * 2048; g = mod + b * 6144 + 4096; }
        const int r0 = wr * 64 + fr, col0 = u.pn * BM + wc * 32 + 4 * fq;
        f32x4 gv[2][2];
#pragma unroll
        for (int bj = 0; bj < 2; ++bj)
#pragma unroll
            for (int n = 0; n < 2; ++n) gv[bj][n] = *(const f32x4*)(g + col0 + bj * HALF + n * 16);
#pragma unroll
        for (int ai = 0; ai < 2; ++ai)
#pragma unroll
            for (int m = 0; m < 4; ++m) { const size_t roff = (size_t)(r0 + ai * HALF + m * 16) * 2048 + col0;
#pragma unroll
                for (int bj = 0; bj < 2; ++bj)
#pragma unroll
                    for (int n = 0; n < 2; ++n) { const f32x4 s = *(const f32x4*)(src + roff + bj * HALF + n * 16); const f32x4 y = s + gv[bj][n] * acc[ai][bj][m][n];
                        unsigned w0 = cvt_pk_bf16(y[0], y[1]), w1 = cvt_pk_bf16(y[2], y[3]); typedef unsigned u32x2_ __attribute__((ext_vector_type(2))); *(u32x2_*)(dst + roff + bj * HALF + n * 16) = (u32x2_){w0, w1}; }
                asm volatile("" ::: "memory"); }
    }
};
struct EpiResL1 {
    static constexpr bool PERM = false, AFTER_DRAIN = false;
    const bf16_t* xa; const bf16_t* xb; float* out; const float* mod;
    __device__ __forceinline__ void operator()(const f32x4 (&acc)[2][2][4][2], const Unit& u, int wr, int wc, int fr, int fq) const {
        const int lt = u.pm, b = lt >> 3;
        const bf16_t* src = (lt < 32 ? xa : xb) + (size_t)(lt & 31) * 256 * 2048; float* dst = out + (size_t)lt * 256 * 2048; const float* g = mod + b * 6144 + 4096;
        const int r0 = wr * 64 + fr, col0 = u.pn * BM + wc * 32 + 4 * fq;
        f32x4 gv[2][2];
#pragma unroll
        for (int bj = 0; bj < 2; ++bj)
#pragma unroll
            for (int n = 0; n < 2; ++n) gv[bj][n] = *(const f32x4*)(g + col0 + bj * HALF + n * 16);
#pragma unroll
        for (int ai = 0; ai < 2; ++ai)
#pragma unroll
            for (int m = 0; m < 4; ++m) { const size_t roff = (size_t)(r0 + ai * HALF + m * 16) * 2048 + col0;
#pragma unroll
                for (int bj = 0; bj < 2; ++bj)
#pragma unroll
                    for (int n = 0; n < 2; ++n) { typedef unsigned u32x2_ __attribute__((ext_vector_type(2))); const u32x2_ w = *(const u32x2_*)(src + roff + bj * HALF + n * 16);
                        const f32x4 s = {__uint_as_float(w[0] << 16), __uint_as_float(w[0] & 0xffff0000u), __uint_as_float(w[1] << 16), __uint_as_float(w[1] & 0xffff0000u)};
                        *(f32x4*)(dst + roff + bj * HALF + n * 16) = s + gv[bj][n] * acc[ai][bj][m][n]; }
                asm volatile("" ::: "memory"); }
    }
};

struct EpiRes {
    static constexpr bool PERM = false, AFTER_DRAIN = false;
    const float* xsrc; float* xdst; const float* csrc; float* cdst; const float* mod; int tpb;
    __device__ __forceinline__ void operator()(const f32x4 (&acc)[2][2][4][2], const Unit& u, int wr, int wc, int fr, int fq) const {
        const int b = u.pm / tpb, j = u.pm - b * tpb;
        const float* src; float* dst; const float* g;
        if (tpb == 9 && j == 0) { const size_t off = (size_t)b * 256 * 2048; src = csrc + off; dst = cdst + off; g = mod + 8 * 6144 + 4096; }
        else { const int jj = (tpb == 9) ? j - 1 : j; const size_t off = ((size_t)b * 2048 + (size_t)jj * 256) * 2048; src = xsrc + off; dst = xdst + off; g = mod + b * 6144 + 4096; }
        const int r0 = wr * 64 + fr, col0 = u.pn * BM + wc * 32 + 4 * fq;
        f32x4 gv[2][2];
#pragma unroll
        for (int bj = 0; bj < 2; ++bj)
#pragma unroll
            for (int n = 0; n < 2; ++n) gv[bj][n] = *(const f32x4*)(g + col0 + bj * HALF + n * 16);
#pragma unroll
        for (int ai = 0; ai < 2; ++ai)
#pragma unroll
            for (int m = 0; m < 4; ++m) { const size_t roff = (size_t)(r0 + ai * HALF + m * 16) * 2048 + col0;
#pragma unroll
                for (int bj = 0; bj < 2; ++bj)
#pragma unroll
                    for (int n = 0; n < 2; ++n) { const f32x4 s = *(const f32x4*)(src + roff + bj * HALF + n * 16); *(f32x4*)(dst + roff + bj * HALF + n * 16) = s + gv[bj][n] * acc[ai][bj][m][n]; }
                asm volatile("" ::: "memory"); }
    }
};

template <class Epi, class Sched, bool ALIGN_EPI = false, bool SP2 = false>
__device__ __forceinline__ void gemm_phase(PG8_LAS unsigned char* lds, const Gemm g, const Sched& S, const Epi& E, const int tid  ) {
    const int wid = __builtin_amdgcn_readfirstlane(tid >> 6), lane = tid & 63, wr = wid >> 2, wc = wid & 3, fr = lane & 15, fq = lane >> 4;
    const int K = g.K, nt = K / BK;
    unsigned voffA[2], voffB[2];
#pragma unroll
    for (int i = 0; i < 2; ++i) { int R, C; stage_rc(tid * 16 + i * 8192, R, C); const int Rb = Epi::PERM ? ((R & ~31) + perm32(R & 31)) : R;
        voffA[i] = (unsigned)(R * K + C) * 2u; voffB[i] = (unsigned)(Rb * K + C) * 2u; }
    const size_t kstep = (size_t)(BK * 2);
    const size_t hstep = (size_t)HALF * K * 2;
    const size_t tstep = 2 * hstep;
    const unsigned ldsw = (unsigned)wid * 1024u;
    const int aoff = lds_byte(wr * 64 + fr, fq * 8), boff = lds_byte(wc * 32 + fr, fq * 8);
#define PG8_SA(b, h) (((b) * 2 + (h)) * HTB)
#define PG8_SB(b, h) ((4 + (b) * 2 + (h)) * HTB)
#define PG8_STAGE(bufoff, gbase, voff) do { _Pragma("unroll") for (int _i = 0; _i < 2; ++_i) \
        __builtin_amdgcn_global_load_lds((const unsigned*)((const char*)(gbase) + (voff)[_i]), (PG8_LAS unsigned*)(lds + (bufoff) + ldsw + _i * 8192), 16, 0, 0); } while (0)
#define PG8_LDA(dst, b, h) do { _Pragma("unroll") for (int m = 0; m < 4; ++m) _Pragma("unroll") for (int k = 0; k < 2; ++k) dst[m][k] = *(const PG8_LAS bf16x8*)(lds + PG8_SA(b, h) + aoff + m * 2048 + k * 1024); } while (0)
#define PG8_LDB(dst, b, h) do { _Pragma("unroll") for (int n = 0; n < 2; ++n) _Pragma("unroll") for (int k = 0; k < 2; ++k) dst[n][k] = *(const PG8_LAS bf16x8*)(lds + PG8_SB(b, h) + boff + n * 2048 + k * 1024); } while (0)
#define PG8_MMA(ai, bj, At, Bt) do { __builtin_amdgcn_s_setprio(1); _Pragma("unroll") for (int m = 0; m < 4; ++m) _Pragma("unroll") for (int n = 0; n < 2; ++n) _Pragma("unroll") for (int k = 0; k < 2; ++k) \
        acc[ai][bj][m][n] = __builtin_amdgcn_mfma_f32_16x16x32_bf16(Bt[n][k], At[m][k], acc[ai][bj][m][n], 0, 0, 0); __builtin_amdgcn_s_setprio(0); } while (0)
#define PG8_WAIT_V(n) asm volatile("s_waitcnt vmcnt(" #n ")" ::: "memory")
#define PG8_WAIT_L(n) asm volatile("s_waitcnt lgkmcnt(" #n ")" ::: "memory")
#define PG8_BAR __builtin_amdgcn_s_barrier()
#define PG8_SCHED __builtin_amdgcn_sched_barrier(0)
    Unit cur, nxt; int ui = 0;
    if (!S.next(0, cur)) return;
    f32x4 acc[2][2][4][2];
#pragma unroll
    for (int a = 0; a < 2; ++a)
#pragma unroll
        for (int b = 0; b < 2; ++b)
#pragma unroll
            for (int m = 0; m < 4; ++m)
#pragma unroll
                for (int n = 0; n < 2; ++n) acc[a][b][m][n] = (f32x4){0.f, 0.f, 0.f, 0.f};
    bf16x8 At[4][2], B0[2][2], B1[2][2];
    const char* cA = (const char*)g.A + (size_t)cur.pm * tstep; const char* cB = (const char*)g.Bt + (size_t)cur.pn * tstep;
    S.a_ready(cur);
    if constexpr (SP2) {
        PG8_STAGE(PG8_SB(0, 0), cB, voffB); PG8_STAGE(PG8_SB(0, 1), cB + hstep, voffB); PG8_STAGE(PG8_SA(0, 0), cA, voffA); PG8_STAGE(PG8_SA(0, 1), cA + hstep, voffA);
        if (wr == 1) PG8_BAR;
        PG8_WAIT_V(2); PG8_BAR;
        PG8_STAGE(PG8_SB(1, 0), cB + kstep, voffB); PG8_STAGE(PG8_SA(1, 0), cA + kstep, voffA); PG8_STAGE(PG8_SB(1, 1), cB + hstep + kstep, voffB);
        PG8_WAIT_V(6); PG8_BAR;
    } else {
        PG8_STAGE(PG8_SB(0, 0), cB, voffB); PG8_STAGE(PG8_SA(0, 0), cA, voffA); PG8_STAGE(PG8_SB(0, 1), cB + hstep, voffB); PG8_STAGE(PG8_SA(0, 1), cA + hstep, voffA);
        if (wr == 1) PG8_BAR;
        PG8_WAIT_V(4); PG8_BAR;
        PG8_STAGE(PG8_SB(1, 0), cB + kstep, voffB); PG8_STAGE(PG8_SA(1, 0), cA + kstep, voffA); PG8_STAGE(PG8_SB(1, 1), cB + hstep + kstep, voffB);
        PG8_WAIT_V(6); PG8_BAR;
    }
    for (;;) {
        const bool has_next = S.next(ui + 1, nxt);
        const char* nA = has_next ? (const char*)g.A + (size_t)nxt.pm * tstep : cA; const char* nB = has_next ? (const char*)g.Bt + (size_t)nxt.pn * tstep : cB;
        for (int t = 0; t < nt; t += 2) {
            const bool last = (t == nt - 2);
            const char* a1 = cA + (size_t)(t + 1) * kstep;
            const char* a2 = last ? nA : cA + (size_t)(t + 2) * kstep; const char* b2 = last ? nB : cB + (size_t)(t + 2) * kstep;
            const char* a3 = a2 + kstep; const char* b3 = b2 + kstep;
            if (last && has_next) S.a_ready(nxt);
            if constexpr (SP2) {
            PG8_LDB(B0, 0, 0); PG8_LDB(B1, 0, 1); PG8_SCHED; PG8_LDA(At, 0, 0); PG8_STAGE(PG8_SA(1, 1), a1 + hstep, voffA);
            PG8_WAIT_V(8); PG8_WAIT_L(0); PG8_BAR; PG8_MMA(0, 0, At, B0); PG8_MMA(0, 1, At, B1); PG8_BAR; PG8_SCHED;
            PG8_LDA(At, 0, 1); PG8_STAGE(PG8_SB(0, 0), b2, voffB); PG8_STAGE(PG8_SB(0, 1), b2 + hstep, voffB); PG8_STAGE(PG8_SA(0, 0), a2, voffA);
            PG8_WAIT_V(8); PG8_WAIT_L(0); PG8_BAR; PG8_MMA(1, 0, At, B0); PG8_MMA(1, 1, At, B1); PG8_BAR; PG8_SCHED;
            PG8_LDB(B0, 1, 0); PG8_LDB(B1, 1, 1); PG8_SCHED; PG8_LDA(At, 1, 0); PG8_STAGE(PG8_SA(0, 1), a2 + hstep, voffA);
            PG8_WAIT_V(8); PG8_WAIT_L(0); PG8_BAR; PG8_MMA(0, 0, At, B0); PG8_MMA(0, 1, At, B1); PG8_BAR; PG8_SCHED;
            PG8_LDA(At, 1, 1); PG8_STAGE(PG8_SB(1, 0), b3, voffB); PG8_STAGE(PG8_SB(1, 1), b3 + hstep, voffB); PG8_STAGE(PG8_SA(1, 0), a3, voffA);
            PG8_WAIT_V(8); PG8_WAIT_L(0); PG8_BAR; PG8_MMA(1, 0, At, B0); PG8_MMA(1, 1, At, B1); PG8_BAR; PG8_SCHED;
            } else {
            PG8_LDB(B0, 0, 0); PG8_SCHED; PG8_LDA(At, 0, 0); PG8_STAGE(PG8_SA(1, 1), a1 + hstep, voffA);
            PG8_WAIT_L(8); PG8_BAR; PG8_WAIT_L(0); PG8_MMA(0, 0, At, B0); PG8_BAR; PG8_SCHED;
            PG8_LDB(B1, 0, 1); PG8_STAGE(PG8_SB(0, 0), b2, voffB);
            PG8_BAR; PG8_WAIT_L(0); PG8_MMA(0, 1, At, B1); PG8_BAR;
            PG8_LDA(At, 0, 1); PG8_STAGE(PG8_SA(0, 0), a2, voffA);
            PG8_BAR; PG8_WAIT_L(0); PG8_MMA(1, 0, At, B0); PG8_BAR; PG8_SCHED;
            PG8_STAGE(PG8_SB(0, 1), b2 + hstep, voffB);
            PG8_WAIT_V(6); PG8_BAR; PG8_MMA(1, 1, At, B1); PG8_BAR;
            PG8_LDB(B0, 1, 0); PG8_SCHED; PG8_LDA(At, 1, 0); PG8_STAGE(PG8_SA(0, 1), a2 + hstep, voffA);
            PG8_WAIT_L(8); PG8_BAR; PG8_WAIT_L(0); PG8_MMA(0, 0, At, B0); PG8_BAR; PG8_SCHED;
            PG8_LDB(B1, 1, 1); PG8_STAGE(PG8_SB(1, 0), b3, voffB);
            PG8_BAR; PG8_WAIT_L(0); PG8_MMA(0, 1, At, B1); PG8_BAR;
            PG8_LDA(At, 1, 1); PG8_STAGE(PG8_SA(1, 0), a3, voffA);
            PG8_BAR; PG8_WAIT_L(0); PG8_MMA(1, 0, At, B0); PG8_BAR; PG8_SCHED;
            PG8_STAGE(PG8_SB(1, 1), b3 + hstep, voffB);
            PG8_WAIT_V(6); PG8_BAR; PG8_MMA(1, 1, At, B1); PG8_BAR;
            }
        }
        if constexpr (ALIGN_EPI) { if (wr == 0) PG8_BAR; }
        if constexpr (!Epi::AFTER_DRAIN) { E(acc, cur, wr, wc, fr, fq); S.done(cur); }
        if (!has_next) break;
#pragma unroll
        for (int a = 0; a < 2; ++a)
#pragma unroll
            for (int b = 0; b < 2; ++b)
#pragma unroll
                for (int m = 0; m < 4; ++m)
#pragma unroll
                    for (int n = 0; n < 2; ++n) acc[a][b][m][n] = (f32x4){0.f, 0.f, 0.f, 0.f};
        cur = nxt; cA = nA; cB = nB; ++ui;
        if constexpr (ALIGN_EPI) { if (wr == 1) PG8_BAR; }
    }
    PG8_WAIT_V(0);
    if constexpr (!ALIGN_EPI) { if (wr == 0) PG8_BAR; }
    PG8_BAR;
    if constexpr (Epi::AFTER_DRAIN) { E.fused(acc, cur, wr, wc, fr, fq, lds, wid, lane); S.done(cur); }
#undef PG8_SA
#undef PG8_SB
#undef PG8_STAGE
#undef PG8_LDA
#undef PG8_LDB
#undef PG8_MMA
#undef PG8_WAIT_V
#undef PG8_WAIT_L
#undef PG8_BAR
#undef PG8_SCHED
}
}

constexpr int NWAVES = 8;
#ifndef PROBE_PH_MASK
#define PROBE_PH_MASK 0
#endif
#ifndef PROBE_DUP_MASK
#define PROBE_DUP_MASK 0
#endif
#ifndef MK_ONE_LAUNCH
#define MK_ONE_LAUNCH 1
#endif
constexpr int NB = 8, SEQ = 2048, NCTX = 256, LTOK = SEQ + NCTX, DM = 2048;
constexpr int MROWS = NB * LTOK;
constexpr int MLAT = NB * SEQ;
constexpr int NE_SRC = 8224, NP = 8192;
#ifndef P_PITCH
#define P_PITCH 8256
#endif
constexpr int LDP = P_PITCH;
constexpr float EPS = 1e-6f;
constexpr int EC_AQ = 0, EC_AFF = 1024, EC_AFB = 2048, EC_AI = 3072, EC_BQ = 4096, EC_BK = 4608, EC_BV = 5120, EC_GATE = 6144;
constexpr int OC_Q = 0, OC_K = 2048, OC_V = 4096, OC_GATE = 6144;
constexpr float QSCALE = 0.12751743074602467f;
constexpr float LAM_INIT1 = 0.35550906759f;

constexpr size_t MiB = 1u << 20;
constexpr size_t WS_CTL = 0, CTL_ZERO_BYTES = 1 * MiB;
constexpr size_t WS_MOD = 1 * MiB;
constexpr size_t WS_WZ = 2 * MiB;
constexpr size_t WS_LBT = 2 * MiB + 512 * 1024;
constexpr size_t WS_ROPE = 2 * MiB + 768 * 1024;
constexpr size_t WS_Z = 3 * MiB;
constexpr size_t WS_WOO = 8 * MiB;
constexpr size_t WS_WIE = 16 * MiB;
constexpr size_t WS_WOE = 48 * MiB;
constexpr size_t WS_WIO = 56 * MiB;
constexpr size_t WS_H = 88 * MiB;
constexpr size_t WS_P = 160 * MiB;
constexpr size_t WS_CTX1 = 452 * MiB;
constexpr size_t WS_LA = 468 * MiB;
constexpr size_t WS_X1A = 16 * MiB, WS_X1B = 468 * MiB, WS_C1B = 500 * MiB;
constexpr size_t WS_END = 508 * MiB;
static_assert(WS_P + (size_t)MROWS * LDP * 2 <= WS_CTX1, "projection buffer");
constexpr size_t WS_O0 = WS_H, WS_O1 = 80 * MiB;
static_assert(WS_O0 + (size_t)MLAT * DM * 2 <= WS_P && WS_X1A + (size_t)8192 * DM * 2 <= WS_WOE && WS_X1B + (size_t)8192 * DM * 2 <= WS_C1B && WS_C1B + (size_t)2048 * DM * 2 <= WS_END, "overlays");

constexpr int LDS_BYTES = 147456;
constexpr int LDSCTL_OFF = 131072, MISC_OFF = LDSCTL_OFF + 320;
constexpr int CW_RANK = 8192;
constexpr int CW_BAR = 4096;

#define GAS __attribute__((address_space(1)))
#define LAS __attribute__((address_space(3)))
typedef unsigned short bf16;
typedef unsigned v4u __attribute__((ext_vector_type(4)));
typedef unsigned v2u __attribute__((ext_vector_type(2)));
typedef float f32x4 __attribute__((ext_vector_type(4)));
typedef short bf16x8 __attribute__((ext_vector_type(8)));

__device__ __forceinline__ unsigned f2bf(float f) { unsigned u = __builtin_bit_cast(unsigned, f); return (u + 0x7fffu + ((u >> 16) & 1u)) >> 16; }
__device__ __forceinline__ unsigned pk2(float lo, float hi) { return f2bf(lo) | (f2bf(hi) << 16); }
__device__ __forceinline__ float bf2f(unsigned short v) { return __uint_as_float((unsigned)v << 16); }
__device__ __forceinline__ float bflo(unsigned w) { return __uint_as_float(w << 16); }
__device__ __forceinline__ float bfhi(unsigned w) { return __uint_as_float(w & 0xffff0000u); }
__device__ __forceinline__ void unpack8(const v4u w, float (&x)[8]) { x[0] = bflo(w.x); x[1] = bfhi(w.x); x[2] = bflo(w.y); x[3] = bfhi(w.y); x[4] = bflo(w.z); x[5] = bfhi(w.z); x[6] = bflo(w.w); x[7] = bfhi(w.w); }
__device__ __forceinline__ v4u pack8(const float (&x)[8]) { v4u w; w.x = pk2(x[0], x[1]); w.y = pk2(x[2], x[3]); w.z = pk2(x[4], x[5]); w.w = pk2(x[6], x[7]); return w; }
__device__ __forceinline__ v4u pack8c(const float (&x)[8]) { v4u w; w.x = pg8::cvt_pk_bf16(x[0], x[1]); w.y = pg8::cvt_pk_bf16(x[2], x[3]); w.z = pg8::cvt_pk_bf16(x[4], x[5]); w.w = pg8::cvt_pk_bf16(x[6], x[7]); return w; }
typedef float f32x2c_ __attribute__((ext_vector_type(2))); typedef __bf16 bf16x2c_ __attribute__((ext_vector_type(2)));
__device__ __forceinline__ unsigned cvtpk_c(float lo, float hi) { const f32x2c_ v = {lo, hi}; const bf16x2c_ b = __builtin_convertvector(v, bf16x2c_); return __builtin_bit_cast(unsigned, b); }
__device__ __forceinline__ float wave_sum(float v) {
#pragma unroll
    for (int o = 1; o < 64; o <<= 1) v += __shfl_xor(v, o);
    return v;
}
__device__ __forceinline__ float sigmoidf_(float x) { return 1.f / (1.f + __expf(-x)); }
__device__ __forceinline__ float siluf_(float x) { return x / (1.f + __expf(-x)); }
__device__ __forceinline__ float logsigmoidf_(float x) { return fminf(x, 0.f) - log1pf(__expf(-fabsf(x))); }
__device__ __forceinline__ void sincos_(float x, float& s, float& c) {
    const float k = rintf(x * 0.63661977236758134f);
    float r = fmaf(-k, 1.5707962512969971f, x); r = fmaf(-k, 7.5497894158615964e-8f, r);
    const float r2 = r * r;
    float sp = fmaf(r2, 2.7557314297e-6f, -1.9841270114e-4f); sp = fmaf(sp, r2, 8.3333337680e-3f); sp = fmaf(sp, r2, -1.6666667163e-1f); sp = fmaf(sp * r2, r, r);
    float cp = fmaf(r2, 2.4801587642e-5f, -1.3888889225e-3f); cp = fmaf(cp, r2, 4.1666667908e-2f); cp = fmaf(cp, r2, -0.5f); cp = fmaf(cp, r2, 1.0f);
    const int q = (int)k & 3;
    const float ss = (q & 1) ? cp : sp, cc = (q & 1) ? sp : cp;
    s = (q & 2) ? -ss : ss; c = ((q + 1) & 2) ? -cc : cc;
}

constexpr int WTAB_OFF = 131072 + 512;
__device__ __forceinline__ int lane_id_() { int l_; asm volatile("v_mbcnt_lo_u32_b32 %0, -1, 0\n\tv_mbcnt_hi_u32_b32 %0, -1, %0" : "=v"(l_)); return l_; }
__device__ __forceinline__ int hw_slot_() { return (int)(__builtin_amdgcn_s_getreg(((6 - 1) << 11) | 4) & 63u); }
__device__ __forceinline__ int wave_id_(LAS unsigned char* lds0) { return __builtin_amdgcn_readfirstlane((int)((volatile LAS unsigned*)(lds0 + WTAB_OFF))[hw_slot_()]); }
#define XB_TMO      128
#define XB_XCNT(j)  (256  + 64 * (j))
#define XB_XSUB(j)  (1280 + 64 * (j))
#define XB_XGEN(j)  (2304 + 64 * (j))
#define XB_TOP      3328
#define XB_TOPGEN   3392
#define XCD_BAR_WORDS 3456
#define XB_SPIN_CAP (1u << 18)

__device__ __forceinline__ unsigned xb_ld(unsigned* p)              { return __hip_atomic_load(p, __ATOMIC_RELAXED, __HIP_MEMORY_SCOPE_AGENT); }
__device__ __forceinline__ unsigned xb_add(unsigned* p, unsigned v) { return __hip_atomic_fetch_add(p, v, __ATOMIC_RELAXED, __HIP_MEMORY_SCOPE_AGENT); }
__device__ __forceinline__ unsigned xb_xcc_id() { return (unsigned)__builtin_amdgcn_s_getreg((3 << 11) | 20) & 0xFu; }
#define XB_SPIN(cond, bar) do { unsigned _sp = 0; while (cond) { __builtin_amdgcn_s_sleep(1); \
    if ((++_sp & 255u) == 0u) { if (xb_ld(&(bar)[XB_TMO])) break; if (_sp > XB_SPIN_CAP) { atomicAdd(&(bar)[XB_TMO], 1u); break; } } } } while (0)

struct XcdBarrier {
    unsigned* bar; unsigned x; int w; LAS unsigned char* lds0;
    volatile LAS unsigned* st;
};

__device__ __forceinline__ XcdBarrier xcd_barrier_post(unsigned* bar, volatile LAS unsigned* st, int wave, LAS unsigned char* lds0) {
    XcdBarrier b; b.bar = bar; b.x = xb_xcc_id(); b.st = st; b.w = wave; b.lds0 = lds0;
    if (b.w == 0 && lane_id_() == 0) (void)xb_add(&bar[XB_XCNT(b.x)], 1u);
    return b;
}
__device__ __forceinline__ void xcd_barrier_complete(unsigned* bar, unsigned x, unsigned& nloc, unsigned& nx) {
    const unsigned G = gridDim.x * gridDim.y * gridDim.z;
    unsigned sum, cnt, mine, sp = 0u;
    for (;;) {
        sum = 0u; cnt = 0u; mine = 0u;
#pragma unroll
        for (unsigned j = 0; j < 16; ++j) { const unsigned c = xb_ld(&bar[XB_XCNT(j)]); sum += c; cnt += (c > 0u) ? 1u : 0u; mine = (j == x) ? c : mine; }
        if (sum == G) break;
        __builtin_amdgcn_s_sleep(1);
        if ((++sp & 255u) == 0u) { if (xb_ld(&bar[XB_TMO])) break; if (sp > XB_SPIN_CAP) { atomicAdd(&bar[XB_TMO], 1u); break; } }
    }
    nloc = mine > 0u ? mine : 1u; nx = cnt > 0u ? cnt : 1u;
}

__device__ __forceinline__ void xcd_barrier(const XcdBarrier& b) {
    asm volatile("s_waitcnt vmcnt(0)" ::: "memory");
    __syncthreads();
    if (wave_id_(b.lds0) == 0 && lane_id_() == 0) {
        unsigned* bar = b.bar;
        __builtin_amdgcn_s_waitcnt(0);
        unsigned nloc = b.st[0], nx = b.st[1];
        if (nloc == 0u) { xcd_barrier_complete(bar, b.x, nloc, nx); b.st[0] = nloc; b.st[1] = nx; }
        const unsigned old = xb_add(&bar[XB_XSUB(b.x)], 1u);
        const unsigned gen = old / nloc;
        if (old + 1u == (gen + 1u) * nloc) {
            __builtin_amdgcn_fence(__ATOMIC_RELEASE, "agent");
            asm volatile("s_waitcnt vmcnt(0)" ::: "memory");
            const unsigned og = xb_add(&bar[XB_TOP], 1u);
            const unsigned tg = og / nx;
            if (og + 1u == (tg + 1u) * nx) xb_add(&bar[XB_TOPGEN], 1u);
            else XB_SPIN(xb_ld(&bar[XB_TOPGEN]) == tg, bar);
            __builtin_amdgcn_fence(__ATOMIC_ACQUIRE, "agent");
            xb_add(&bar[XB_XGEN(b.x)], 1u);
            asm volatile("s_waitcnt vmcnt(0)" ::: "memory");
        } else {
            XB_SPIN(xb_ld(&bar[XB_XGEN(b.x)]) == gen, bar);
            __builtin_amdgcn_fence(__ATOMIC_ACQUIRE, "agent");
            asm volatile("s_waitcnt vmcnt(0)" ::: "memory");
        }
    }
    __syncthreads();
}

struct Args { const float* in[20]; float* out; unsigned char* ws; int ph_lo, ph_hi; };
__device__ __forceinline__ int tid_() { int t = threadIdx.x; asm volatile("" : "+v"(t)); return t; }
__device__ __forceinline__ const float* argp(int i) {
    const __attribute__((address_space(4))) char* ka = (const __attribute__((address_space(4))) char*)__builtin_amdgcn_kernarg_segment_ptr();
    int off = i * 8; asm volatile("" : "+s"(off));
    return *(const float* const __attribute__((address_space(4)))*)(ka + off);
}
__device__ __forceinline__ unsigned char* karg_ptr_(int off) {
    const __attribute__((address_space(4))) char* ka = (const __attribute__((address_space(4))) char*)__builtin_amdgcn_kernarg_segment_ptr();
    asm volatile("" : "+s"(off));
    return *(unsigned char* const __attribute__((address_space(4)))*)(ka + off);
}
struct Frame {
    LAS unsigned char* lds;
    int tid, lane, wave, G;
    float* out; unsigned char* ws;
    __device__ __forceinline__ void ids() { int l_ = lane_id_(); asm volatile("" : "+v"(l_)); lane = l_; wave = wave_id_(lds); tid = wave * 64 + l_; out = (float*)karg_ptr_(160); ws = karg_ptr_(168); }
};
enum { I_X = 0, I_C, I_CTX, I_CCTX, I_NG, I_WADA, I_BADA, I_LB, I_WINE, I_WA2, I_BA2, I_AG, I_BG, I_WOE, I_WINO, I_QG, I_KG, I_LQK, I_CG, I_WOO };

__device__ __forceinline__ void p0_transpose_item(const float* W, int N, int k0, int n0, bf16* WT, int drow0, LAS float* scr, int lane, bool perm128 = false) {
#pragma unroll 8
    for (int i = 0; i < 32; ++i) { const int kk = 2 * i + (lane >> 5); scr[kk * 33 + (lane & 31)] = W[(size_t)(k0 + kk) * N + n0 + (lane & 31)]; }
    asm volatile("s_waitcnt lgkmcnt(0)" ::: "memory");
    const int c = lane & 7;
#pragma unroll
    for (int j = 0; j < 4; ++j) { const int n = (lane >> 3) + 8 * j; const LAS float* s = scr + (8 * c) * 33 + n;
        v4u o; o.x = pk2(s[0 * 33], s[1 * 33]); o.y = pk2(s[2 * 33], s[3 * 33]); o.z = pk2(s[4 * 33], s[5 * 33]); o.w = pk2(s[6 * 33], s[7 * 33]);
        int drow = drow0 + n;
        if (perm128) { const int d = drow & 127; drow = (drow & ~127) + (d >> 6) * 64 + 2 * (d & 31) + ((d >> 5) & 1); }
        *(GAS v4u*)(WT + (size_t)drow * 2048 + k0 + 8 * c) = o; }
    asm volatile("s_waitcnt lgkmcnt(0)" ::: "memory");
}
constexpr int P0_I_E = 32 * 257, P0_I_S = 32 * 64, P0_I_O = 32 * 256;
__device__ __forceinline__ void p0_transposes(Frame& F, int first, int last, int gw, int ngw) {
    LAS float* scr = (LAS float*)(F.lds + F.wave * 16384);
    const float* wine_ = argp(I_WINE); const float* woe_ = argp(I_WOE); const float* wino_ = argp(I_WINO); const float* woo_ = argp(I_WOO);
    for (int it = first + gw; it < last; it += ngw) {
        int r = it;
        if (r < P0_I_E) { const int kb = r / 257, nb = r % 257;
            if (nb < 192) p0_transpose_item(wine_, NE_SRC, 64 * kb, 32 * nb, (bf16*)(F.ws + WS_WIE), 32 * nb, scr, F.lane);
            else if (nb == 192) p0_transpose_item(wine_, NE_SRC, 64 * kb, 32 * nb, (bf16*)(F.ws + WS_WZ), 0, scr, F.lane);
            else p0_transpose_item(wine_, NE_SRC, 64 * kb, 32 * nb, (bf16*)(F.ws + WS_WIE), 32 * nb - 32, scr, F.lane);
            continue; }
        r -= P0_I_E;
        if (r < P0_I_S) { p0_transpose_item(woe_, 2048, 64 * (r / 64), 32 * (r % 64), (bf16*)(F.ws + WS_WOE), 32 * (r % 64), scr, F.lane); continue; }
        r -= P0_I_S;
        if (r < P0_I_O) { p0_transpose_item(wino_, 8192, 64 * (r / 256), 32 * (r % 256), (bf16*)(F.ws + WS_WIO), 32 * (r % 256), scr, F.lane, (r % 256) < 128); continue; }
        r -= P0_I_O;
        p0_transpose_item(woo_, 2048, 64 * (r / 64), 32 * (r % 64), (bf16*)(F.ws + WS_WOO), 32 * (r % 64), scr, F.lane);
    }
}
__device__ __forceinline__ void p0_prologue(Frame& F) {
    if (blockIdx.x < 192) {
        const int l = blockIdx.x / 96, n0 = (blockIdx.x % 96) * 64;
        LAS float* sc = (LAS float*)F.lds;
        LAS float* red = (LAS float*)(F.lds + 9 * 2048 * 4);
        const float* cin_ = argp(I_C); const float* ccx_ = argp(I_CCTX); const float* bada_ = argp(I_BADA);
        for (int i = F.tid; i < 9 * 2048; i += 512) { const int r = i >> 11, k = i & 2047; const float c = (r < 8) ? cin_[r * 2048 + k] : ccx_[k]; sc[i] = siluf_(c); }
        __syncthreads();
        const float* w = argp(I_WADA) + (size_t)l * 2048 * 6144 + n0 + F.lane;
        float acc[9];
#pragma unroll
        for (int r = 0; r < 9; ++r) acc[r] = 0.f;
        const int kb = F.wave * 256;
#pragma unroll 2
        for (int k = 0; k < 256; k += 4) {
            float wv[4];
#pragma unroll
            for (int i = 0; i < 4; ++i) wv[i] = w[(size_t)(kb + k + i) * 6144];
#pragma unroll
            for (int r = 0; r < 9; ++r) { const f32x4 s = *(const LAS f32x4*)(sc + r * 2048 + kb + k); acc[r] += s[0] * wv[0] + s[1] * wv[1] + s[2] * wv[2] + s[3] * wv[3]; }
        }
#pragma unroll
        for (int r = 0; r < 9; ++r) red[(F.wave * 9 + r) * 64 + F.lane] = acc[r];
        __syncthreads();
        for (int t = F.tid; t < 576; t += 512) { const int r = t >> 6, c = t & 63; float s = 0.f;
#pragma unroll
            for (int wv = 0; wv < 8; ++wv) s += red[(wv * 9 + r) * 64 + c];
            ((float*)(F.ws + WS_MOD))[(size_t)(l * 9 + r) * 6144 + n0 + c] = s + bada_[l * 6144 + n0 + c]; }
        __syncthreads();
    }
    if (blockIdx.x == F.G - 1) {
        const float* lbp_ = argp(I_LB);
        for (int cc = F.tid; cc < 1024; cc += 512) { const float l0 = lbp_[cc], l1 = lbp_[1024 + cc], l2 = lbp_[2048 + cc]; const float mx = fmaxf(l0, fmaxf(l1, l2));
            const float e0 = __expf(l0 - mx), e1 = __expf(l1 - mx), e2 = __expf(l2 - mx); ((float*)(F.ws + WS_LBT))[cc] = e0 / (e0 + e1 + e2); }
    }
    if (blockIdx.x == F.G - 2) {
        for (int t = F.tid; t < 2048; t += 512) { const int pos = t >> 5, i = t & 31; float sn, cs; sincos_((float)pos * exp2f(-(float)i * (13.287712379549449f / 32.f)), sn, cs);
            ((float*)(F.ws + WS_ROPE))[2 * t] = cs; ((float*)(F.ws + WS_ROPE))[2 * t + 1] = sn; }
    }
    p0_transposes(F, 0, P0_I_E + P0_I_S + P0_I_O + P0_I_S, blockIdx.x * NWAVES + F.wave, F.G * NWAVES);
}

__device__ __forceinline__ void modulate_phase(Frame& F, int l, const float* xsrc, const float* csrc) {
    const int gw = blockIdx.x * NWAVES + F.wave, NGW = F.G * NWAVES;
    const float* gain = argp(I_NG) + l * 2048;
    bf16* H = (bf16*)(F.ws + WS_H);
    f32x4 v[8];
    { const int b = gw / LTOK, t = gw - b * LTOK; const float* src = (t < NCTX) ? csrc + ((size_t)b * NCTX + t) * DM : xsrc + ((size_t)b * SEQ + (t - NCTX)) * DM;
#pragma unroll
      for (int j = 0; j < 8; ++j) v[j] = *(const f32x4*)(src + (F.lane + 64 * j) * 4); }
    for (int m = gw; m < MROWS; m += NGW) {
        const int b = m / LTOK, t = m - b * LTOK;
        const float* mod = (const float*)(F.ws + WS_MOD) + (size_t)(l * 9 + ((t < NCTX) ? 8 : b)) * 6144;
        f32x4 vn[8];
        { const int mn = (m + NGW < MROWS) ? m + NGW : m; const int bn = mn / LTOK, tn = mn - bn * LTOK;
          const float* srcn = (tn < NCTX) ? csrc + ((size_t)bn * NCTX + tn) * DM : xsrc + ((size_t)bn * SEQ + (tn - NCTX)) * DM;
#pragma unroll
          for (int j = 0; j < 8; ++j) vn[j] = *(const f32x4*)(srcn + (F.lane + 64 * j) * 4); }
        float ss = 0.f;
#pragma unroll
        for (int j = 0; j < 8; ++j) ss += (v[j].x * v[j].x + v[j].y * v[j].y) + (v[j].z * v[j].z + v[j].w * v[j].w);
        const float rstd = rsqrtf(wave_sum(ss) * (1.f / DM) + EPS);
#pragma unroll
        for (int j = 0; j < 8; ++j) { const int col = (F.lane + 64 * j) * 4;
            const f32x4 g = *(const f32x4*)(gain + col), sh = *(const f32x4*)(mod + col), sl = *(const f32x4*)(mod + 2048 + col);
            const f32x4 y = (v[j] * rstd) * g * (sl + 1.f) + sh;
            v2u o; o.x = pg8::cvt_pk_bf16(y.x, y.y); o.y = pg8::cvt_pk_bf16(y.z, y.w);
            *(v2u*)(H + (size_t)m * DM + col) = o; }
#pragma unroll
        for (int j = 0; j < 8; ++j) v[j] = vn[j];
    }
}

__device__ __forceinline__ void modulate_phase_b(Frame& F, int l, int m_lo, int m_hi, int gw, int NGW) {
    const float* gain = argp(I_NG) + l * 2048;
    bf16* H = (bf16*)(F.ws + WS_H);
    const bf16* xa = (const bf16*)(F.ws + WS_X1A); const bf16* xb = (const bf16*)(F.ws + WS_X1B); const bf16* cb = (const bf16*)(F.ws + WS_C1B);
#define MODB_SRC(m_) ({ const int b_ = (m_) / LTOK, t_ = (m_) - b_ * LTOK; const int r_ = b_ * SEQ + (t_ - NCTX); \
        (t_ < NCTX) ? cb + ((size_t)b_ * NCTX + t_) * DM : (r_ < 8192 ? xa + (size_t)r_ * DM : xb + (size_t)(r_ - 8192) * DM); })
    v2u v[8];
    { const bf16* src = MODB_SRC((m_lo + gw < m_hi) ? m_lo + gw : m_lo);
#pragma unroll
      for (int j = 0; j < 8; ++j) v[j] = *(const v2u*)(src + (F.lane + 64 * j) * 4); }
    for (int m = m_lo + gw; m < m_hi; m += NGW) {
        const int b = m / LTOK, t = m - b * LTOK;
        const float* mod = (const float*)(F.ws + WS_MOD) + (size_t)(l * 9 + ((t < NCTX) ? 8 : b)) * 6144;
        v2u vn[8];
        { const int mn = (m + NGW < m_hi) ? m + NGW : m; const bf16* srcn = MODB_SRC(mn);
#pragma unroll
          for (int j = 0; j < 8; ++j) vn[j] = *(const v2u*)(srcn + (F.lane + 64 * j) * 4); }
        f32x4 x[8]; float ss = 0.f;
#pragma unroll
        for (int j = 0; j < 8; ++j) { x[j] = (f32x4){bflo(v[j].x), bfhi(v[j].x), bflo(v[j].y), bfhi(v[j].y)}; ss += (x[j].x * x[j].x + x[j].y * x[j].y) + (x[j].z * x[j].z + x[j].w * x[j].w); }
        const float rstd = rsqrtf(wave_sum(ss) * (1.f / DM) + EPS);
#pragma unroll
        for (int j = 0; j < 8; ++j) { const int col = (F.lane + 64 * j) * 4;
            const f32x4 g = *(const f32x4*)(gain + col), sh = *(const f32x4*)(mod + col), sl = *(const f32x4*)(mod + 2048 + col);
            const f32x4 y = (x[j] * rstd) * g * (sl + 1.f) + sh;
            v2u o; o.x = pg8::cvt_pk_bf16(y.x, y.y); o.y = pg8::cvt_pk_bf16(y.z, y.w);
            *(v2u*)(H + (size_t)m * DM + col) = o; }
#pragma unroll
        for (int j = 0; j < 8; ++j) v[j] = vn[j];
    }
#undef MODB_SRC
}

__device__ __forceinline__ void zgemm_phase(Frame& F) {
    const bf16* H = (const bf16*)(F.ws + WS_H); const bf16* WZ = (const bf16*)(F.ws + WS_WZ); unsigned short* LAo = (unsigned short*)(F.ws + WS_LA);
    const int fr = F.lane & 15, fq = F.lane >> 4, wave = F.wave, dir = wave >> 2, rgrp = wave & 3;
    LAS float* red = (LAS float*)F.lds;
    LAS float* zf = (LAS float*)(F.lds + 16384);
    f32x4 w0[16], w1[16];
    const float* wp = argp(I_WA2) + (size_t)dir * 16 * 512 + F.lane * 8; const float* bp = argp(I_BA2) + dir * 512 + F.lane * 8;
#pragma unroll
    for (int rr = 0; rr < 16; ++rr) { w0[rr] = *(const f32x4*)(wp + rr * 512); w1[rr] = *(const f32x4*)(wp + rr * 512 + 4); }
    const f32x4 b0 = *(const f32x4*)bp, b1 = *(const f32x4*)(bp + 4);
    for (int u = blockIdx.x; u < MROWS / 16; u += F.G) {
        const bf16* ap = H + (size_t)(u * 16 + fr) * DM + wave * 256 + 8 * fq; const bf16* b0p = WZ + (size_t)fr * DM + wave * 256 + 8 * fq; const bf16* b1p = WZ + (size_t)(16 + fr) * DM + wave * 256 + 8 * fq;
        f32x4 a0 = {0.f, 0.f, 0.f, 0.f}, a1 = {0.f, 0.f, 0.f, 0.f};
#pragma unroll
        for (int hf = 0; hf < 2; ++hf) {
            bf16x8 av[4], bv0[4], bv1[4];
#pragma unroll
            for (int k = 0; k < 4; ++k) { av[k] = *(const bf16x8*)(ap + (hf * 4 + k) * 32); bv0[k] = *(const bf16x8*)(b0p + (hf * 4 + k) * 32); bv1[k] = *(const bf16x8*)(b1p + (hf * 4 + k) * 32); }
#pragma unroll
            for (int k = 0; k < 4; ++k) { a0 = __builtin_amdgcn_mfma_f32_16x16x32_bf16(av[k], bv0[k], a0, 0, 0, 0); a1 = __builtin_amdgcn_mfma_f32_16x16x32_bf16(av[k], bv1[k], a1, 0, 0, 0); }
        }
#pragma unroll
        for (int i = 0; i < 4; ++i) { red[wave * 512 + (fq * 4 + i) * 32 + fr] = a0[i]; red[wave * 512 + (fq * 4 + i) * 32 + 16 + fr] = a1[i]; }
        __syncthreads();
        { float zs = 0.f;
#pragma unroll
          for (int w8 = 0; w8 < 8; ++w8) zs += red[w8 * 512 + F.tid];
          zf[F.tid] = zs; }
        __syncthreads();
#pragma unroll 2
        for (int rr = 0; rr < 4; ++rr) { const int row = rgrp * 4 + rr;
            f32x4 x0 = b0, x1 = b1;
#pragma unroll
            for (int r4 = 0; r4 < 4; ++r4) { const f32x4 zz = *(const LAS f32x4*)(zf + row * 32 + dir * 16 + r4 * 4);
#pragma unroll
                for (int e = 0; e < 4; ++e) { x0 += zz[e] * w0[r4 * 4 + e]; x1 += zz[e] * w1[r4 * 4 + e]; } }
            typedef _Float16 h8 __attribute__((ext_vector_type(8)));
            h8 hv;
#pragma unroll
            for (int e = 0; e < 4; ++e) {
                const float y0 = x0[e] * 1.4426950408889634f, y1 = x1[e] * 1.4426950408889634f;
                hv[e] = (_Float16)((fminf(y0, 0.f) - __builtin_amdgcn_logf(1.f + __builtin_amdgcn_exp2f(-fabsf(y0)))) * (1.f / 16.f)); hv[4 + e] = (_Float16)((fminf(y1, 0.f) - __builtin_amdgcn_logf(1.f + __builtin_amdgcn_exp2f(-fabsf(y1)))) * (1.f / 16.f)); }
            *(h8*)(LAo + (size_t)(u * 16 + row) * 1024 + dir * 512 + F.lane * 8) = hv;
        }
    }
}

#ifndef PROBE_SC
#define PROBE_SC 0
#endif
#ifndef PROBE_SC_BLOCK
#define PROBE_SC_BLOCK 0
#endif
#ifndef PROBE_SC_WAVE
#define PROBE_SC_WAVE 0
#endif
#if PROBE_SC
#define SC_ON(id) do { if (PROBE_SC == (id)) sc_t0 = __builtin_amdgcn_s_memtime(); } while (0)
#define SC_OFF(id) do { if (PROBE_SC == (id)) sc_acc += __builtin_amdgcn_s_memtime() - sc_t0; } while (0)
#else
#define SC_ON(id) do { } while (0)
#define SC_OFF(id) do { } while (0)
#endif
namespace sc2 {
constexpr int QD_OFF = 0, KI_OFF = 8704, KT_OFF = 17408, VT_OFF = 25600, DEC_OFF = 33792, BUF_BYTES = 34816, W_OFF = 2 * BUF_BYTES, C_OFF = W_OFF + 8192, J_OFF = C_OFF + 512, SC2_TOUCH = 6;
constexpr int ROWB = 272;
typedef float f32x16 __attribute__((ext_vector_type(16)));
typedef short s16x4 __attribute__((ext_vector_type(4)));
__device__ __forceinline__ int crow(int r, int hi) { return (r & 3) + 8 * (r >> 2) + 4 * hi; }
template <int OFF> __device__ __forceinline__ s16x4 tr_read(unsigned a) { s16x4 r; asm volatile("ds_read_b64_tr_b16 %0, %1 offset:%2" : "=&v"(r) : "v"(a), "i"(OFF) : "memory"); return r; }
struct Raw { v4u q, k, v, la; };
}
__device__ __forceinline__ void scan_phase_v2(Frame& F, bf16* OF, bf16* OB) {
    using namespace sc2;
#if PROBE_SC
    unsigned long long sc_acc = 0, sc_t0 = 0;
#endif
    const bf16* P = (const bf16*)(F.ws + WS_P); const unsigned short* LA = (const unsigned short*)(F.ws + WS_LA);
    const int lane = F.lane, wave = F.wave;
    const int r = lane & 31, h = lane >> 5;
    for (int u = blockIdx.x; u < 256; u += F.G) {
        const bool isA = u < 128; const int uu = isA ? u : u - 128;
        int b, hd, dir, vh;
        if (isA) { b = uu >> 4; hd = (uu >> 1) & 7; dir = uu & 1; vh = 0; } else { b = uu >> 4; hd = (uu >> 2) & 3; dir = (uu >> 1) & 1; vh = uu & 1; }
        const int qcol = isA ? EC_AQ + hd * 128 : EC_BQ + hd * 128;
        const int kcol = isA ? (dir ? EC_AFB : EC_AFF) + hd * 128 : EC_BK + hd * 128;
        const int vcol = isA ? EC_AI + hd * 128 : EC_BV + hd * 256 + vh * 128;
        const int ocol = isA ? hd * 128 : 1024 + hd * 256 + vh * 128;
        bf16* OUT = dir ? OB : OF;
        const size_t rowb = (size_t)b * LTOK;
        SC_ON(5);
        __syncthreads();
#define SC2_TOK(ch, tb, ts) do { const int i0_ = (ch) * 32; if (!dir) { tb = i0_; ts = 1; } else { tb = (i0_ < NCTX) ? (NCTX - 1 - i0_) : (LTOK - 1 - (i0_ - NCTX)); ts = -1; } } while (0)
        if (wave >= 4) {
            const int pw = wave - 4;
            Raw cur[2], nxt[2];
#define SC2_LOAD(dst, ch) do { int tb_, ts_; SC2_TOK(ch, tb_, ts_); const size_t row_ = rowb + tb_ + ts_ * r; \
                _Pragma("unroll") for (int ps = 0; ps < 2; ++ps) { const int d0 = (pw * 4 + ps * 2 + h) * 8; \
                    dst[ps].q = *(const v4u*)(P + row_ * LDP + qcol + d0); dst[ps].k = *(const v4u*)(P + row_ * LDP + kcol + d0); dst[ps].v = *(const v4u*)(P + row_ * LDP + vcol + d0); } \
                if (!isA) { _Pragma("unroll") for (int ps = 0; ps < 2; ++ps) dst[ps].la = *(const v4u*)(LA + row_ * 1024 + dir * 512 + hd * 128 + (pw * 4 + ps * 2 + h) * 8); } } while (0)
#define SC2_FILL(src, bi) do { LAS unsigned char* bb_ = F.lds + (bi) * BUF_BYTES; \
                _Pragma("unroll") for (int ps = 0; ps < 2; ++ps) { const int dg = pw * 4 + ps * 2 + h, d0 = dg * 8; \
                    float q8[8], k8[8], la[8]; unpack8(src[ps].q, q8); unpack8(src[ps].k, k8); \
                    if (isA) { typedef _Float16 h8a_ __attribute__((ext_vector_type(8))); const h8a_ lh_ = __builtin_bit_cast(h8a_, src[ps].k);     \
                        _Pragma("unroll") for (int e = 0; e < 8; ++e) { la[e] = (float)lh_[e]; k8[e] = 1.f - __builtin_amdgcn_exp2f(la[e]); } } \
                    else { typedef _Float16 h8_ __attribute__((ext_vector_type(8))); const h8_ lh_ = __builtin_bit_cast(h8_, src[ps].la); \
                        _Pragma("unroll") for (int e = 0; e < 8; ++e) la[e] = (float)lh_[e]; } \
                      \
                    _Pragma("unroll") for (int e = 0; e < 8; ++e) { float x_ = la[e]; \
                        x_ += __int_as_float(__builtin_amdgcn_update_dpp(0, __float_as_int(x_), 0x111, 0xf, 0xf, true)); x_ += __int_as_float(__builtin_amdgcn_update_dpp(0, __float_as_int(x_), 0x112, 0xf, 0xf, true)); \
                        x_ += __int_as_float(__builtin_amdgcn_update_dpp(0, __float_as_int(x_), 0x114, 0xf, 0xf, true)); x_ += __int_as_float(__builtin_amdgcn_update_dpp(0, __float_as_int(x_), 0x118, 0xf, 0xf, true)); \
                        x_ += __int_as_float(__builtin_amdgcn_update_dpp(0, __float_as_int(x_), 0x142, 0xa, 0xf, true)); la[e] = x_; } \
                    float qd[8], ki[8], kt[8]; \
                    float ebv[8]; \
                    _Pragma("unroll") for (int e = 0; e < 8; ++e) { const float eb = __builtin_amdgcn_exp2f(la[e]); const float ebl = __shfl(eb, 31, 32); const float ei = __builtin_amdgcn_rcpf(eb); qd[e] = q8[e] * eb; ki[e] = k8[e] * ei; kt[e] = ki[e] * ebl; ebv[e] = eb; } \
                    if (r == 31) { *(LAS f32x4*)(bb_ + DEC_OFF + d0 * 4) = (f32x4){ebv[0], ebv[1], ebv[2], ebv[3]}; *(LAS f32x4*)(bb_ + DEC_OFF + d0 * 4 + 16) = (f32x4){ebv[4], ebv[5], ebv[6], ebv[7]}; } \
                    *(LAS v4u*)(bb_ + QD_OFF + r * ROWB + d0 * 2) = pack8c(qd); *(LAS v4u*)(bb_ + KI_OFF + r * ROWB + d0 * 2) = pack8c(ki); \
                    *(LAS v4u*)(bb_ + KT_OFF + (dg >> 2) * 2048 + r * 64 + (dg & 3) * 16) = pack8c(kt); \
                    *(LAS v4u*)(bb_ + VT_OFF + (dg >> 2) * 2048 + r * 64 + (dg & 3) * 16) = src[ps].v; __builtin_amdgcn_sched_barrier(0); } } while (0)
            SC2_LOAD(cur, 0);
            SC2_LOAD(nxt, 1);
            SC2_FILL(cur, 0);
            __syncthreads();
            for (int ch = 0; ch < LTOK / 32; ch += 2) {
                if (ch + 2 < LTOK / 32) SC2_LOAD(cur, ch + 2);
                SC_ON(2); SC2_FILL(nxt, (ch + 1) & 1); SC_OFF(2);
                SC_ON(1); asm volatile("s_waitcnt lgkmcnt(0)\n\ts_barrier" ::: "memory"); SC_OFF(1);
                if (ch + 3 < LTOK / 32) SC2_LOAD(nxt, ch + 3);
                SC_ON(2); if (ch + 2 < LTOK / 32) SC2_FILL(cur, ch & 1); SC_OFF(2);
                SC_ON(1); asm volatile("s_waitcnt lgkmcnt(0)\n\ts_barrier" ::: "memory"); SC_OFF(1);
            }
#undef SC2_LOAD
#undef SC2_FILL
        } else {
            const int cw = wave;
            f32x16 S[4];
#pragma unroll
            for (int dt = 0; dt < 4; ++dt) S[dt] = (f32x16){};
            const int q4 = (lane & 15) >> 2, p4 = lane & 3, blk = (lane >> 4) & 1;
            const unsigned trl = (unsigned)(q4 * 64 + (16 * blk + 4 * p4) * 2);
            __syncthreads();
            for (int ch = 0; ch < LTOK / 32; ++ch) {
                LAS unsigned char* bb = F.lds + (ch & 1) * BUF_BYTES;
                const unsigned bba = (unsigned)(size_t)bb;
                f32x16 X = (f32x16){};
#pragma unroll
                for (int kk = 0; kk < 8; ++kk) {
                    const bf16x8 a = *(const LAS bf16x8*)(bb + KI_OFF + r * ROWB + (16 * kk + 8 * h) * 2), bq = *(const LAS bf16x8*)(bb + QD_OFF + r * ROWB + (16 * kk + 8 * h) * 2);
                    X = __builtin_amdgcn_mfma_f32_32x32x16_bf16(a, bq, X, 0, 0, 0);
                }
#pragma unroll
                for (int g = 0; g < 16; ++g) X[g] = (r >= crow(g, h)) ? X[g] : 0.f;
                v4u xa0, xa1;
                xa0.x = pg8::cvt_pk_bf16(X[0], X[1]); xa0.y = pg8::cvt_pk_bf16(X[2], X[3]); xa0.z = pg8::cvt_pk_bf16(X[4], X[5]); xa0.w = pg8::cvt_pk_bf16(X[6], X[7]);
                xa1.x = pg8::cvt_pk_bf16(X[8], X[9]); xa1.y = pg8::cvt_pk_bf16(X[10], X[11]); xa1.z = pg8::cvt_pk_bf16(X[12], X[13]); xa1.w = pg8::cvt_pk_bf16(X[14], X[15]);
                const unsigned vta = bba + VT_OFF + cw * 2048 + trl;
                s16x4 vp00 = tr_read<0>(vta + (4 * h) * 64), vp01 = tr_read<0>(vta + (8 + 4 * h) * 64), vp10 = tr_read<0>(vta + (16 + 4 * h) * 64), vp11 = tr_read<0>(vta + (24 + 4 * h) * 64);
                s16x4 vn00 = tr_read<0>(vta + (8 * h) * 64), vn01 = tr_read<0>(vta + (8 * h + 4) * 64), vn10 = tr_read<0>(vta + (16 + 8 * h) * 64), vn11 = tr_read<0>(vta + (16 + 8 * h + 4) * 64);
                asm volatile("s_waitcnt lgkmcnt(0)" ::: "memory"); __builtin_amdgcn_sched_barrier(0);
#define SC2_PK(L, H) (bf16x8){L[0], L[1], L[2], L[3], H[0], H[1], H[2], H[3]}
                f32x16 o = (f32x16){};
                o = __builtin_amdgcn_mfma_f32_32x32x16_bf16(__builtin_bit_cast(bf16x8, xa0), SC2_PK(vp00, vp01), o, 0, 0, 0);
                o = __builtin_amdgcn_mfma_f32_32x32x16_bf16(__builtin_bit_cast(bf16x8, xa1), SC2_PK(vp10, vp11), o, 0, 0, 0);
#pragma unroll
                for (int dt = 0; dt < 4; ++dt)
#pragma unroll
                    for (int ks = 0; ks < 2; ++ks) {
                        const LAS unsigned char* qp = bb + QD_OFF + r * ROWB + (32 * dt + 16 * ks + 4 * h) * 2;
                        const s16x4 a0 = *(const LAS s16x4*)qp, a1 = *(const LAS s16x4*)(qp + 16);
                        v4u sb; sb.x = pg8::cvt_pk_bf16(S[dt][8 * ks + 0], S[dt][8 * ks + 1]); sb.y = pg8::cvt_pk_bf16(S[dt][8 * ks + 2], S[dt][8 * ks + 3]);
                        sb.z = pg8::cvt_pk_bf16(S[dt][8 * ks + 4], S[dt][8 * ks + 5]); sb.w = pg8::cvt_pk_bf16(S[dt][8 * ks + 6], S[dt][8 * ks + 7]);
                        o = __builtin_amdgcn_mfma_f32_32x32x16_bf16(SC2_PK(a0, a1), __builtin_bit_cast(bf16x8, sb), o, 0, 0, 0);
                    }
#pragma unroll
                for (int dt = 0; dt < 4; ++dt) {
                    const unsigned kta = bba + KT_OFF + dt * 2048 + trl;
                    s16x4 k00 = tr_read<0>(kta + (8 * h) * 64), k01 = tr_read<0>(kta + (8 * h + 4) * 64), k10 = tr_read<0>(kta + (16 + 8 * h) * 64), k11 = tr_read<0>(kta + (16 + 8 * h + 4) * 64);
#pragma unroll
                    for (int g = 0; g < 4; ++g) { const f32x4 dc = *(const LAS f32x4*)(bb + DEC_OFF + (32 * dt + 8 * g + 4 * h) * 4);
                        S[dt][4 * g + 0] *= dc[0]; S[dt][4 * g + 1] *= dc[1]; S[dt][4 * g + 2] *= dc[2]; S[dt][4 * g + 3] *= dc[3]; }
                    asm volatile("s_waitcnt lgkmcnt(0)" ::: "memory"); __builtin_amdgcn_sched_barrier(0);
                    S[dt] = __builtin_amdgcn_mfma_f32_32x32x16_bf16(SC2_PK(k00, k01), SC2_PK(vn00, vn01), S[dt], 0, 0, 0);
                    S[dt] = __builtin_amdgcn_mfma_f32_32x32x16_bf16(SC2_PK(k10, k11), SC2_PK(vn10, vn11), S[dt], 0, 0, 0);
                }
#undef SC2_PK
                int tb, ts; SC2_TOK(ch, tb, ts);
#pragma unroll
                for (int g = 0; g < 16; g += 2) {
                    bf16* ob_ = OUT + (rowb + tb) * DM + ocol + cw * 32; const int lo_ = (ts * 4 * h) * DM + r; const unsigned pk_ = cvtpk_c(o[g], o[g + 1]);
                    ob_[lo_ + ts * (((g & 3) + 8 * (g >> 2)) * DM)] = (bf16)(pk_ & 0xffffu);
                    ob_[lo_ + ts * ((((g + 1) & 3) + 8 * ((g + 1) >> 2)) * DM)] = (bf16)(pk_ >> 16); }
                if (ch + SC2_TOUCH < LTOK / 32) { int tb2, ts2; SC2_TOK(ch + SC2_TOUCH, tb2, ts2);
                    const int ti = cw * 64 + lane, trw = ti & 31, tw = ti >> 5;
                    const size_t trow = rowb + tb2 + ts2 * trw;
                    const char* tp = (tw < 6) ? (const char*)(P + trow * LDP + (tw < 2 ? qcol : tw < 4 ? kcol : vcol)) + (tw & 1) * 128 : (const char*)(LA + trow * 1024 + dir * 512 + hd * 128) + (tw & 1) * 128;
                    if (tw < 6 || !isA) __builtin_amdgcn_global_load_lds((const unsigned*)tp, (LAS unsigned*)(F.lds + J_OFF + cw * 256), 4, 0, 0); }
                SC_ON(1); asm volatile("s_waitcnt lgkmcnt(0)\n\ts_barrier" ::: "memory"); SC_OFF(1);
            }
            asm volatile("s_waitcnt vmcnt(0)" ::: "memory");
        }
#undef SC2_TOK
        __syncthreads();
        SC_OFF(5);
    }
    if (false && F.G == 256 && blockIdx.x >= 128) {
        p0_transposes(F, P0_I_E + P0_I_S, P0_I_E + P0_I_S + P0_I_O + P0_I_S, ((int)blockIdx.x - 128) * NWAVES + F.wave, 128 * NWAVES); }
#if PROBE_SC
    if (PROBE_SC_BLOCK == 999 && wave == PROBE_SC_WAVE && lane == 0) atomicMax((unsigned*)(F.ws + WS_CTL) + 9216, (unsigned)sc_acc);
    if ((PROBE_SC_BLOCK == 1000 || blockIdx.x == PROBE_SC_BLOCK) && wave == PROBE_SC_WAVE) { const unsigned long long t0_ = __builtin_amdgcn_s_memtime(); while (__builtin_amdgcn_s_memtime() - t0_ < sc_acc) __builtin_amdgcn_s_sleep(8); }
#endif
}

__device__ __forceinline__ void evengate_phase(Frame& F, const bf16* OF) {
    const int gw = blockIdx.x * NWAVES + F.wave, NGW = F.G * NWAVES;
    bf16* Y = (bf16*)(F.ws + WS_H); const bf16* P = (const bf16*)(F.ws + WS_P);
    const float* agp_ = argp(I_AG); const float* bgp_ = argp(I_BG);
    for (int m = gw; m < MROWS; m += NGW) {
        v4u ra[4], rb[4], rg[4];
#pragma unroll
        for (int j = 0; j < 4; ++j) { const int col = j * 512 + F.lane * 8;
            ra[j] = *(const v4u*)(OF + (size_t)m * DM + col); rb[j] = *(const v4u*)(Y + (size_t)m * DM + col); rg[j] = *(const v4u*)(P + (size_t)m * LDP + EC_GATE + col); }
#pragma unroll
        for (int j = 0; j < 4; ++j) {
            const int col = j * 512 + F.lane * 8;
            float a[8], bb[8], g[8];
            unpack8(ra[j], a); unpack8(rb[j], bb); unpack8(rg[j], g);
            float ss = 0.f;
#pragma unroll
            for (int e = 0; e < 8; ++e) { a[e] += bb[e]; ss += a[e] * a[e]; }
            ss += __shfl_xor(ss, 1); ss += __shfl_xor(ss, 2); ss += __shfl_xor(ss, 4); ss += __shfl_xor(ss, 8);
            float rstd; const float* gn;
            if (j < 2) { rstd = rsqrtf(ss * (1.f / 128.f) + EPS); gn = agp_ + (col & 127); }
            else { ss += __shfl_xor(ss, 16); rstd = rsqrtf(ss * (1.f / 256.f) + EPS); gn = bgp_ + (col & 255); }
            float y[8];
#pragma unroll
            for (int e = 0; e < 8; ++e) y[e] = a[e] * rstd * gn[e] * siluf_(g[e]);
            *(v4u*)(Y + (size_t)m * DM + col) = pack8c(y);
        }
    }
}

namespace at2 {
constexpr int STAGE = 65536, K0_OFF = 0, K1_OFF = 16384, V_OFF = 32768, XW_OFF = 131072 + 1024;
typedef float f32x16 __attribute__((ext_vector_type(16)));
typedef short s16x4 __attribute__((ext_vector_type(4)));
__device__ __forceinline__ int crow(int r, int hi) { return (r & 3) + 8 * (r >> 2) + 4 * hi; }
template <int OFF> __device__ __forceinline__ s16x4 tr_read(unsigned a) { s16x4 r; asm volatile("ds_read_b64_tr_b16 %0, %1 offset:%2" : "=&v"(r) : "v"(a), "i"(OFF) : "memory"); return r; }
constexpr int v_rd_off(int d0, int ks, int half) { return d0 * 512 + ks * 8192 + half * 4096; }
template <int D0> __device__ __forceinline__ void pv_one(f32x16& od, unsigned vb, bf16x8 pa0, bf16x8 pa1, bf16x8 pa2, bf16x8 pa3) {
    const s16x4 l0 = tr_read<v_rd_off(D0, 0, 0)>(vb), h0 = tr_read<v_rd_off(D0, 0, 1)>(vb), l1 = tr_read<v_rd_off(D0, 1, 0)>(vb), h1 = tr_read<v_rd_off(D0, 1, 1)>(vb);
    const s16x4 l2 = tr_read<v_rd_off(D0, 2, 0)>(vb), h2 = tr_read<v_rd_off(D0, 2, 1)>(vb), l3 = tr_read<v_rd_off(D0, 3, 0)>(vb), h3 = tr_read<v_rd_off(D0, 3, 1)>(vb);
    asm volatile("s_waitcnt lgkmcnt(0)" ::: "memory"); __builtin_amdgcn_sched_barrier(0);
#define AT2_PK(L, H) (bf16x8){L[0], L[1], L[2], L[3], H[0], H[1], H[2], H[3]}
    od = __builtin_amdgcn_mfma_f32_32x32x16_bf16(pa0, AT2_PK(l0, h0), od, 0, 0, 0);
    od = __builtin_amdgcn_mfma_f32_32x32x16_bf16(pa1, AT2_PK(l1, h1), od, 0, 0, 0);
    od = __builtin_amdgcn_mfma_f32_32x32x16_bf16(pa2, AT2_PK(l2, h2), od, 0, 0, 0);
    od = __builtin_amdgcn_mfma_f32_32x32x16_bf16(pa3, AT2_PK(l3, h3), od, 0, 0, 0);
#undef AT2_PK
}
}
#ifndef PROBE_SW
#define PROBE_SW 0
#endif
#ifndef PROBE_SW_WAVE
#define PROBE_SW_WAVE 0
#endif
#if PROBE_SW
#define SW_ON(id) do { if (PROBE_SW == (id)) sw_t0 = __builtin_amdgcn_s_memtime(); } while (0)
#define SW_OFF(id) do { if (PROBE_SW == (id)) sw_acc += __builtin_amdgcn_s_memtime() - sw_t0; } while (0)
#else
#define SW_ON(id) do { } while (0)
#define SW_OFF(id) do { } while (0)
#endif
__device__ __forceinline__ void attn_phase_v2(Frame& F) {
    using namespace at2;
#if PROBE_SW
    unsigned long long sw_acc = 0, sw_t0 = 0;
#endif
    const bf16* P = (const bf16*)(F.ws + WS_P); bf16* Y2 = (bf16*)(F.ws + WS_O0);
    const int lane = F.lane, wave = F.wave, r32 = lane & 31, hi = lane >> 5, mp = wave >> 2, wq = wave & 3;
    float gqm, gkm;
    { const float* qg = argp(I_QG); const float* kg = argp(I_KG); float a = fmaxf(fabsf(qg[lane]), fabsf(qg[64 + lane])), c = fmaxf(fabsf(kg[lane]), fabsf(kg[64 + lane]));
#pragma unroll
      for (int o = 1; o < 64; o <<= 1) { a = fmaxf(a, __shfl_xor(a, o)); c = fmaxf(c, __shfl_xor(c, o)); }
      gqm = a; gkm = c; }
    const float negBl = __builtin_bit_cast(float, __builtin_amdgcn_readfirstlane(__builtin_bit_cast(int, -(1.4426950408889634f * 11.313708498984761f * 1.02f) * gqm * gkm)));
    const unsigned vrd = (unsigned)(((lane & 3) << 3) | (((lane >> 2) & 3) << 6) | (((lane >> 4) & 1) << 5) | (((lane >> 5) & 1) << 8));
    const unsigned ldsb = (unsigned)(size_t)F.lds;
    LAS float* xw = (LAS float*)(F.lds + XW_OFF) + wave * 64;
    int vidx;
    { const volatile LAS unsigned* misc_ = (const volatile LAS unsigned*)(F.lds + MISC_OFF); const unsigned rk = misc_[10], xc = misc_[11];
      const unsigned* bw = (const unsigned*)(F.ws + WS_CTL) + CW_BAR;
      unsigned c = (lane < 16) ? __hip_atomic_load(bw + XB_XCNT(lane), __ATOMIC_RELAXED, __HIP_MEMORY_SCOPE_AGENT) : 0u;
      c = ((unsigned)lane < xc) ? c : 0u;
#pragma unroll
      for (int o_ = 1; o_ < 16; o_ <<= 1) c += __shfl_xor(c, o_);
      vidx = __builtin_amdgcn_readfirstlane((int)(c + rk)); if (vidx >= F.G || vidx < 0) vidx = blockIdx.x; }
#ifndef ATT_REP
#define ATT_REP 1
#endif
    for (int rd_ = 0; rd_ * F.G + vidx < 1024 * ATT_REP; ++rd_) {
        const int rd = rd_ % (1024 / (F.G > 1024 ? 1024 : F.G));
        int b, h, qb;
        { const int u = rd * F.G + vidx; b = u >> 7; h = (u >> 4) & 7; qb = u & 15; }
        SW_ON(8);
        const char* Kg = (const char*)(P + (size_t)b * LTOK * LDP + OC_K + h * 256);
        const char* Vg = (const char*)(P + (size_t)b * LTOK * LDP + OC_V + h * 256);
#define AT2_DMA4(isK, t) do { const bool k_ = (isK); const int stg_ = (t) & 1; const char* gb_ = (k_ ? Kg : Vg) + (size_t)(t) * 64 * LDP * 2; \
        int ln_ = lane; asm volatile("" : "+v"(ln_)); unsigned vo_; \
        { const int jk_ = wave * 64 + ln_, rowk_ = jk_ >> 4, cck_ = (jk_ & 15) ^ (rowk_ & 7); const unsigned ks_ = (unsigned)(rowk_ * (LDP * 2) + cck_ * 16); \
          const int jv_ = (4 * wave) * 64 + ln_, st_ = jv_ >> 5, krow_ = (jv_ & 31) >> 2, cch_ = jv_ & 3, kk_ = (st_ >> 3) * 8 + krow_, key_ = (kk_ & ~0xC) | ((kk_ & 4) << 1) | ((kk_ & 8) >> 1); \
          const unsigned vs_ = (unsigned)(key_ * (LDP * 2) + ((st_ & 7) * 32 + cch_ * 8) * 2); vo_ = k_ ? ks_ : vs_; } \
        _Pragma("unroll") for (int i_ = 0; i_ < 4; ++i_) { \
            const unsigned dl_ = k_ ? (unsigned)((i_ >> 1) * 32 * LDP * 2 + (i_ & 1) * 256) : (unsigned)(i_ * 128); \
            const int ld_ = stg_ * STAGE + (k_ ? ((i_ & 1) ? K1_OFF : K0_OFF) + (wave + 8 * (i_ >> 1)) * 1024 : V_OFF + (4 * wave + i_) * 1024); \
            __builtin_amdgcn_global_load_lds((const unsigned*)(gb_ + dl_ + vo_), (LAS unsigned*)(F.lds + ld_), 16, 0, 0); } } while (0)
#define AT2_WAITBAR4() asm volatile("s_waitcnt vmcnt(4) lgkmcnt(0)\n\ts_barrier" ::: "memory")
#define AT2_WAITBAR0() asm volatile("s_waitcnt vmcnt(0) lgkmcnt(0)\n\ts_barrier" ::: "memory")
        AT2_DMA4(true, 0); AT2_DMA4(false, 0);
        bf16x8 qr[8];
        { const bf16* Pq_ = P; asm volatile("" : "+s"(Pq_));
          int lq_ = lane; asm volatile("" : "+v"(lq_));
          const bf16* Qw = Pq_ + ((size_t)b * LTOK + NCTX + qb * 128 + wq * 32 + (lq_ & 31)) * LDP + OC_Q + h * 256 + mp * 128 + (lq_ >> 5) * 8;
#pragma unroll
          for (int d0 = 0; d0 < 8; ++d0) qr[d0] = *(const bf16x8*)(Qw + d0 * 16); }
        f32x16 o[8];
#pragma unroll
        for (int d0 = 0; d0 < 8; ++d0) o[d0] = (f32x16){};
        float lsum = 0.f;
        AT2_WAITBAR0();
        if (mp == 1) { AT2_DMA4(true, 1); AT2_WAITBAR4(); }
        SW_OFF(8); SW_ON(7);
#pragma unroll 1
        for (int t = 0; t < LTOK / 64; ++t) {
            const int stg = t & 1;
            SW_ON(4);
            bool issued;
            issued = t + 1 < LTOK / 64; if (issued) AT2_DMA4(mp == 0, t + 1);
            f32x16 p0, p1;
#pragma unroll
            for (int g = 0; g < 16; ++g) { p0[g] = negBl; p1[g] = negBl; }
            {
                const unsigned kb_ = ldsb + stg * STAGE + (mp ? K1_OFF : K0_OFF) + r32 * 256;
                const unsigned xs = (unsigned)((hi * 16) ^ ((r32 & 7) << 4));
                const unsigned ka0 = kb_ + (0u ^ xs), ka1 = kb_ + (32u ^ xs), ka2 = kb_ + (64u ^ xs), ka3 = kb_ + (96u ^ xs);
                v4u k0, k1, k2, k3, k4, k5;
#define AT2_KRD(DST, AD, OFF) asm volatile("ds_read_b128 %0, %1 offset:%2" : "=&v"(DST) : "v"(AD), "i"(OFF) : "memory")
#define AT2_KMM(KA, KB, D0, N) do { asm volatile("s_waitcnt lgkmcnt(" #N ")" ::: "memory"); __builtin_amdgcn_sched_barrier(0); \
                    p0 = __builtin_amdgcn_mfma_f32_32x32x16_bf16(__builtin_bit_cast(bf16x8, KA), qr[D0], p0, 0, 0, 0); p1 = __builtin_amdgcn_mfma_f32_32x32x16_bf16(__builtin_bit_cast(bf16x8, KB), qr[D0], p1, 0, 0, 0); \
                    __builtin_amdgcn_sched_barrier(0); } while (0)
                AT2_KRD(k0, ka0, 0); AT2_KRD(k1, ka0, 8192); AT2_KRD(k2, ka1, 0); AT2_KRD(k3, ka1, 8192); AT2_KRD(k4, ka2, 0); AT2_KRD(k5, ka2, 8192);
                AT2_KMM(k0, k1, 0, 4); AT2_KRD(k0, ka3, 0);   AT2_KRD(k1, ka3, 8192);
                AT2_KMM(k2, k3, 1, 4); AT2_KRD(k2, ka0, 128); AT2_KRD(k3, ka0, 8320);
                AT2_KMM(k4, k5, 2, 4); AT2_KRD(k4, ka1, 128); AT2_KRD(k5, ka1, 8320);
                AT2_KMM(k0, k1, 3, 4); AT2_KRD(k0, ka2, 128); AT2_KRD(k1, ka2, 8320);
                AT2_KMM(k2, k3, 4, 4); AT2_KRD(k2, ka3, 128); AT2_KRD(k3, ka3, 8320);
                AT2_KMM(k4, k5, 5, 4); AT2_KMM(k0, k1, 6, 2); AT2_KMM(k2, k3, 7, 0);
#undef AT2_KRD
#undef AT2_KMM
            }
            float ps = 0.f;
#pragma unroll
            for (int g = 0; g < 16; ++g) { p0[g] = __builtin_amdgcn_exp2f(p0[g]); p1[g] = __builtin_amdgcn_exp2f(p1[g]); ps += p0[g] + p1[g]; }
            lsum += ps;
            bf16x8 pa0, pa1, pa2, pa3;
#define AT2_PK4(PP, BASE, OUT) do { const unsigned a0 = pg8::cvt_pk_bf16(PP[BASE + 0], PP[BASE + 1]), a1 = pg8::cvt_pk_bf16(PP[BASE + 2], PP[BASE + 3]); \
            const unsigned b0_ = pg8::cvt_pk_bf16(PP[BASE + 4], PP[BASE + 5]), b1_ = pg8::cvt_pk_bf16(PP[BASE + 6], PP[BASE + 7]); \
            auto r0 = __builtin_amdgcn_permlane32_swap(a0, b0_, false, false); auto r1 = __builtin_amdgcn_permlane32_swap(a1, b1_, false, false); \
            v4u w_ = {r0[0], r1[0], r0[1], r1[1]}; OUT = __builtin_bit_cast(bf16x8, w_); } while (0)
            AT2_PK4(p0, 0, pa0); AT2_PK4(p0, 8, pa1); AT2_PK4(p1, 0, pa2); AT2_PK4(p1, 8, pa3);
#undef AT2_PK4
            SW_OFF(4); SW_ON(1); if (issued) AT2_WAITBAR4(); else AT2_WAITBAR0(); SW_OFF(1);
            SW_ON(3);
            SW_ON(6); { const int tn_ = t + 1 + mp; issued = tn_ < LTOK / 64; if (issued) AT2_DMA4(mp == 1, tn_); }
#if PROBE_SW == 6
            asm volatile("s_waitcnt vmcnt(0)" ::: "memory");
#endif
            SW_OFF(6);
            const unsigned vb = ldsb + stg * STAGE + V_OFF + vrd;
            s16x4 va0, va1, va2, va3, vc0, vc1, vc2, vc3, vd0, vd1, vd2, vd3;
#define AT2_RDH(B, D0, KS) do { B##0 = tr_read<v_rd_off(D0, KS, 0)>(vb); B##1 = tr_read<v_rd_off(D0, KS, 1)>(vb); B##2 = tr_read<v_rd_off(D0, KS + 1, 0)>(vb); B##3 = tr_read<v_rd_off(D0, KS + 1, 1)>(vb); } while (0)
#define AT2_PKV(L, H) (bf16x8){L[0], L[1], L[2], L[3], H[0], H[1], H[2], H[3]}
#define AT2_MMH(B, D0, PA, PB, N) do { asm volatile("s_waitcnt lgkmcnt(" #N ")" ::: "memory"); __builtin_amdgcn_sched_barrier(0); \
                o[D0] = __builtin_amdgcn_mfma_f32_32x32x16_bf16(PA, AT2_PKV(B##0, B##1), o[D0], 0, 0, 0); o[D0] = __builtin_amdgcn_mfma_f32_32x32x16_bf16(PB, AT2_PKV(B##2, B##3), o[D0], 0, 0, 0); \
                __builtin_amdgcn_sched_barrier(0); } while (0)
            AT2_RDH(va, 0, 0); AT2_RDH(vc, 0, 2);
            AT2_RDH(vd, 1, 0); AT2_MMH(va, 0, pa0, pa1, 8);
            AT2_RDH(va, 1, 2); AT2_MMH(vc, 0, pa2, pa3, 8);
            AT2_RDH(vc, 2, 0); AT2_MMH(vd, 1, pa0, pa1, 8);
            AT2_RDH(vd, 2, 2); AT2_MMH(va, 1, pa2, pa3, 8);
            AT2_RDH(va, 3, 0); AT2_MMH(vc, 2, pa0, pa1, 8);
            AT2_RDH(vc, 3, 2); AT2_MMH(vd, 2, pa2, pa3, 8);
            AT2_RDH(vd, 4, 0); AT2_MMH(va, 3, pa0, pa1, 8);
            AT2_RDH(va, 4, 2); AT2_MMH(vc, 3, pa2, pa3, 8);
            AT2_RDH(vc, 5, 0); AT2_MMH(vd, 4, pa0, pa1, 8);
            AT2_RDH(vd, 5, 2); AT2_MMH(va, 4, pa2, pa3, 8);
            AT2_RDH(va, 6, 0); AT2_MMH(vc, 5, pa0, pa1, 8);
            AT2_RDH(vc, 6, 2); AT2_MMH(vd, 5, pa2, pa3, 8);
            AT2_RDH(vd, 7, 0); AT2_MMH(va, 6, pa0, pa1, 8);
            AT2_RDH(va, 7, 2); AT2_MMH(vc, 6, pa2, pa3, 8);
            AT2_MMH(vd, 7, pa0, pa1, 4);
            AT2_MMH(va, 7, pa2, pa3, 0);
#undef AT2_RDH
#undef AT2_PKV
#undef AT2_MMH
            SW_OFF(3); SW_ON(2); if (issued) AT2_WAITBAR4(); else AT2_WAITBAR0(); SW_OFF(2);
        }
        SW_OFF(7);
        if (mp == 0) AT2_WAITBAR0();
#undef AT2_DMA4
#undef AT2_WAITBAR4
#undef AT2_WAITBAR0
        SW_ON(5);
        int lane_e = lane; asm volatile("" : "+v"(lane_e)); const int r32e = lane_e & 31, hie = lane_e >> 5;
        { auto rr = __builtin_amdgcn_permlane32_swap(__float_as_uint(lsum), __float_as_uint(lsum), false, false); lsum = __uint_as_float(rr[0]) + __uint_as_float(rr[1]); }
        v4u gtr[8];
        { const bf16* gb_ = P + ((size_t)b * LTOK + NCTX + qb * 128 + wave * 16 + hie) * LDP + OC_GATE + h * 256 + r32e * 8;
#pragma unroll
          for (int it = 0; it < 8; ++it) gtr[it] = *(const v4u*)(gb_ + (size_t)(it * 2) * LDP); }
        if (hie == 0) xw[r32e] = lsum;
        asm volatile("s_waitcnt lgkmcnt(0)" ::: "memory");
        {   float rli[16];
#pragma unroll
            for (int g = 0; g < 16; ++g) rli[g] = __builtin_amdgcn_rcpf(xw[crow(g, hie)]);
#pragma unroll
            for (int d0 = 0; d0 < 8; ++d0)
#pragma unroll
                for (int g = 0; g < 16; ++g) o[d0][g] *= rli[g];
        }
        __builtin_amdgcn_sched_barrier(0);
        {   LAS unsigned char* img = F.lds + mp * 65536 + wq * 16384 + (4 * hie) * 512 + r32e * 2;
#pragma unroll
            for (int d0 = 0; d0 < 8; ++d0) {
#pragma unroll
                for (int g = 0; g < 16; ++g) *(LAS unsigned short*)(img + ((g & 3) + 8 * (g >> 2)) * 512 + d0 * 64) = (unsigned short)f2bf(o[d0][g]);
                __builtin_amdgcn_sched_barrier(0); }
        }
        __syncthreads();
        {   const float* lq = argp(I_LQK);
            const float d01 = wave_sum(lq[lane_e] * lq[128 + lane_e] + lq[64 + lane_e] * lq[192 + lane_e]);
            const float d23 = wave_sum(lq[256 + lane_e] * lq[384 + lane_e] + lq[320 + lane_e] * lq[448 + lane_e]);
            const float nlam = -(expf(d01) - expf(d23) + LAM_INIT1);
            const int c8 = r32e * 8;
            const float* cg = argp(I_CG) + c8;
            const f32x4 g0 = *(const f32x4*)cg, g1 = *(const f32x4*)(cg + 4);
            const float gn[8] = {g0[0], g0[1], g0[2], g0[3], g1[0], g1[1], g1[2], g1[3]};
            bf16* ybase = Y2 + ((size_t)b * SEQ + qb * 128) * DM + h * 256 + c8;
#pragma unroll
            for (int it = 0; it < 8; ++it) {
                const int rr = wave * 16 + it * 2 + hie;
                const LAS unsigned char* ip = F.lds + (rr >> 5) * 16384 + (rr & 31) * 512 + c8 * 2;
                float a[8], bb[8], gt[8];
                unpack8(*(const LAS v4u*)ip, a); unpack8(*(const LAS v4u*)(ip + 65536), bb); unpack8(gtr[it], gt);
                float ss = 0.f;
#pragma unroll
                for (int e = 0; e < 8; ++e) { a[e] = fmaf(nlam, bb[e], a[e]); ss = fmaf(a[e], a[e], ss); }
                ss += __shfl_xor(ss, 1); ss += __shfl_xor(ss, 2); ss += __shfl_xor(ss, 4); ss += __shfl_xor(ss, 8); ss += __shfl_xor(ss, 16);
                const float rstd = rsqrtf(ss * (1.f / 256.f) + EPS) * (1.f - LAM_INIT1);
                float y[8];
#pragma unroll
                for (int e = 0; e < 8; ++e) y[e] = a[e] * rstd * gn[e] * siluf_(gt[e]);
                *(v4u*)(ybase + (size_t)rr * DM) = pack8(y);
            }
        }
        __syncthreads();
        SW_OFF(5);
    }
#if PROBE_SW
    if (wave == PROBE_SW_WAVE) { const unsigned long long t0_ = __builtin_amdgcn_s_memtime(); while (__builtin_amdgcn_s_memtime() - t0_ < sw_acc) __builtin_amdgcn_s_sleep(8); }
#endif
}

__global__ void __launch_bounds__(NWAVES * 64, 2) mega_fwd(Args args) {
    extern __shared__ __attribute__((aligned(16))) unsigned char lds[];
    Frame F;
    F.lds = (LAS unsigned char*)lds;
    F.G = gridDim.x;
#if MK_ONE_LAUNCH
    if (args.ph_hi == 0x7fffffff) cg::this_grid().sync();
    { const int t0_ = tid_();
      for (int u = t0_; u < (LDS_BYTES - LDSCTL_OFF) / 4; u += NWAVES * 64) ((LAS unsigned*)(F.lds + LDSCTL_OFF))[u] = 0u;
      __syncthreads();
      if ((t0_ & 63) == 0) ((volatile LAS unsigned*)(F.lds + WTAB_OFF))[hw_slot_()] = (unsigned)(t0_ >> 6);
      __syncthreads(); }
    F.ids();
    const XcdBarrier bar = xcd_barrier_post((unsigned*)(args.ws + WS_CTL) + CW_BAR, (volatile LAS unsigned*)(F.lds + MISC_OFF) + 8, F.wave, F.lds);
    if (F.tid == 0) {
        volatile LAS unsigned* misc_ = (volatile LAS unsigned*)(F.lds + MISC_OFF);
        misc_[10] = __hip_atomic_fetch_add((unsigned*)(args.ws + WS_CTL) + CW_RANK + 64 * bar.x, 1u, __ATOMIC_RELAXED, __HIP_MEMORY_SCOPE_AGENT); misc_[11] = bar.x; }
    __syncthreads();
#endif
    const int lo = args.ph_lo, hi = args.ph_hi;
#define IN(k) (lo <= (k) && (k) < hi)
#if PROBE_PH_MASK
    unsigned long long ph_acc = 0, ph_t0 = 0;
#define PH_ON(k) do { if ((PROBE_PH_MASK >> (k)) & 1) ph_t0 = __builtin_amdgcn_s_memtime(); } while (0)
#define PH_OFF(k) do { if ((PROBE_PH_MASK >> (k)) & 1) ph_acc += __builtin_amdgcn_s_memtime() - ph_t0; } while (0)
#else
#define PH_ON(k) do { } while (0)
#define PH_OFF(k) do { } while (0)
#endif
#if MK_ONE_LAUNCH
#define GRIDBAR() do { XcdBarrier b_; b_.bar = (unsigned*)(karg_ptr_(168) + WS_CTL) + CW_BAR; b_.x = xb_xcc_id(); b_.w = 0; b_.st = (volatile LAS unsigned*)(F.lds + MISC_OFF) + 8; b_.lds0 = F.lds; xcd_barrier(b_); } while (0)
#define SEAM(k) do { if (IN(k) && IN((k) + 1)) { XcdBarrier b_; b_.bar = (unsigned*)(karg_ptr_(168) + WS_CTL) + CW_BAR; b_.x = xb_xcc_id(); b_.w = 0; b_.st = (volatile LAS unsigned*)(F.lds + MISC_OFF) + 8; b_.lds0 = F.lds; xcd_barrier(b_); } } while (0)
#else
#define SEAM(k) do { } while (0)
#endif
#define Hb ((bf16*)(F.ws + WS_H))
#define Pb ((bf16*)(F.ws + WS_P))
#define mod0 ((const float*)(F.ws + WS_MOD))
#define mod1 ((const float*)(F.ws + WS_MOD) + 9 * 6144)
#define ctx1 ((float*)(F.ws + WS_CTX1))

    PH_ON(0); if (IN(0)) for (int rep_ = 0; rep_ < (((PROBE_DUP_MASK >> 0) & 1) ? 2 : 1); ++rep_) { F.ids(); p0_prologue(F); } SEAM(0); PH_OFF(0);
    PH_ON(1); if (IN(1)) for (int rep_ = 0; rep_ < (((PROBE_DUP_MASK >> 1) & 1) ? 2 : 1); ++rep_) { F.ids(); modulate_phase(F, 0, argp(I_X), argp(I_CTX)); } SEAM(1); PH_OFF(1);
    PH_ON(2); if (IN(2)) for (int rep_ = 0; rep_ < (((PROBE_DUP_MASK >> 2) & 1) ? 2 : 1); ++rep_) { F.ids();
        zgemm_phase(F);
        __syncthreads();
        pg8::Gemm g{Hb, (const bf16*)(F.ws + WS_WIE), MROWS, NP, DM}; pg8::StaticOrder S; S.init(MROWS, NP, F.G, (int)blockIdx.x);
        pg8::EpiEven E{Pb, LDP, (const float*)(F.ws + WS_LBT)};
        pg8::gemm_phase<pg8::EpiEven, pg8::StaticOrder, true, true>(F.lds, g, S, E, F.tid);
    } SEAM(2); PH_OFF(2);
        PH_ON(3); if (IN(3)) for (int rep_ = 0; rep_ < (((PROBE_DUP_MASK >> 3) & 1) ? 2 : 1); ++rep_) { F.ids(); scan_phase_v2(F, (bf16*)F.out, Hb); } SEAM(3); PH_OFF(3);
    PH_ON(4); if (IN(4)) for (int rep_ = 0; rep_ < (((PROBE_DUP_MASK >> 4) & 1) ? 2 : 1); ++rep_) { F.ids(); evengate_phase(F, (const bf16*)F.out); } SEAM(4); PH_OFF(4);
    PH_ON(5); if (IN(5) && IN(6)) { F.ids();
        if (F.G == 256) {
            { pg8::Gemm g{Hb, (const bf16*)(F.ws + WS_WOE), MROWS, DM, DM}; pg8::RangeOrder S; S.init(64 * 256, DM, F.G, (int)blockIdx.x); S.pm0 = 0;
              pg8::EpiResL0 E{argp(I_X), argp(I_CTX), (bf16*)(F.ws + WS_X1A), (bf16*)(F.ws + WS_X1B), (bf16*)(F.ws + WS_C1B), mod0};
              pg8::gemm_phase<pg8::EpiResL0, pg8::RangeOrder, true, true>(F.lds, g, S, E, F.tid); }
            GRIDBAR();
            F.ids();
            if (blockIdx.x < 64) { pg8::Gemm g{Hb, (const bf16*)(F.ws + WS_WOE), MROWS, DM, DM}; pg8::RangeOrder S; S.init(8 * 256, DM, 64, (int)blockIdx.x); S.pm0 = 64;
              pg8::EpiResL0 E{argp(I_X), argp(I_CTX), (bf16*)(F.ws + WS_X1A), (bf16*)(F.ws + WS_X1B), (bf16*)(F.ws + WS_C1B), mod0};
              pg8::gemm_phase<pg8::EpiResL0, pg8::RangeOrder, true, true>(F.lds, g, S, E, F.tid); }
            else modulate_phase_b(F, 1, 0, 64 * 256, ((int)blockIdx.x - 64) * NWAVES + F.wave, 192 * NWAVES);
            GRIDBAR();
            F.ids(); modulate_phase_b(F, 1, 64 * 256, MROWS, blockIdx.x * NWAVES + F.wave, F.G * NWAVES);
        } else {
            { pg8::Gemm g{Hb, (const bf16*)(F.ws + WS_WOE), MROWS, DM, DM}; pg8::StaticOrder S; S.init(MROWS, DM, F.G, (int)blockIdx.x);
              pg8::EpiResL0 E{argp(I_X), argp(I_CTX), (bf16*)(F.ws + WS_X1A), (bf16*)(F.ws + WS_X1B), (bf16*)(F.ws + WS_C1B), mod0};
              pg8::gemm_phase<pg8::EpiResL0, pg8::StaticOrder, true, true>(F.lds, g, S, E, F.tid); }
            GRIDBAR();
            F.ids(); modulate_phase_b(F, 1, 0, MROWS, blockIdx.x * NWAVES + F.wave, F.G * NWAVES);
        }
    } SEAM(6); PH_OFF(5);
    PH_ON(7); if (IN(7)) for (int rep_ = 0; rep_ < (((PROBE_DUP_MASK >> 7) & 1) ? 2 : 1); ++rep_) { F.ids();
        pg8::Gemm g{Hb, (const bf16*)(F.ws + WS_WIO), MROWS, NP, DM}; pg8::StaticOrder S; S.init(MROWS, NP, F.G, (int)blockIdx.x);
        pg8::EpiOdd E{Pb, LDP, argp(I_QG), argp(I_KG), (const float*)(F.ws + WS_ROPE), (LAS float*)(F.lds + LDSCTL_OFF + 4096), QSCALE};
        pg8::gemm_phase<pg8::EpiOdd, pg8::StaticOrder, true, true>(F.lds, g, S, E, F.tid);
    } SEAM(7); PH_OFF(7);
    PH_ON(9); if (IN(9)) for (int rep_ = 0; rep_ < (((PROBE_DUP_MASK >> 9) & 1) ? 2 : 1); ++rep_) { F.ids(); attn_phase_v2(F); } SEAM(9); PH_OFF(9);
    PH_ON(11); if (IN(11)) for (int rep_ = 0; rep_ < (((PROBE_DUP_MASK >> 11) & 1) ? 2 : 1); ++rep_) { F.ids();
        pg8::Gemm g{(const bf16*)(F.ws + WS_O0), (const bf16*)(F.ws + WS_WOO), MLAT, DM, DM}; pg8::StaticOrder S; S.init(MLAT, DM, F.G, (int)blockIdx.x);
        pg8::EpiResL1 E{(const bf16*)(F.ws + WS_X1A), (const bf16*)(F.ws + WS_X1B), F.out, mod1};
        pg8::gemm_phase<pg8::EpiResL1, pg8::StaticOrder, true, true>(F.lds, g, S, E, F.tid);
    }
    PH_OFF(11);
#if PROBE_PH_MASK
    if (blockIdx.x == 0 && F.wave == 0 && lane_id_() == 0) { const unsigned long long t0_ = __builtin_amdgcn_s_memtime(); while (__builtin_amdgcn_s_memtime() - t0_ < ph_acc) __builtin_amdgcn_s_sleep(8); }
#endif
#undef Hb
#undef Pb
#undef mod0
#undef mod1
#undef ctx1
#undef IN
#undef SEAM
}
constexpr int N_PHASES = 12;

extern "C" void kernel_launch(void* const* d_in, const int* in_sizes, int n_in, void* d_out, int out_size, void* d_ws, size_t ws_size, hipStream_t stream) {
    static int grid = 0;
    if (grid == 0) {
        if (n_in != 20 || in_sizes[0] != MLAT * DM || out_size != MLAT * DM || ws_size < WS_END) {
            fprintf(stderr, "kernel_launch: unexpected shapes: n_in %d in0 %d out %d ws %zu (need >= %zu)\n", n_in, n_in > 0 ? in_sizes[0] : -1, out_size, ws_size, (size_t)WS_END); grid = -1; return; }
        int dev = 0, cus = 0, per_cu = 0;
        if (hipGetDevice(&dev) != hipSuccess || hipDeviceGetAttribute(&cus, hipDeviceAttributeMultiprocessorCount, dev) != hipSuccess) { grid = -1; return; }
        if (hipFuncSetAttribute((const void*)mega_fwd, hipFuncAttributeMaxDynamicSharedMemorySize, LDS_BYTES) != hipSuccess) { fprintf(stderr, "kernel_launch: hipFuncSetAttribute failed\n"); grid = -1; return; }
        if (hipOccupancyMaxActiveBlocksPerMultiprocessor(&per_cu, (const void*)mega_fwd, NWAVES * 64, LDS_BYTES) != hipSuccess || per_cu < 1) { fprintf(stderr, "kernel_launch: occupancy query says %d blocks per CU\n", per_cu); (void)hipGetLastError(); grid = -1; return; }
        grid = cus;
    }
    if (grid < 0) return;
    Args a{};
    for (int i = 0; i < 20; ++i) a.in[i] = (const float*)d_in[i];
    a.out = (float*)d_out; a.ws = (unsigned char*)d_ws;
#if MK_ONE_LAUNCH
    if (hipMemsetAsync((char*)d_ws + WS_CTL, 0, CTL_ZERO_BYTES, stream) != hipSuccess) { fprintf(stderr, "kernel_launch: hipMemsetAsync failed\n"); return; }
    a.ph_lo = 0; a.ph_hi = N_PHASES;
    void* kargs[] = {&a};
    const hipError_t e = hipLaunchCooperativeKernel((const void*)mega_fwd, dim3(grid), dim3(NWAVES * 64), kargs, LDS_BYTES, stream);
    if (e != hipSuccess) fprintf(stderr, "kernel_launch: cooperative launch failed: %s (grid %d)\n", hipGetErrorString(e), grid);
#else
    for (int p = 0; p < N_PHASES; ++p) {
        a.ph_lo = p; a.ph_hi = p + 1;
        hipLaunchKernelGGL(mega_fwd, dim3(grid), dim3(NWAVES * 64), LDS_BYTES, stream, a);
    }
    const hipError_t le = hipPeekAtLastError();
    if (le != hipSuccess) fprintf(stderr, "kernel_launch: launch failed: %s\n", hipGetErrorName(le));
#endif
}
```

```cpp
#define L1_SCAN_ITEMS 0
#include <hip/hip_runtime.h>
#include <hip/hip_bf16.h>
#include <hip/hip_cooperative_groups.h>
#include <cstdio>
#include <cstdint>
#include <cmath>
namespace cg = cooperative_groups;

#ifndef RES_PREFETCH
#define RES_PREFETCH 0
#endif
#ifndef PROBE_GE
#define PROBE_GE 0
#endif
#ifndef PROBE_GE_SEL
#define PROBE_GE_SEL 4
#endif
#ifndef PROBE_GE_BLOCK
#define PROBE_GE_BLOCK 0
#endif
#ifndef OUT_NT
#define OUT_NT 0
#endif
#ifndef GEMM_PRIO
#define GEMM_PRIO 0
#endif
#ifndef RES_PERM
#define RES_PERM 0
#endif
namespace pg8 {
#define PG8_LAS __attribute__((address_space(3)))
typedef unsigned short bf16_t;
typedef short bf16x8 __attribute__((ext_vector_type(8)));
typedef float f32x4 __attribute__((ext_vector_type(4)));
typedef unsigned u32x4 __attribute__((ext_vector_type(4)));
constexpr int BM = 256, BK = 64, HALF = 128, HTB = HALF * BK * 2  , STAGE_BYTES = 8 * HTB, NXCD = 8, WGM = 8;

__host__ __device__ __forceinline__ int lds_byte(int r, int c) { const int st = (r >> 4) * 2 + (c >> 5), rr = r & 15, cc = c & 31, ob = rr * 64 + cc * 2; return st * 1024 + (ob ^ (((ob >> 9) & 1) << 5)); }
__host__ __device__ __forceinline__ void stage_rc(int b, int& R, int& C) { const int st = b / 1024, sb = b % 1024, swz = sb ^ (((sb >> 9) & 1) << 5); R = (st >> 1) * 16 + swz / 64; C = (st & 1) * 32 + (swz % 64) / 2; }
__host__ __device__ __forceinline__ int perm32(int rho) { const int n = rho >> 4, i = rho & 15; return 8 * (i >> 2) + 4 * n + (i & 3); }

struct Unit { int pm, pn; };
struct Gemm { const bf16_t* A; const bf16_t* Bt; int M, N, K; };

struct StaticOrder {
    int nM, nN, nwg, G, c;
    __host__ __device__ void init(int M, int N, int G_, int c_) { nM = M / BM; nN = N / BM; nwg = nM * nN; G = G_; c = c_; }
    __host__ __device__ bool next(int i, Unit& u) const {
        const long L = (long)i * G + c; if (L >= nwg) return false;
        int wgid = (int)L; { const int q = nwg / NXCD, r = nwg % NXCD, xcd = wgid % NXCD, off = wgid / NXCD; wgid = (xcd < r ? xcd * (q + 1) : r * (q + 1) + (xcd - r) * q) + off; }
        const int nig = WGM * nN, gid = wgid / nig, fm = gid * WGM, gsz = (nM - fm) < WGM ? (nM - fm) : WGM;
        u.pm = fm + ((wgid % nig) % gsz); u.pn = (wgid % nig) / gsz; return true;
    }
    __device__ __forceinline__ void a_ready(const Unit&) const {}
    __device__ __forceinline__ void done(const Unit&) const {}
};

struct RangeOrder : StaticOrder {
    int pm0;
    __host__ __device__ bool next(int i, Unit& u) const { if (!StaticOrder::next(i, u)) return false; u.pm += pm0; return true; }
};

__device__ __forceinline__ unsigned cvt_pk_bf16(float lo, float hi) { unsigned r; asm volatile("v_cvt_pk_bf16_f32 %0, %1, %2" : "=v"(r) : "v"(lo), "v"(hi)); return r; }
struct EpiStoreBf16 {
    static constexpr int EPI_ID = 0; static constexpr bool PERM = true, AFTER_DRAIN = false, PREFETCH = false;
    bf16_t* O; int ldc;
    __device__ __forceinline__ void operator()(const f32x4 (&acc)[2][2][4][2], const Unit& u, int wr, int wc, int fr, int fq) const {
        const int row0 = u.pm * BM + wr * 64 + fr; const int col0 = u.pn * BM + wc * 32 + 8 * fq;
#pragma unroll
        for (int ai = 0; ai < 2; ++ai)
#pragma unroll
            for (int m = 0; m < 4; ++m) { bf16_t* rowp = O + (size_t)(row0 + ai * HALF + m * 16) * ldc + col0;
#pragma unroll
                for (int bj = 0; bj < 2; ++bj) { const f32x4 v0 = acc[ai][bj][m][0], v1 = acc[ai][bj][m][1];
                    u32x4 w; w.x = cvt_pk_bf16(v0[0], v0[1]); w.y = cvt_pk_bf16(v0[2], v0[3]); w.z = cvt_pk_bf16(v1[0], v1[1]); w.w = cvt_pk_bf16(v1[2], v1[3]);
                    *(u32x4*)(rowp + bj * HALF) = w; } }
    }
};
struct EpiEven {
    static constexpr int EPI_ID = 1; static constexpr bool PERM = true, AFTER_DRAIN = false, PREFETCH = false;
    bf16_t* O; int ldc; const float* lb;
    __device__ __forceinline__ void operator()(const f32x4 (&acc)[2][2][4][2], const Unit& u, int wr, int wc, int fr, int fq) const {
        const int row0 = u.pm * BM + wr * 64 + fr; const int col0 = u.pn * BM + wc * 32 + 8 * fq;
        const int kind = u.pn < 4 ? 1 : (u.pn < 12 ? 2 : ((u.pn == 16 || u.pn == 17) ? 3 : 0));
        float lbv[2][8];
        if (kind == 2) {
#pragma unroll
            for (int bj = 0; bj < 2; ++bj) { const f32x4 a = *(const f32x4*)(lb + ((col0 + bj * HALF - 1024) & 1023)), b = *(const f32x4*)(lb + ((col0 + bj * HALF - 1024) & 1023) + 4);
                lbv[bj][0] = a[0]; lbv[bj][1] = a[1]; lbv[bj][2] = a[2]; lbv[bj][3] = a[3]; lbv[bj][4] = b[0]; lbv[bj][5] = b[1]; lbv[bj][6] = b[2]; lbv[bj][7] = b[3]; }
        }
#pragma unroll
        for (int ai = 0; ai < 2; ++ai)
#pragma unroll
            for (int m = 0; m < 4; ++m) { bf16_t* rowp = O + (size_t)(row0 + ai * HALF + m * 16) * ldc + col0;
#pragma unroll
                for (int bj = 0; bj < 2; ++bj) { float v[8] = {acc[ai][bj][m][0][0], acc[ai][bj][m][0][1], acc[ai][bj][m][0][2], acc[ai][bj][m][0][3], acc[ai][bj][m][1][0], acc[ai][bj][m][1][1], acc[ai][bj][m][1][2], acc[ai][bj][m][1][3]};
                    u32x4 w;
                    if (kind == 2) {
                        typedef _Float16 h8 __attribute__((ext_vector_type(8))); h8 hv;
#pragma unroll
                        for (int e = 0; e < 8; ++e) { const float sg = __builtin_amdgcn_rcpf(1.f + __expf(-v[e])); hv[e] = (_Float16)__builtin_amdgcn_logf(__builtin_fmaf(1.f - lbv[bj][e], sg, lbv[bj][e])); }
                        w = __builtin_bit_cast(u32x4, hv);
                    } else {
                        if (kind == 1) {
#pragma unroll
                            for (int e = 0; e < 8; ++e) v[e] = v[e] * __builtin_amdgcn_rcpf(1.f + __expf(-v[e]));
                        } else if (kind == 3) {
#pragma unroll
                            for (int e = 0; e < 8; ++e) v[e] *= 0.088388347648318440f;
                        }
                        w.x = cvt_pk_bf16(v[0], v[1]); w.y = cvt_pk_bf16(v[2], v[3]); w.z = cvt_pk_bf16(v[4], v[5]); w.w = cvt_pk_bf16(v[6], v[7]);
                    }
                    *(u32x4*)(rowp + bj * HALF) = w; } }
    }
};

struct EpiOdd {
    static constexpr int EPI_ID = 2; static constexpr bool PERM = true, AFTER_DRAIN = false, PREFETCH = false;
    bf16_t* O; int ldc; const float* qg; const float* kg; const float* rope; PG8_LAS float* part; float qscale;
    __device__ __forceinline__ void operator()(const f32x4 (&acc)[2][2][4][2], const Unit& u, int wr, int wc, int fr, int fq) const {
        const int row0 = u.pm * BM + wr * 64 + fr; const int col0 = u.pn * BM + wc * 32 + 8 * fq;
        if (u.pn >= 16) {
#pragma unroll
            for (int ai = 0; ai < 2; ++ai)
#pragma unroll
                for (int m = 0; m < 4; ++m) { bf16_t* rowp = O + (size_t)(row0 + ai * HALF + m * 16) * ldc + col0;
#pragma unroll
                    for (int bj = 0; bj < 2; ++bj) { const f32x4 v0 = acc[ai][bj][m][0], v1 = acc[ai][bj][m][1];
                        u32x4 w; w.x = cvt_pk_bf16(v0[0], v0[1]); w.y = cvt_pk_bf16(v0[2], v0[3]); w.z = cvt_pk_bf16(v1[0], v1[1]); w.w = cvt_pk_bf16(v1[2], v1[3]);
                        *(u32x4*)(rowp + bj * HALF) = w; } }
            return;
        }
        const bool isq = u.pn < 8;
        const int B = wc >> 1, i0 = (wc & 1) * 16 + 4 * fq;
        const int jt = u.pm % 9; const bool lat = jt != 0;
        float g[8];
        { const float* gp = (isq ? qg : kg) + B * 64 + i0; const f32x4 g0 = *(const f32x4*)gp, g1 = *(const f32x4*)(gp + 32); const float sc = isq ? qscale : 1.f;
          g[0] = g0[0] * sc; g[1] = g1[0] * sc; g[2] = g0[1] * sc; g[3] = g1[1] * sc; g[4] = g0[2] * sc; g[5] = g1[2] * sc; g[6] = g0[3] * sc; g[7] = g1[3] * sc; }
        f32x4 csa[2][4], csb[2][4];
#pragma unroll
        for (int ai = 0; ai < 2; ++ai)
#pragma unroll
            for (int m = 0; m < 4; ++m) { csa[ai][m] = (f32x4){1.f, 0.f, 1.f, 0.f}; csb[ai][m] = (f32x4){1.f, 0.f, 1.f, 0.f};
                if (lat) { const int ptok = (jt - 1) * 256 + ai * HALF + wr * 64 + m * 16 + fr; const int pos = B ? (ptok & 63) : (ptok >> 6); const float* tp = rope + (pos * 32 + i0) * 2; csa[ai][m] = *(const f32x4*)tp; csb[ai][m] = *(const f32x4*)(tp + 4); } }
#pragma unroll
        for (int ai = 0; ai < 2; ++ai)
#pragma unroll
            for (int m = 0; m < 4; ++m)
#pragma unroll
                for (int bj = 0; bj < 2; ++bj) { const f32x4 a = acc[ai][bj][m][0], b = acc[ai][bj][m][1];
                    float s = (a[0] * a[0] + a[1] * a[1]) + (a[2] * a[2] + a[3] * a[3]) + (b[0] * b[0] + b[1] * b[1]) + (b[2] * b[2] + b[3] * b[3]);
                    s += __shfl_xor(s, 16); s += __shfl_xor(s, 32);
                    if (fq == 0) part[((ai * HALF + wr * 64 + m * 16 + fr) * 2 + bj) * 4 + wc] = s; }
        asm volatile("s_waitcnt lgkmcnt(0)" ::: "memory"); __builtin_amdgcn_s_barrier(); asm volatile("" ::: "memory");
#pragma unroll
        for (int ai = 0; ai < 2; ++ai)
#pragma unroll
            for (int m = 0; m < 4; ++m) { const int rt = ai * HALF + wr * 64 + m * 16 + fr;
                const f32x4 cs0 = csa[ai][m], cs1 = csb[ai][m];
                bf16_t* rowp = O + (size_t)(row0 + ai * HALF + m * 16) * ldc + col0;
#pragma unroll
                for (int bj = 0; bj < 2; ++bj) { const f32x4 p4 = *(const PG8_LAS f32x4*)(part + (rt * 2 + bj) * 4);
                    const float rstd = __builtin_amdgcn_rsqf(((p4[0] + p4[1]) + (p4[2] + p4[3])) * (1.f / 128.f) + 1e-6f);
                    const f32x4 a = acc[ai][bj][m][0], b = acc[ai][bj][m][1];
                    const float x[8] = {a[0] * rstd * g[0], a[1] * rstd * g[1], a[2] * rstd * g[2], a[3] * rstd * g[3], b[0] * rstd * g[4], b[1] * rstd * g[5], b[2] * rstd * g[6], b[3] * rstd * g[7]};
                    const float c[4] = {cs0[0], cs0[2], cs1[0], cs1[2]}, sn[4] = {cs0[1], cs0[3], cs1[1], cs1[3]};
                    float y[8];
#pragma unroll
                    for (int j = 0; j < 4; ++j) { y[2 * j] = x[2 * j] * c[j] - x[2 * j + 1] * sn[j]; y[2 * j + 1] = x[2 * j + 1] * c[j] + x[2 * j] * sn[j]; }
                    u32x4 w; w.x = cvt_pk_bf16(y[0], y[1]); w.y = cvt_pk_bf16(y[2], y[3]); w.z = cvt_pk_bf16(y[4], y[5]); w.w = cvt_pk_bf16(y[6], y[7]);
                    *(u32x4*)(rowp + bj * HALF) = w; }
                asm volatile("" ::: "memory"); }
    }
};

struct EpiResL0 {
    static constexpr int EPI_ID = 3; static constexpr bool PERM = (RES_PERM != 0), AFTER_DRAIN = false, PREFETCH = (RES_PREFETCH != 0);
    const float* xsrc; const float* csrc; bf16_t* xa; bf16_t* xb; bf16_t* cb; const float* mod;
    __device__ __forceinline__ void prefetch(const Unit& u, int tid, PG8_LAS unsigned char* junk) const {
        const int b = u.pm / 9, j = u.pm - b * 9;
        const char* src = (j == 0) ? (const char*)(csrc + (size_t)b * 256 * 2048) : (const char*)(xsrc + (size_t)(b * 8 + (j - 1)) * 256 * 2048);
        src += (size_t)u.pn * (BM * 4);
#pragma unroll
        for (int i = 0; i < 4; ++i) { const int li = tid + i * 512, row = li >> 3, seg = li & 7;
            __builtin_amdgcn_global_load_lds((const unsigned*)(src + (size_t)((unsigned)(row * 8192 + seg * 128))), (PG8_LAS unsigned*)junk, 4, 0, 0); }
    }
    __device__ __forceinline__ void operator()(const f32x4 (&acc)[2][2][4][2], const Unit& u, int wr, int wc, int fr, int fq) const {
        const int b = u.pm / 9, j = u.pm - b * 9;
        const char* src; char* dst; const float* g;
        if (j == 0) { const size_t off = (size_t)b * 256 * 2048; src = (const char*)(csrc + off); dst = (char*)(cb + off); g = mod + 8 * 6144 + 4096; }
        else { const int lt = b * 8 + (j - 1); src = (const char*)(xsrc + (size_t)lt * 256 * 2048); dst = (char*)((lt < 32 ? xa : xb) + (size_t)(lt & 31) * 256 * 2048); g = mod + b * 6144 + 4096; }
        const int r0 = wr * 64 + fr, col0 = u.pn * BM + wc * 32 + (RES_PERM ? 8 : 4) * fq;
        const unsigned e0 = (unsigned)(r0 * 2048 + col0);
        f32x4 gv[2][2];
#pragma unroll
        for (int bj = 0; bj < 2; ++bj)
#pragma unroll
            for (int n = 0; n < 2; ++n) gv[bj][n] = *(const f32x4*)(g + col0 + bj * HALF + n * (RES_PERM ? 4 : 16));
        f32x4 sa[2][2], sb[2][2];
#define PG8_RL0_LD(S, AI, M) do { _Pragma("unroll") for (int bj = 0; bj < 2; ++bj) _Pragma("unroll") for (int n = 0; n < 2; ++n) \
            S[bj][n] = *(const f32x4*)(src + (size_t)((e0 + (unsigned)(((AI) * HALF + (M) * 16) * 2048 + bj * HALF + n * (RES_PERM ? 4 : 16))) * 4u)); } while (0)
#define PG8_RL0_ST(S, AI, M) do { _Pragma("unroll") for (int bj = 0; bj < 2; ++bj) _Pragma("unroll") for (int n = 0; n < 2; ++n) { const f32x4 y = S[bj][n] + gv[bj][n] * acc[AI][bj][M][n]; \
            unsigned w0 = cvt_pk_bf16(y[0], y[1]), w1 = cvt_pk_bf16(y[2], y[3]); typedef unsigned u32x2_ __attribute__((ext_vector_type(2))); \
            *(u32x2_*)(dst + (size_t)((e0 + (unsigned)(((AI) * HALF + (M) * 16) * 2048 + bj * HALF + n * (RES_PERM ? 4 : 16))) * 2u)) = (u32x2_){w0, w1}; } } while (0)
        PG8_RL0_LD(sa, 0, 0); PG8_RL0_LD(sb, 0, 1);
        PG8_RL0_ST(sa, 0, 0); PG8_RL0_LD(sa, 0, 2);
        PG8_RL0_ST(sb, 0, 1); PG8_RL0_LD(sb, 0, 3);
        PG8_RL0_ST(sa, 0, 2); PG8_RL0_LD(sa, 1, 0);
        PG8_RL0_ST(sb, 0, 3); PG8_RL0_LD(sb, 1, 1);
        PG8_RL0_ST(sa, 1, 0); PG8_RL0_LD(sa, 1, 2);
        PG8_RL0_ST(sb, 1, 1); PG8_RL0_LD(sb, 1, 3);
        PG8_RL0_ST(sa, 1, 2); PG8_RL0_ST(sb, 1, 3);
#undef PG8_RL0_LD
#undef PG8_RL0_ST
    }
};
struct EpiResL1 {
    static constexpr int EPI_ID = 4; static constexpr bool PERM = (RES_PERM != 0), AFTER_DRAIN = false, PREFETCH = (RES_PREFETCH != 0);
    const bf16_t* xa; const bf16_t* xb; float* out; const float* mod;
    __device__ __forceinline__ void prefetch(const Unit& u, int tid, PG8_LAS unsigned char* junk) const {
        const int lt = u.pm;
        const char* src = (const char*)((lt < 32 ? xa : xb) + (size_t)(lt & 31) * 256 * 2048) + (size_t)u.pn * (BM * 2);
#pragma unroll
        for (int i = 0; i < 2; ++i) { const int li = tid + i * 512, row = li >> 2, seg = li & 3;
            __builtin_amdgcn_global_load_lds((const unsigned*)(src + (size_t)((unsigned)(row * 4096 + seg * 128))), (PG8_LAS unsigned*)junk, 4, 0, 0); }
    }
    __device__ __forceinline__ void operator()(const f32x4 (&acc)[2][2][4][2], const Unit& u, int wr, int wc, int fr, int fq) const {
        const int lt = u.pm, b = lt >> 3;
        const char* src = (const char*)((lt < 32 ? xa : xb) + (size_t)(lt & 31) * 256 * 2048); char* dst = (char*)(out + (size_t)lt * 256 * 2048); const float* g = mod + b * 6144 + 4096;
        const int r0 = wr * 64 + fr, col0 = u.pn * BM + wc * 32 + (RES_PERM ? 8 : 4) * fq;
        const unsigned e0 = (unsigned)(r0 * 2048 + col0);
        f32x4 gv[2][2];
#pragma unroll
        for (int bj = 0; bj < 2; ++bj)
#pragma unroll
            for (int n = 0; n < 2; ++n) gv[bj][n] = *(const f32x4*)(g + col0 + bj * HALF + n * (RES_PERM ? 4 : 16));
        typedef unsigned u32x2_ __attribute__((ext_vector_type(2)));
        u32x2_ sa[2][2][2], sb[2][2][2];
#define PG8_RL1_LD(S, Q) do { _Pragma("unroll") for (int mm = 0; mm < 2; ++mm) _Pragma("unroll") for (int bj = 0; bj < 2; ++bj) _Pragma("unroll") for (int n = 0; n < 2; ++n) \
            S[mm][bj][n] = *(const u32x2_*)(src + (size_t)((e0 + (unsigned)((((Q) >> 1) * HALF + (((Q) & 1) * 2 + mm) * 16) * 2048 + bj * HALF + n * (RES_PERM ? 4 : 16))) * 2u)); } while (0)
#define PG8_RL1_ST(S, Q) do { _Pragma("unroll") for (int mm = 0; mm < 2; ++mm) _Pragma("unroll") for (int bj = 0; bj < 2; ++bj) _Pragma("unroll") for (int n = 0; n < 2; ++n) { const u32x2_ ww = S[mm][bj][n]; \
            const f32x4 s = {__uint_as_float(ww[0] << 16), __uint_as_float(ww[0] & 0xffff0000u), __uint_as_float(ww[1] << 16), __uint_as_float(ww[1] & 0xffff0000u)}; \
            const f32x4 o_ = s + gv[bj][n] * acc[(Q) >> 1][bj][((Q) & 1) * 2 + mm][n]; f32x4* op_ = (f32x4*)(dst + (size_t)((e0 + (unsigned)((((Q) >> 1) * HALF + (((Q) & 1) * 2 + mm) * 16) * 2048 + bj * HALF + n * (RES_PERM ? 4 : 16))) * 4u)); \
            if (OUT_NT) __builtin_nontemporal_store(o_, op_); else *op_ = o_; } } while (0)
        PG8_RL1_LD(sa, 0); PG8_RL1_LD(sb, 1);
        PG8_RL1_ST(sa, 0); PG8_RL1_LD(sa, 2);
        PG8_RL1_ST(sb, 1); PG8_RL1_LD(sb, 3);
        PG8_RL1_ST(sa, 2); PG8_RL1_ST(sb, 3);
#undef PG8_RL1_LD
#undef PG8_RL1_ST
    }
};

struct EpiRes {
    static constexpr int EPI_ID = 5; static constexpr bool PERM = false, AFTER_DRAIN = false, PREFETCH = false;
    const float* xsrc; float* xdst; const float* csrc; float* cdst; const float* mod; int tpb;
    __device__ __forceinline__ void operator()(const f32x4 (&acc)[2][2][4][2], const Unit& u, int wr, int wc, int fr, int fq) const {
        const int b = u.pm / tpb, j = u.pm - b * tpb;
        const float* src; float* dst; const float* g;
        if (tpb == 9 && j == 0) { const size_t off = (size_t)b * 256 * 2048; src = csrc + off; dst = cdst + off; g = mod + 8 * 6144 + 4096; }
        else { const int jj = (tpb == 9) ? j - 1 : j; const size_t off = ((size_t)b * 2048 + (size_t)jj * 256) * 2048; src = xsrc + off; dst = xdst + off; g = mod + b * 6144 + 4096; }
        const int r0 = wr * 64 + fr, col0 = u.pn * BM + wc * 32 + 4 * fq;
        f32x4 gv[2][2];
#pragma unroll
        for (int bj = 0; bj < 2; ++bj)
#pragma unroll
            for (int n = 0; n < 2; ++n) gv[bj][n] = *(const f32x4*)(g + col0 + bj * HALF + n * 16);
#pragma unroll
        for (int ai = 0; ai < 2; ++ai)
#pragma unroll
            for (int m = 0; m < 4; ++m) { const size_t roff = (size_t)(r0 + ai * HALF + m * 16) * 2048 + col0;
#pragma unroll
                for (int bj = 0; bj < 2; ++bj)
#pragma unroll
                    for (int n = 0; n < 2; ++n) { const f32x4 s = *(const f32x4*)(src + roff + bj * HALF + n * 16); *(f32x4*)(dst + roff + bj * HALF + n * 16) = s + gv[bj][n] * acc[ai][bj][m][n]; }
                asm volatile("" ::: "memory"); }
    }
};

template <class Epi, class Sched, bool ALIGN_EPI = false, bool SP2 = false>
__device__ __forceinline__ void gemm_phase(PG8_LAS unsigned char* lds, const Gemm g, const Sched& S, const Epi& E, const int tid  ) {
    const int wid = __builtin_amdgcn_readfirstlane(tid >> 6), lane = tid & 63, wr = wid >> 2, wc = wid & 3, fr = lane & 15, fq = lane >> 4;
    const int K = g.K, nt = K / BK;
    unsigned voffA[2], voffB[2];
#pragma unroll
    for (int i = 0; i < 2; ++i) { int R, C; stage_rc(tid * 16 + i * 8192, R, C); const int Rb = Epi::PERM ? ((R & ~31) + perm32(R & 31)) : R;
        voffA[i] = (unsigned)(R * K + C) * 2u; voffB[i] = (unsigned)(Rb * K + C) * 2u; }
    const size_t kstep = (size_t)(BK * 2);
    const size_t hstep = (size_t)HALF * K * 2;
    const size_t tstep = 2 * hstep;
    const unsigned ldsw = (unsigned)wid * 1024u;
    const int aoff = lds_byte(wr * 64 + fr, fq * 8), boff = lds_byte(wc * 32 + fr, fq * 8);
#define PG8_SA(b, h) (((b) * 2 + (h)) * HTB)
#define PG8_SB(b, h) ((4 + (b) * 2 + (h)) * HTB)
#define PG8_STAGE(bufoff, gbase, voff) do { _Pragma("unroll") for (int _i = 0; _i < 2; ++_i) \
        __builtin_amdgcn_global_load_lds((const unsigned*)((const char*)(gbase) + (voff)[_i]), (PG8_LAS unsigned*)(lds + (bufoff) + ldsw + _i * 8192), 16, 0, 0); } while (0)
#define PG8_LDA(dst, b, h) do { _Pragma("unroll") for (int m = 0; m < 4; ++m) _Pragma("unroll") for (int k = 0; k < 2; ++k) dst[m][k] = *(const PG8_LAS bf16x8*)(lds + PG8_SA(b, h) + aoff + m * 2048 + k * 1024); } while (0)
#define PG8_LDB(dst, b, h) do { _Pragma("unroll") for (int n = 0; n < 2; ++n) _Pragma("unroll") for (int k = 0; k < 2; ++k) dst[n][k] = *(const PG8_LAS bf16x8*)(lds + PG8_SB(b, h) + boff + n * 2048 + k * 1024); } while (0)
#define PG8_MMA(ai, bj, At, Bt) do { if (GEMM_PRIO == 0) __builtin_amdgcn_s_setprio(1); _Pragma("unroll") for (int m = 0; m < 4; ++m) _Pragma("unroll") for (int n = 0; n < 2; ++n) _Pragma("unroll") for (int k = 0; k < 2; ++k) \
        acc[ai][bj][m][n] = __builtin_amdgcn_mfma_f32_16x16x32_bf16(Bt[n][k], At[m][k], acc[ai][bj][m][n], 0, 0, 0); if (GEMM_PRIO == 0) __builtin_amdgcn_s_setprio(0); } while (0)
#define PG8_WAIT_V(n) asm volatile("s_waitcnt vmcnt(" #n ")" ::: "memory")
#define PG8_WAIT_L(n) asm volatile("s_waitcnt lgkmcnt(" #n ")" ::: "memory")
#define PG8_BAR __builtin_amdgcn_s_barrier()
#define PG8_SCHED __builtin_amdgcn_sched_barrier(0)
#define PG8_LPRI(p) do { if (GEMM_PRIO == 1) __builtin_amdgcn_s_setprio(p); } while (0)
    Unit cur, nxt; int ui = 0;
    if (!S.next(0, cur)) return;
#if PROBE_GE
    unsigned long long ge_acc = 0, ge_t0 = __builtin_amdgcn_s_memtime();
#endif
    f32x4 acc[2][2][4][2];
#pragma unroll
    for (int a = 0; a < 2; ++a)
#pragma unroll
        for (int b = 0; b < 2; ++b)
#pragma unroll
            for (int m = 0; m < 4; ++m)
#pragma unroll
                for (int n = 0; n < 2; ++n) acc[a][b][m][n] = (f32x4){0.f, 0.f, 0.f, 0.f};
    bf16x8 At[4][2], B0[2][2], B1[2][2];
    const char* cA = (const char*)g.A + (size_t)cur.pm * tstep; const char* cB = (const char*)g.Bt + (size_t)cur.pn * tstep;
    S.a_ready(cur);
    if constexpr (SP2) {
        PG8_STAGE(PG8_SB(0, 0), cB, voffB); PG8_STAGE(PG8_SB(0, 1), cB + hstep, voffB); PG8_STAGE(PG8_SA(0, 0), cA, voffA); PG8_STAGE(PG8_SA(0, 1), cA + hstep, voffA);
        if (wr == 1) PG8_BAR;
        PG8_WAIT_V(2); PG8_BAR;
        PG8_STAGE(PG8_SB(1, 0), cB + kstep, voffB); PG8_STAGE(PG8_SA(1, 0), cA + kstep, voffA); PG8_STAGE(PG8_SB(1, 1), cB + hstep + kstep, voffB);
        PG8_WAIT_V(6); PG8_BAR;
    } else {
        PG8_STAGE(PG8_SB(0, 0), cB, voffB); PG8_STAGE(PG8_SA(0, 0), cA, voffA); PG8_STAGE(PG8_SB(0, 1), cB + hstep, voffB); PG8_STAGE(PG8_SA(0, 1), cA + hstep, voffA);
        if (wr == 1) PG8_BAR;
        PG8_WAIT_V(4); PG8_BAR;
        PG8_STAGE(PG8_SB(1, 0), cB + kstep, voffB); PG8_STAGE(PG8_SA(1, 0), cA + kstep, voffA); PG8_STAGE(PG8_SB(1, 1), cB + hstep + kstep, voffB);
        PG8_WAIT_V(6); PG8_BAR;
    }
    for (;;) {
        const bool has_next = S.next(ui + 1, nxt);
        const char* nA = has_next ? (const char*)g.A + (size_t)nxt.pm * tstep : cA; const char* nB = has_next ? (const char*)g.Bt + (size_t)nxt.pn * tstep : cB;
        for (int t = 0; t < nt; t += 2) {
            const bool last = (t == nt - 2);
            const char* a1 = cA + (size_t)(t + 1) * kstep;
            const char* a2 = last ? nA : cA + (size_t)(t + 2) * kstep; const char* b2 = last ? nB : cB + (size_t)(t + 2) * kstep;
            const char* a3 = a2 + kstep; const char* b3 = b2 + kstep;
            if (last && has_next) S.a_ready(nxt);
            if constexpr (Epi::PREFETCH) { if (t == nt - 10) E.prefetch(cur, tid, lds + STAGE_BYTES + 4096 + wid * 256); }
            if constexpr (SP2) {
            PG8_LPRI(1); PG8_LDB(B0, 0, 0); PG8_LDB(B1, 0, 1); PG8_SCHED; PG8_LDA(At, 0, 0); PG8_STAGE(PG8_SA(1, 1), a1 + hstep, voffA);
            PG8_WAIT_V(8); PG8_WAIT_L(0); PG8_LPRI(0); PG8_BAR; PG8_MMA(0, 0, At, B0); PG8_MMA(0, 1, At, B1); PG8_BAR; PG8_SCHED;
            PG8_LPRI(1); PG8_LDA(At, 0, 1); PG8_STAGE(PG8_SB(0, 0), b2, voffB); PG8_STAGE(PG8_SB(0, 1), b2 + hstep, voffB); PG8_STAGE(PG8_SA(0, 0), a2, voffA);
            PG8_WAIT_V(8); PG8_WAIT_L(0); PG8_LPRI(0); PG8_BAR; PG8_MMA(1, 0, At, B0); PG8_MMA(1, 1, At, B1); PG8_BAR; PG8_SCHED;
            PG8_LPRI(1); PG8_LDB(B0, 1, 0); PG8_LDB(B1, 1, 1); PG8_SCHED; PG8_LDA(At, 1, 0); PG8_STAGE(PG8_SA(0, 1), a2 + hstep, voffA);
            PG8_WAIT_V(8); PG8_WAIT_L(0); PG8_LPRI(0); PG8_BAR; PG8_MMA(0, 0, At, B0); PG8_MMA(0, 1, At, B1); PG8_BAR; PG8_SCHED;
            PG8_LPRI(1); PG8_LDA(At, 1, 1); PG8_STAGE(PG8_SB(1, 0), b3, voffB); PG8_STAGE(PG8_SB(1, 1), b3 + hstep, voffB); PG8_STAGE(PG8_SA(1, 0), a3, voffA);
            PG8_WAIT_V(8); PG8_WAIT_L(0); PG8_LPRI(0); PG8_BAR; PG8_MMA(1, 0, At, B0); PG8_MMA(1, 1, At, B1); PG8_BAR; PG8_SCHED;
            } else {
            PG8_LDB(B0, 0, 0); PG8_SCHED; PG8_LDA(At, 0, 0); PG8_STAGE(PG8_SA(1, 1), a1 + hstep, voffA);
            PG8_WAIT_L(8); PG8_BAR; PG8_WAIT_L(0); PG8_MMA(0, 0, At, B0); PG8_BAR; PG8_SCHED;
            PG8_LDB(B1, 0, 1); PG8_STAGE(PG8_SB(0, 0), b2, voffB);
            PG8_BAR; PG8_WAIT_L(0); PG8_MMA(0, 1, At, B1); PG8_BAR;
            PG8_LDA(At, 0, 1); PG8_STAGE(PG8_SA(0, 0), a2, voffA);
            PG8_BAR; PG8_WAIT_L(0); PG8_MMA(1, 0, At, B0); PG8_BAR; PG8_SCHED;
            PG8_STAGE(PG8_SB(0, 1), b2 + hstep, voffB);
            PG8_WAIT_V(6); PG8_BAR; PG8_MMA(1, 1, At, B1); PG8_BAR;
            PG8_LDB(B0, 1, 0); PG8_SCHED; PG8_LDA(At, 1, 0); PG8_STAGE(PG8_SA(0, 1), a2 + hstep, voffA);
            PG8_WAIT_L(8); PG8_BAR; PG8_WAIT_L(0); PG8_MMA(0, 0, At, B0); PG8_BAR; PG8_SCHED;
            PG8_LDB(B1, 1, 1); PG8_STAGE(PG8_SB(1, 0), b3, voffB);
            PG8_BAR; PG8_WAIT_L(0); PG8_MMA(0, 1, At, B1); PG8_BAR;
            PG8_LDA(At, 1, 1); PG8_STAGE(PG8_SA(1, 0), a3, voffA);
            PG8_BAR; PG8_WAIT_L(0); PG8_MMA(1, 0, At, B0); PG8_BAR; PG8_SCHED;
            PG8_STAGE(PG8_SB(1, 1), b3 + hstep, voffB);
            PG8_WAIT_V(6); PG8_BAR; PG8_MMA(1, 1, At, B1); PG8_BAR;
            }
        }
        if constexpr (ALIGN_EPI) { if (wr == 0) PG8_BAR; }
#if PROBE_GE == 2
        if (Epi::EPI_ID == PROBE_GE_SEL) ge_acc += __builtin_amdgcn_s_memtime() - ge_t0;
#endif
#if PROBE_GE == 1
        ge_t0 = __builtin_amdgcn_s_memtime();
#endif
        if constexpr (!Epi::AFTER_DRAIN) { E(acc, cur, wr, wc, fr, fq); S.done(cur); }
#if PROBE_GE == 1
        if (Epi::EPI_ID == PROBE_GE_SEL) { asm volatile("s_waitcnt vmcnt(0)" ::: "memory"); ge_acc += __builtin_amdgcn_s_memtime() - ge_t0; }
#endif
#if PROBE_GE == 2
        ge_t0 = __builtin_amdgcn_s_memtime();
#endif
        if (!has_next) break;
#pragma unroll
        for (int a = 0; a < 2; ++a)
#pragma unroll
            for (int b = 0; b < 2; ++b)
#pragma unroll
                for (int m = 0; m < 4; ++m)
#pragma unroll
                    for (int n = 0; n < 2; ++n) acc[a][b][m][n] = (f32x4){0.f, 0.f, 0.f, 0.f};
        cur = nxt; cA = nA; cB = nB; ++ui;
        if constexpr (ALIGN_EPI) { if (wr == 1) PG8_BAR; }
    }
    PG8_WAIT_V(0);
    if constexpr (!ALIGN_EPI) { if (wr == 0) PG8_BAR; }
    PG8_BAR;
    if constexpr (Epi::AFTER_DRAIN) { E.fused(acc, cur, wr, wc, fr, fq, lds, wid, lane); S.done(cur); }
#if PROBE_GE
    if (Epi::EPI_ID == PROBE_GE_SEL && blockIdx.x == PROBE_GE_BLOCK && wid == 0) { const unsigned long long t0_ = __builtin_amdgcn_s_memtime(); while (__builtin_amdgcn_s_memtime() - t0_ < 8 * ge_acc) __builtin_amdgcn_s_sleep(8); }
#endif
#undef PG8_SA
#undef PG8_SB
#undef PG8_STAGE
#undef PG8_LDA
#undef PG8_LDB
#undef PG8_MMA
#undef PG8_WAIT_V
#undef PG8_WAIT_L
#undef PG8_BAR
#undef PG8_SCHED
#undef PG8_LPRI
}
}

constexpr int NWAVES = 8;
#ifndef ADA_CH
#define ADA_CH 32
#endif
#ifndef L1_LATE
#define L1_LATE 1
#endif
#ifndef P0_LD16
#define P0_LD16 1
#endif
#ifndef ADA_X4
#define ADA_X4 1
#endif
#ifndef ADA_W128
#define ADA_W128 0
#endif
#ifndef MOD_CONTIG
#define MOD_CONTIG 1
#endif
#ifndef MOD_DEPTH
#define MOD_DEPTH 2
#endif
#ifndef NT_STREAMS
#define NT_STREAMS 0
#endif
#if NT_STREAMS
#define NT_LD(p) __builtin_nontemporal_load(p)
#else
#define NT_LD(p) (*(p))
#endif
#ifndef L1_SCAN_ITEMS
#define L1_SCAN_ITEMS 5120
#endif
#ifndef L1_LATE_ITEMS
#define L1_LATE_ITEMS 10240
#endif
#ifndef P0_TFIRST
#define P0_TFIRST 0
#endif
#ifndef PROBE_PH_BLOCK
#define PROBE_PH_BLOCK 0
#endif
#ifndef PROBE_PH_AMP
#define PROBE_PH_AMP 1
#endif
#ifndef PROBE_PH_MASK
#define PROBE_PH_MASK 0
#endif
#ifndef PROBE_DUP_MASK
#define PROBE_DUP_MASK 0
#endif
#ifndef MK_ONE_LAUNCH
#define MK_ONE_LAUNCH 1
#endif
constexpr int NB = 8, SEQ = 2048, NCTX = 256, LTOK = SEQ + NCTX, DM = 2048;
constexpr int MROWS = NB * LTOK;
constexpr int MLAT = NB * SEQ;
constexpr int NE_SRC = 8224, NP = 8192;
#ifndef P_PITCH
#define P_PITCH 8256
#endif
constexpr int LDP = P_PITCH;
constexpr float EPS = 1e-6f;
constexpr int EC_AQ = 0, EC_AFF = 1024, EC_AFB = 2048, EC_AI = 3072, EC_BQ = 4096, EC_BK = 4608, EC_BV = 5120, EC_GATE = 6144;
constexpr int OC_Q = 0, OC_K = 2048, OC_V = 4096, OC_GATE = 6144;
constexpr float QSCALE = 0.12751743074602467f;
constexpr float LAM_INIT1 = 0.35550906759f;

constexpr size_t MiB = 1u << 20;
constexpr size_t WS_CTL = 0, CTL_ZERO_BYTES = 1 * MiB;
constexpr size_t WS_MOD = 1 * MiB;
constexpr size_t WS_WZ = 2 * MiB;
constexpr size_t WS_LBT = 2 * MiB + 512 * 1024;
constexpr size_t WS_ROPE = 2 * MiB + 768 * 1024;
constexpr size_t WS_Z = 3 * MiB;
constexpr size_t WS_WOO = 8 * MiB;
constexpr size_t WS_WIE = 16 * MiB;
constexpr size_t WS_WOE = 48 * MiB;
constexpr size_t WS_WIO = 56 * MiB;
constexpr size_t WS_H = 88 * MiB;
constexpr size_t WS_P = 160 * MiB;
constexpr size_t WS_CTX1 = 452 * MiB;
constexpr size_t WS_LA = 468 * MiB;
constexpr size_t WS_X1A = 16 * MiB, WS_X1B = 468 * MiB, WS_C1B = 500 * MiB;
constexpr size_t WS_END = 508 * MiB;
static_assert(WS_P + (size_t)MROWS * LDP * 2 <= WS_CTX1, "projection buffer");
constexpr size_t WS_O0 = WS_H, WS_O1 = 80 * MiB;
static_assert(WS_O0 + (size_t)MLAT * DM * 2 <= WS_P && WS_X1A + (size_t)8192 * DM * 2 <= WS_WOE && WS_X1B + (size_t)8192 * DM * 2 <= WS_C1B && WS_C1B + (size_t)2048 * DM * 2 <= WS_END, "overlays");

constexpr int LDS_BYTES = 147456;
constexpr int LDSCTL_OFF = 131072, MISC_OFF = LDSCTL_OFF + 320;
constexpr int CW_RANK = 8192;
constexpr int CW_BAR = 4096;

#define GAS __attribute__((address_space(1)))
#define LAS __attribute__((address_space(3)))
typedef unsigned short bf16;
typedef unsigned v4u __attribute__((ext_vector_type(4)));
typedef unsigned v2u __attribute__((ext_vector_type(2)));
typedef float f32x4 __attribute__((ext_vector_type(4)));
typedef short bf16x8 __attribute__((ext_vector_type(8)));

__device__ __forceinline__ unsigned f2bf(float f) { unsigned u = __builtin_bit_cast(unsigned, f); return (u + 0x7fffu + ((u >> 16) & 1u)) >> 16; }
__device__ __forceinline__ unsigned pk2(float lo, float hi) { return f2bf(lo) | (f2bf(hi) << 16); }
__device__ __forceinline__ float bf2f(unsigned short v) { return __uint_as_float((unsigned)v << 16); }
__device__ __forceinline__ float bflo(unsigned w) { return __uint_as_float(w << 16); }
__device__ __forceinline__ float bfhi(unsigned w) { return __uint_as_float(w & 0xffff0000u); }
__device__ __forceinline__ void unpack8(const v4u w, float (&x)[8]) { x[0] = bflo(w.x); x[1] = bfhi(w.x); x[2] = bflo(w.y); x[3] = bfhi(w.y); x[4] = bflo(w.z); x[5] = bfhi(w.z); x[6] = bflo(w.w); x[7] = bfhi(w.w); }
__device__ __forceinline__ v4u pack8(const float (&x)[8]) { v4u w; w.x = pk2(x[0], x[1]); w.y = pk2(x[2], x[3]); w.z = pk2(x[4], x[5]); w.w = pk2(x[6], x[7]); return w; }
__device__ __forceinline__ v4u pack8c(const float (&x)[8]) { v4u w; w.x = pg8::cvt_pk_bf16(x[0], x[1]); w.y = pg8::cvt_pk_bf16(x[2], x[3]); w.z = pg8::cvt_pk_bf16(x[4], x[5]); w.w = pg8::cvt_pk_bf16(x[6], x[7]); return w; }
typedef float f32x2c_ __attribute__((ext_vector_type(2))); typedef __bf16 bf16x2c_ __attribute__((ext_vector_type(2)));
__device__ __forceinline__ unsigned cvtpk_c(float lo, float hi) { const f32x2c_ v = {lo, hi}; const bf16x2c_ b = __builtin_convertvector(v, bf16x2c_); return __builtin_bit_cast(unsigned, b); }
__device__ __forceinline__ float wave_sum(float v) {
#pragma unroll
    for (int o = 1; o < 64; o <<= 1) v += __shfl_xor(v, o);
    return v;
}
__device__ __forceinline__ float sigmoidf_(float x) { return 1.f / (1.f + __expf(-x)); }
__device__ __forceinline__ float siluf_(float x) { return x / (1.f + __expf(-x)); }
__device__ __forceinline__ float logsigmoidf_(float x) { return fminf(x, 0.f) - log1pf(__expf(-fabsf(x))); }
__device__ __forceinline__ void sincos_(float x, float& s, float& c) {
    const float k = rintf(x * 0.63661977236758134f);
    float r = fmaf(-k, 1.5707962512969971f, x); r = fmaf(-k, 7.5497894158615964e-8f, r);
    const float r2 = r * r;
    float sp = fmaf(r2, 2.7557314297e-6f, -1.9841270114e-4f); sp = fmaf(sp, r2, 8.3333337680e-3f); sp = fmaf(sp, r2, -1.6666667163e-1f); sp = fmaf(sp * r2, r, r);
    float cp = fmaf(r2, 2.4801587642e-5f, -1.3888889225e-3f); cp = fmaf(cp, r2, 4.1666667908e-2f); cp = fmaf(cp, r2, -0.5f); cp = fmaf(cp, r2, 1.0f);
    const int q = (int)k & 3;
    const float ss = (q & 1) ? cp : sp, cc = (q & 1) ? sp : cp;
    s = (q & 2) ? -ss : ss; c = ((q + 1) & 2) ? -cc : cc;
}

constexpr int WTAB_OFF = 131072 + 512;
__device__ __forceinline__ int lane_id_() { int l_; asm volatile("v_mbcnt_lo_u32_b32 %0, -1, 0\n\tv_mbcnt_hi_u32_b32 %0, -1, %0" : "=v"(l_)); return l_; }
__device__ __forceinline__ int hw_slot_() { return (int)(__builtin_amdgcn_s_getreg(((6 - 1) << 11) | 4) & 63u); }
__device__ __forceinline__ int wave_id_(LAS unsigned char* lds0) { return __builtin_amdgcn_readfirstlane((int)((volatile LAS unsigned*)(lds0 + WTAB_OFF))[hw_slot_()]); }
#define XB_TMO      128
#define XB_XCNT(j)  (256  + 64 * (j))
#define XB_XSUB(j)  (1280 + 64 * (j))
#define XB_XGEN(j)  (2304 + 64 * (j))
#define XB_TOP      3328
#define XB_TOPGEN   3392
#define XCD_BAR_WORDS 3456
#define XB_SPIN_CAP (1u << 18)

__device__ __forceinline__ unsigned xb_ld(unsigned* p)              { return __hip_atomic_load(p, __ATOMIC_RELAXED, __HIP_MEMORY_SCOPE_AGENT); }
__device__ __forceinline__ unsigned xb_add(unsigned* p, unsigned v) { return __hip_atomic_fetch_add(p, v, __ATOMIC_RELAXED, __HIP_MEMORY_SCOPE_AGENT); }
__device__ __forceinline__ unsigned xb_xcc_id() { return (unsigned)__builtin_amdgcn_s_getreg((3 << 11) | 20) & 0xFu; }
#define XB_SPIN(cond, bar) do { unsigned _sp = 0; while (cond) { __builtin_amdgcn_s_sleep(1); \
    if ((++_sp & 255u) == 0u) { if (xb_ld(&(bar)[XB_TMO])) break; if (_sp > XB_SPIN_CAP) { atomicAdd(&(bar)[XB_TMO], 1u); break; } } } } while (0)

struct XcdBarrier {
    unsigned* bar; unsigned x; int w; LAS unsigned char* lds0;
    volatile LAS unsigned* st;
};

__device__ __forceinline__ XcdBarrier xcd_barrier_post(unsigned* bar, volatile LAS unsigned* st, int wave, LAS unsigned char* lds0) {
    XcdBarrier b; b.bar = bar; b.x = xb_xcc_id(); b.st = st; b.w = wave; b.lds0 = lds0;
    if (b.w == 0 && lane_id_() == 0) (void)xb_add(&bar[XB_XCNT(b.x)], 1u);
    return b;
}
__device__ __forceinline__ void xcd_barrier_complete(unsigned* bar, unsigned x, unsigned& nloc, unsigned& nx) {
    const unsigned G = gridDim.x * gridDim.y * gridDim.z;
    unsigned sum, cnt, mine, sp = 0u;
    for (;;) {
        sum = 0u; cnt = 0u; mine = 0u;
#pragma unroll
        for (unsigned j = 0; j < 16; ++j) { const unsigned c = xb_ld(&bar[XB_XCNT(j)]); sum += c; cnt += (c > 0u) ? 1u : 0u; mine = (j == x) ? c : mine; }
        if (sum == G) break;
        __builtin_amdgcn_s_sleep(1);
        if ((++sp & 255u) == 0u) { if (xb_ld(&bar[XB_TMO])) break; if (sp > XB_SPIN_CAP) { atomicAdd(&bar[XB_TMO], 1u); break; } }
    }
    nloc = mine > 0u ? mine : 1u; nx = cnt > 0u ? cnt : 1u;
}

__device__ __forceinline__ void xcd_barrier(const XcdBarrier& b) {
    asm volatile("s_waitcnt vmcnt(0)" ::: "memory");
    __syncthreads();
    if (wave_id_(b.lds0) == 0 && lane_id_() == 0) {
        unsigned* bar = b.bar;
        __builtin_amdgcn_s_waitcnt(0);
        unsigned nloc = b.st[0], nx = b.st[1];
        if (nloc == 0u) { xcd_barrier_complete(bar, b.x, nloc, nx); b.st[0] = nloc; b.st[1] = nx; }
        const unsigned old = xb_add(&bar[XB_XSUB(b.x)], 1u);
        const unsigned gen = old / nloc;
        if (old + 1u == (gen + 1u) * nloc) {
            __builtin_amdgcn_fence(__ATOMIC_RELEASE, "agent");
            asm volatile("s_waitcnt vmcnt(0)" ::: "memory");
            const unsigned og = xb_add(&bar[XB_TOP], 1u);
            const unsigned tg = og / nx;
            if (og + 1u == (tg + 1u) * nx) xb_add(&bar[XB_TOPGEN], 1u);
            else XB_SPIN(xb_ld(&bar[XB_TOPGEN]) == tg, bar);
            __builtin_amdgcn_fence(__ATOMIC_ACQUIRE, "agent");
            xb_add(&bar[XB_XGEN(b.x)], 1u);
            asm volatile("s_waitcnt vmcnt(0)" ::: "memory");
        } else {
            XB_SPIN(xb_ld(&bar[XB_XGEN(b.x)]) == gen, bar);
            __builtin_amdgcn_fence(__ATOMIC_ACQUIRE, "agent");
            asm volatile("s_waitcnt vmcnt(0)" ::: "memory");
        }
    }
    __syncthreads();
}

struct Args { const float* in[20]; float* out; unsigned char* ws; int ph_lo, ph_hi; };
__device__ __forceinline__ int tid_() { int t = threadIdx.x; asm volatile("" : "+v"(t)); return t; }
__device__ __forceinline__ const float* argp(int i) {
    const __attribute__((address_space(4))) char* ka = (const __attribute__((address_space(4))) char*)__builtin_amdgcn_kernarg_segment_ptr();
    int off = i * 8; asm volatile("" : "+s"(off));
    return *(const float* const __attribute__((address_space(4)))*)(ka + off);
}
__device__ __forceinline__ unsigned char* karg_ptr_(int off) {
    const __attribute__((address_space(4))) char* ka = (const __attribute__((address_space(4))) char*)__builtin_amdgcn_kernarg_segment_ptr();
    asm volatile("" : "+s"(off));
    return *(unsigned char* const __attribute__((address_space(4)))*)(ka + off);
}
struct Frame {
    LAS unsigned char* lds;
    int tid, lane, wave, G;
    float* out; unsigned char* ws;
    __device__ __forceinline__ void ids() { int l_ = lane_id_(); asm volatile("" : "+v"(l_)); lane = l_; wave = wave_id_(lds); tid = wave * 64 + l_; out = (float*)karg_ptr_(160); ws = karg_ptr_(168); }
};
enum { I_X = 0, I_C, I_CTX, I_CCTX, I_NG, I_WADA, I_BADA, I_LB, I_WINE, I_WA2, I_BA2, I_AG, I_BG, I_WOE, I_WINO, I_QG, I_KG, I_LQK, I_CG, I_WOO };

__device__ __forceinline__ void p0_transpose_item(const float* W, int N, int k0, int n0, bf16* WT, int drow0, LAS float* scr, int lane, bool perm128 = false) {
#if P0_LD16
    {
        f32x4 t_[8];
#pragma unroll
        for (int i = 0; i < 8; ++i) { const int kk = 8 * i + (lane >> 3); t_[i] = *(const f32x4*)(W + (size_t)(k0 + kk) * N + n0 + (lane & 7) * 4); }
#pragma unroll
        for (int i = 0; i < 8; ++i) { const int kk = 8 * i + (lane >> 3); LAS float* d_ = scr + kk * 33 + (lane & 7) * 4; d_[0] = t_[i][0]; d_[1] = t_[i][1]; d_[2] = t_[i][2]; d_[3] = t_[i][3]; }
    }
#else
#pragma unroll 8
    for (int i = 0; i < 32; ++i) { const int kk = 2 * i + (lane >> 5); scr[kk * 33 + (lane & 31)] = W[(size_t)(k0 + kk) * N + n0 + (lane & 31)]; }
#endif
    asm volatile("s_waitcnt lgkmcnt(0)" ::: "memory");
    const int c = lane & 7;
#pragma unroll
    for (int j = 0; j < 4; ++j) { const int n = (lane >> 3) + 8 * j; const LAS float* s = scr + (8 * c) * 33 + n;
        v4u o; o.x = pk2(s[0 * 33], s[1 * 33]); o.y = pk2(s[2 * 33], s[3 * 33]); o.z = pk2(s[4 * 33], s[5 * 33]); o.w = pk2(s[6 * 33], s[7 * 33]);
        int drow = drow0 + n;
        if (perm128) { const int d = drow & 127; drow = (drow & ~127) + (d >> 6) * 64 + 2 * (d & 31) + ((d >> 5) & 1); }
        *(GAS v4u*)(WT + (size_t)drow * 2048 + k0 + 8 * c) = o; }
    asm volatile("s_waitcnt lgkmcnt(0)" ::: "memory");
}
#ifndef P0_NO
#define P0_NO 0
#endif
constexpr int P0_I_E = 32 * 257, P0_I_S = 32 * 64, P0_I_O = 32 * 256;
constexpr int L1_SPLIT = P0_I_E + P0_I_S + P0_I_O + P0_I_S - L1_LATE_ITEMS;
__device__ __forceinline__ void p0_transposes(Frame& F, int first, int last, int gw, int ngw) {
    LAS float* scr = (LAS float*)(F.lds + F.wave * 16384);
    const float* wine_ = argp(I_WINE); const float* woe_ = argp(I_WOE); const float* wino_ = argp(I_WINO); const float* woo_ = argp(I_WOO);
    for (int it = first + gw; it < last; it += ngw) {
        int r = it;
        if (r < P0_I_E) { const int kb = r / 257, nb = r % 257;
            if (nb < 192) p0_transpose_item(wine_, NE_SRC, 64 * kb, 32 * nb, (bf16*)(F.ws + WS_WIE), 32 * nb, scr, F.lane);
            else if (nb == 192) p0_transpose_item(wine_, NE_SRC, 64 * kb, 32 * nb, (bf16*)(F.ws + WS_WZ), 0, scr, F.lane);
            else p0_transpose_item(wine_, NE_SRC, 64 * kb, 32 * nb, (bf16*)(F.ws + WS_WIE), 32 * nb - 32, scr, F.lane);
            continue; }
        r -= P0_I_E;
        if (r < P0_I_S) { p0_transpose_item(woe_, 2048, 64 * (r / 64), 32 * (r % 64), (bf16*)(F.ws + WS_WOE), 32 * (r % 64), scr, F.lane); continue; }
        r -= P0_I_S;
        if (r < P0_I_O) { p0_transpose_item(wino_, 8192, 64 * (r / 256), 32 * (r % 256), (bf16*)(F.ws + WS_WIO), 32 * (r % 256), scr, F.lane, (r % 256) < 128); continue; }
        r -= P0_I_O;
        p0_transpose_item(woo_, 2048, 64 * (r / 64), 32 * (r % 64), (bf16*)(F.ws + WS_WOO), 32 * (r % 64), scr, F.lane);
    }
}
#if PROBE_PH_MASK
#define P0_ON(k) do { if ((PROBE_PH_MASK >> (k)) & 1) p0_t0 = __builtin_amdgcn_s_memtime(); } while (0)
#define P0_OFF(k) do { if ((PROBE_PH_MASK >> (k)) & 1) p0_acc += __builtin_amdgcn_s_memtime() - p0_t0; } while (0)
#else
#define P0_ON(k) do { } while (0)
#define P0_OFF(k) do { } while (0)
#endif
__device__ __forceinline__ void p0_prologue(Frame& F) {
#if PROBE_PH_MASK
    unsigned long long p0_acc = 0, p0_t0 = 0;
#endif
#if P0_TFIRST
    P0_ON(13);
    { constexpr int NIT = P0_I_E + P0_I_S + P0_I_O + P0_I_S;
      if (P0_NO > 0 && F.G == 256) { constexpr int n_o = 64 * NWAVES * P0_NO;
          if (blockIdx.x >= 192) p0_transposes(F, 0, n_o, ((int)blockIdx.x - 192) * NWAVES + F.wave, 64 * NWAVES);
          else p0_transposes(F, n_o, NIT, (int)blockIdx.x * NWAVES + F.wave, 192 * NWAVES); }
      else p0_transposes(F, 0, (L1_LATE && F.G == 256) ? L1_SPLIT : NIT, blockIdx.x * NWAVES + F.wave, F.G * NWAVES); }
    P0_OFF(13);
    __syncthreads();
#endif
    P0_ON(12);
#if ADA_W128
    if (F.G == 256 && blockIdx.x < 96) {
        const int l = blockIdx.x / 48, n0 = (blockIdx.x % 48) * 128;
        LAS float* sc = (LAS float*)F.lds;
        LAS float* red = (LAS float*)(F.lds + 9 * 2048 * 4);
        const float* cin_ = argp(I_C); const float* ccx_ = argp(I_CCTX); const float* bada_ = argp(I_BADA);
        {   float cv[36];
#pragma unroll
            for (int j = 0; j < 36; ++j) { const int i = F.tid + 512 * j, r = i >> 11, k = i & 2047; cv[j] = (r < 8) ? cin_[r * 2048 + k] : ccx_[k]; }
#pragma unroll
            for (int j = 0; j < 36; ++j) sc[F.tid + 512 * j] = siluf_(cv[j]);
        }
        __syncthreads();
        const char* wbase = (const char*)(argp(I_WADA) + (size_t)l * 2048 * 6144 + n0);
        float a0[9], a1[9];
#pragma unroll
        for (int r = 0; r < 9; ++r) { a0[r] = 0.f; a1[r] = 0.f; }
        const int kb = F.wave * 256;
        float wa0[16], wa1[16], wb0[16], wb1[16];
        unsigned voff = (unsigned)(F.lane * 4 + kb * 24576);
        const LAS float* scp = sc + kb;
#define ADA_LD(W0_, W1_) do { _Pragma("unroll") for (int i = 0; i < 16; ++i) { W0_[i] = *(const float*)(wbase + (voff + (unsigned)(i * 24576))); W1_[i] = *(const float*)(wbase + (voff + (unsigned)(i * 24576 + 256))); } voff += 16u * 24576u; } while (0)
#define ADA_FMA(W0_, W1_) do { _Pragma("unroll") for (int q = 0; q < 4; ++q) { _Pragma("unroll") for (int r = 0; r < 9; ++r) { const f32x4 s_ = *(const LAS f32x4*)(scp + r * 2048 + 4 * q); \
            a0[r] += s_[0] * W0_[4 * q] + s_[1] * W0_[4 * q + 1] + s_[2] * W0_[4 * q + 2] + s_[3] * W0_[4 * q + 3]; a1[r] += s_[0] * W1_[4 * q] + s_[1] * W1_[4 * q + 1] + s_[2] * W1_[4 * q + 2] + s_[3] * W1_[4 * q + 3]; } \
            asm volatile("" : "+v"(a0[0]), "+v"(a0[1]), "+v"(a0[2]), "+v"(a0[3]), "+v"(a0[4]), "+v"(a0[5]), "+v"(a0[6]), "+v"(a0[7]), "+v"(a0[8]), "+v"(a1[0]), "+v"(a1[1]), "+v"(a1[2]), "+v"(a1[3]), "+v"(a1[4]), "+v"(a1[5]), "+v"(a1[6]), "+v"(a1[7]), "+v"(a1[8]) :: "memory"); } scp += 16; } while (0)
        ADA_LD(wa0, wa1);
#pragma unroll 1
        for (int c = 0; c < 16; c += 2) {
            ADA_LD(wb0, wb1);
            __builtin_amdgcn_sched_barrier(0);
            ADA_FMA(wa0, wa1);
            if (c + 2 < 16) ADA_LD(wa0, wa1);
            __builtin_amdgcn_sched_barrier(0);
            ADA_FMA(wb0, wb1);
        }
#undef ADA_LD
#undef ADA_FMA
#pragma unroll
        for (int r = 0; r < 9; ++r) { red[(F.wave * 9 + r) * 128 + F.lane] = a0[r]; red[(F.wave * 9 + r) * 128 + 64 + F.lane] = a1[r]; }
        __syncthreads();
        for (int t = F.tid; t < 1152; t += 512) { const int r = t >> 7, c = t & 127; float s = 0.f;
#pragma unroll
            for (int wv = 0; wv < 8; ++wv) s += red[(wv * 9 + r) * 128 + c];
            ((float*)(F.ws + WS_MOD))[(size_t)(l * 9 + r) * 6144 + n0 + c] = s + bada_[l * 6144 + n0 + c]; }
        __syncthreads();
    } else if (F.G != 256 && blockIdx.x < 192) {
#else
    if (blockIdx.x < 192) {
#endif
        const int l = blockIdx.x / 96, n0 = (blockIdx.x % 96) * 64;
        LAS float* sc = (LAS float*)F.lds;
        LAS float* red = (LAS float*)(F.lds + 9 * 2048 * 4);
        const float* cin_ = argp(I_C); const float* ccx_ = argp(I_CCTX); const float* bada_ = argp(I_BADA);
        {
            float cv[36];
#pragma unroll
            for (int j = 0; j < 36; ++j) { const int i = F.tid + 512 * j, r = i >> 11, k = i & 2047; cv[j] = (r < 8) ? cin_[r * 2048 + k] : ccx_[k]; }
#pragma unroll
            for (int j = 0; j < 36; ++j) sc[F.tid + 512 * j] = siluf_(cv[j]);
        }
        __syncthreads();
#if ADA_X4
        const int cg = F.lane & 15, rg = F.lane >> 4, kb = F.wave * 256;
        const char* wbase = (const char*)(argp(I_WADA) + (size_t)l * 2048 * 6144 + n0);
        f32x4 acc[9];
#pragma unroll
        for (int r = 0; r < 9; ++r) acc[r] = (f32x4){0.f, 0.f, 0.f, 0.f};
        f32x4 wa[8], wb[8];
        unsigned voff = (unsigned)((kb + rg) * 24576 + cg * 16);
        const LAS float* scp = sc + kb + rg;
#define ADA_LD(W_) do { _Pragma("unroll") for (int i = 0; i < 8; ++i) W_[i] = *(const f32x4*)(wbase + (voff + (unsigned)(i * 4 * 24576))); voff += 32u * 24576u; } while (0)
#define ADA_FMA(W_) do { _Pragma("unroll") for (int i = 0; i < 8; ++i) { _Pragma("unroll") for (int r = 0; r < 9; ++r) { const float s_ = scp[r * 2048 + 4 * i]; acc[r] += s_ * W_[i]; } \
            asm volatile("" : "+v"(acc[0]), "+v"(acc[1]), "+v"(acc[2]), "+v"(acc[3]), "+v"(acc[4]) :: "memory"); asm volatile("" : "+v"(acc[5]), "+v"(acc[6]), "+v"(acc[7]), "+v"(acc[8]) :: "memory"); } scp += 32; } while (0)
        ADA_LD(wa);
#pragma unroll 1
        for (int c = 0; c < 8; c += 2) {
            ADA_LD(wb);
            __builtin_amdgcn_sched_barrier(0);
            ADA_FMA(wa);
            if (c + 2 < 8) ADA_LD(wa);
            __builtin_amdgcn_sched_barrier(0);
            ADA_FMA(wb);
        }
#undef ADA_LD
#undef ADA_FMA
#pragma unroll
        for (int r = 0; r < 9; ++r) {
#pragma unroll
            for (int e = 0; e < 4; ++e) { float x_ = acc[r][e]; x_ += __shfl_xor(x_, 16); x_ += __shfl_xor(x_, 32); acc[r][e] = x_; }
            if (rg == 0) *(LAS f32x4*)(red + (F.wave * 9 + r) * 64 + 4 * cg) = acc[r]; }
#else
        const char* wbase = (const char*)(argp(I_WADA) + (size_t)l * 2048 * 6144 + n0);
        float acc[9];
#pragma unroll
        for (int r = 0; r < 9; ++r) acc[r] = 0.f;
        const int kb = F.wave * 256;
        float wa[ADA_CH], wb[ADA_CH];
        unsigned voff = (unsigned)(F.lane * 4 + kb * 24576);
        const LAS float* scp = sc + kb;
#define ADA_LD(W_) do { _Pragma("unroll") for (int i = 0; i < ADA_CH; ++i) W_[i] = *(const float*)(wbase + (voff + (unsigned)(i * 24576))); voff += (unsigned)ADA_CH * 24576u; } while (0)
#define ADA_FMA(W_) do { _Pragma("unroll") for (int q = 0; q < ADA_CH / 4; ++q) { _Pragma("unroll") for (int r = 0; r < 9; ++r) { const f32x4 s_ = *(const LAS f32x4*)(scp + r * 2048 + 4 * q); \
            acc[r] += s_[0] * W_[4 * q] + s_[1] * W_[4 * q + 1] + s_[2] * W_[4 * q + 2] + s_[3] * W_[4 * q + 3]; } \
            asm volatile("" : "+v"(acc[0]), "+v"(acc[1]), "+v"(acc[2]), "+v"(acc[3]), "+v"(acc[4]), "+v"(acc[5]), "+v"(acc[6]), "+v"(acc[7]), "+v"(acc[8]) :: "memory"); } scp += ADA_CH; } while (0)
        ADA_LD(wa);
#pragma unroll 1
        for (int c = 0; c < 256 / ADA_CH; c += 2) {
            ADA_LD(wb);
            __builtin_amdgcn_sched_barrier(0);
            ADA_FMA(wa);
            if (c + 2 < 256 / ADA_CH) ADA_LD(wa);
            __builtin_amdgcn_sched_barrier(0);
            ADA_FMA(wb);
        }
#undef ADA_LD
#undef ADA_FMA
#pragma unroll
        for (int r = 0; r < 9; ++r) red[(F.wave * 9 + r) * 64 + F.lane] = acc[r];
#endif
        __syncthreads();
        for (int t = F.tid; t < 576; t += 512) { const int r = t >> 6, c = t & 63; float s = 0.f;
#pragma unroll
            for (int wv = 0; wv < 8; ++wv) s += red[(wv * 9 + r) * 64 + c];
            ((float*)(F.ws + WS_MOD))[(size_t)(l * 9 + r) * 6144 + n0 + c] = s + bada_[l * 6144 + n0 + c]; }
        __syncthreads();
    }
    P0_OFF(12);
    if (blockIdx.x == F.G - 1) {
        const float* lbp_ = argp(I_LB);
        for (int cc = F.tid; cc < 1024; cc += 512) { const float l0 = lbp_[cc], l1 = lbp_[1024 + cc], l2 = lbp_[2048 + cc]; const float mx = fmaxf(l0, fmaxf(l1, l2));
            const float e0 = __expf(l0 - mx), e1 = __expf(l1 - mx), e2 = __expf(l2 - mx); ((float*)(F.ws + WS_LBT))[cc] = e0 / (e0 + e1 + e2); }
    }
    if (blockIdx.x == F.G - 2) {
        for (int t = F.tid; t < 2048; t += 512) { const int pos = t >> 5, i = t & 31; float sn, cs; sincos_((float)pos * exp2f(-(float)i * (13.287712379549449f / 32.f)), sn, cs);
            ((float*)(F.ws + WS_ROPE))[2 * t] = cs; ((float*)(F.ws + WS_ROPE))[2 * t + 1] = sn; }
    }

#if !P0_TFIRST
    P0_ON(13);
    { constexpr int NIT = P0_I_E + P0_I_S + P0_I_O + P0_I_S;
      if (P0_NO > 0 && F.G == 256) { constexpr int n_o = 64 * NWAVES * P0_NO;
          if (blockIdx.x >= 192) p0_transposes(F, 0, n_o, ((int)blockIdx.x - 192) * NWAVES + F.wave, 64 * NWAVES);
          else p0_transposes(F, n_o, NIT, (int)blockIdx.x * NWAVES + F.wave, 192 * NWAVES); }
      else if (ADA_W128 && F.G == 256) { if (blockIdx.x >= 96) p0_transposes(F, 0, L1_LATE ? L1_SPLIT : NIT, ((int)blockIdx.x - 96) * NWAVES + F.wave, 160 * NWAVES); }
      else p0_transposes(F, 0, (L1_LATE && F.G == 256) ? L1_SPLIT : NIT, blockIdx.x * NWAVES + F.wave, F.G * NWAVES); }
    P0_OFF(13);
#endif
#if PROBE_PH_MASK
    if (blockIdx.x == 0 && F.wave == 0 && (PROBE_PH_MASK >> 12)) { const unsigned long long t0_ = __builtin_amdgcn_s_memtime(); while (__builtin_amdgcn_s_memtime() - t0_ < 4 * p0_acc) __builtin_amdgcn_s_sleep(8); }
#endif
}

#define MCOL(j) ((F.lane + 64 * ((j) >> 1)) * 8 + ((j) & 1) * 4)
__device__ __forceinline__ void modulate_phase(Frame& F, int l, const float* xsrc, const float* csrc) {
    const int gw = blockIdx.x * NWAVES + F.wave, NGW = F.G * NWAVES;
    const float* gain = argp(I_NG) + l * 2048;
    bf16* H = (bf16*)(F.ws + WS_H);
#if MOD_CONTIG
    if (NGW * 9 == MROWS) {
#define MODC_SRC(m_) ({ const int mm_ = (m_); const int b_ = mm_ / LTOK, t_ = mm_ - b_ * LTOK; (t_ < NCTX) ? csrc + ((size_t)b_ * NCTX + t_) * DM : xsrc + ((size_t)b_ * SEQ + (t_ - NCTX)) * DM; })
        const int m0 = gw * 9;
        f32x4 v[8], vn[8], c1[8], sh[8];
        { const float* src = MODC_SRC(m0); const float* src1 = MODC_SRC(m0 + 1);
#pragma unroll
          for (int j = 0; j < 8; ++j) v[j] = *(const f32x4*)(src + MCOL(j));
#pragma unroll
          for (int j = 0; j < 8; ++j) vn[j] = *(const f32x4*)(src1 + MCOL(j)); }
        int tab = -1;
#pragma unroll 1
        for (int i = 0; i < 9; ++i) { const int m = m0 + i;
            const int b = m / LTOK, t = m - b * LTOK, tb = (t < NCTX) ? 8 : b;
            f32x4 vnn[8];
            { const float* srcn = MODC_SRC((i + 2 < 9) ? m + 2 : m);
#pragma unroll
              for (int j = 0; j < 8; ++j) vnn[j] = *(const f32x4*)(srcn + MCOL(j)); }
            if (tb != tab) { tab = tb; const float* mod = (const float*)(F.ws + WS_MOD) + (size_t)(l * 9 + tb) * 6144;
#pragma unroll
                for (int j = 0; j < 8; ++j) { const int col = MCOL(j); sh[j] = *(const f32x4*)(mod + col); c1[j] = *(const f32x4*)(gain + col) * (*(const f32x4*)(mod + 2048 + col) + 1.f); } }
            float ss = 0.f;
#pragma unroll
            for (int j = 0; j < 8; ++j) ss += (v[j].x * v[j].x + v[j].y * v[j].y) + (v[j].z * v[j].z + v[j].w * v[j].w);
            const float rstd = rsqrtf(wave_sum(ss) * (1.f / DM) + EPS);
#pragma unroll
            for (int jj = 0; jj < 4; ++jj) { const int col = MCOL(2 * jj);
                const f32x4 y0 = (v[2 * jj] * rstd) * c1[2 * jj] + sh[2 * jj], y1 = (v[2 * jj + 1] * rstd) * c1[2 * jj + 1] + sh[2 * jj + 1];
                v4u o; o.x = pg8::cvt_pk_bf16(y0.x, y0.y); o.y = pg8::cvt_pk_bf16(y0.z, y0.w); o.z = pg8::cvt_pk_bf16(y1.x, y1.y); o.w = pg8::cvt_pk_bf16(y1.z, y1.w);
                *(v4u*)(H + (size_t)m * DM + col) = o; }
#pragma unroll
            for (int j = 0; j < 8; ++j) { v[j] = vn[j]; vn[j] = vnn[j]; }
        }
#undef MODC_SRC
        return;
    }
#endif
    f32x4 v[8], vn[8];
#define MOD_SRC(m_) ({ const int mm_ = ((m_) < MROWS) ? (m_) : gw; const int b_ = mm_ / LTOK, t_ = mm_ - b_ * LTOK; \
        (t_ < NCTX) ? csrc + ((size_t)b_ * NCTX + t_) * DM : xsrc + ((size_t)b_ * SEQ + (t_ - NCTX)) * DM; })
    { const float* src = MOD_SRC(gw); const float* src1 = MOD_SRC(gw + NGW);
#pragma unroll
      for (int j = 0; j < 8; ++j) v[j] = NT_LD((const f32x4*)(src + MCOL(j)));
#pragma unroll
      for (int j = 0; j < 8; ++j) vn[j] = NT_LD((const f32x4*)(src1 + MCOL(j))); }
    f32x4 gv[8];
#pragma unroll
    for (int j = 0; j < 8; ++j) gv[j] = *(const f32x4*)(gain + MCOL(j));
    for (int m = gw; m < MROWS; m += NGW) {
        const int b = m / LTOK, t = m - b * LTOK;
        const float* mod = (const float*)(F.ws + WS_MOD) + (size_t)(l * 9 + ((t < NCTX) ? 8 : b)) * 6144;
        f32x4 vnn[8], sh[8], sl[8];
        { const float* srcn = MOD_SRC(m + MOD_DEPTH * NGW);
#pragma unroll
          for (int j = 0; j < 8; ++j) vnn[j] = NT_LD((const f32x4*)(srcn + MCOL(j))); }
#pragma unroll
        for (int j = 0; j < 8; ++j) { const int col = MCOL(j); sh[j] = *(const f32x4*)(mod + col); sl[j] = *(const f32x4*)(mod + 2048 + col); }
        float ss = 0.f;
#pragma unroll
        for (int j = 0; j < 8; ++j) ss += (v[j].x * v[j].x + v[j].y * v[j].y) + (v[j].z * v[j].z + v[j].w * v[j].w);
        const float rstd = rsqrtf(wave_sum(ss) * (1.f / DM) + EPS);
#pragma unroll
        for (int jj = 0; jj < 4; ++jj) { const int col = MCOL(2 * jj);
            const f32x4 y0 = (v[2 * jj] * rstd) * gv[2 * jj] * (sl[2 * jj] + 1.f) + sh[2 * jj], y1 = (v[2 * jj + 1] * rstd) * gv[2 * jj + 1] * (sl[2 * jj + 1] + 1.f) + sh[2 * jj + 1];
            v4u o; o.x = pg8::cvt_pk_bf16(y0.x, y0.y); o.y = pg8::cvt_pk_bf16(y0.z, y0.w); o.z = pg8::cvt_pk_bf16(y1.x, y1.y); o.w = pg8::cvt_pk_bf16(y1.z, y1.w);
            *(v4u*)(H + (size_t)m * DM + col) = o; }
#pragma unroll
        for (int j = 0; j < 8; ++j) { if (MOD_DEPTH == 2) { v[j] = vn[j]; vn[j] = vnn[j]; } else v[j] = vnn[j]; }
    }
#undef MOD_SRC
}

__device__ __forceinline__ void modulate_phase_b(Frame& F, int l, int m_lo, int m_hi, int gw, int NGW) {
    const float* gain = argp(I_NG) + l * 2048;
    bf16* H = (bf16*)(F.ws + WS_H);
    const bf16* xa = (const bf16*)(F.ws + WS_X1A); const bf16* xb = (const bf16*)(F.ws + WS_X1B); const bf16* cb = (const bf16*)(F.ws + WS_C1B);
#define MODB_SRC(m_) ({ const int b_ = (m_) / LTOK, t_ = (m_) - b_ * LTOK; const int r_ = b_ * SEQ + (t_ - NCTX); \
        (t_ < NCTX) ? cb + ((size_t)b_ * NCTX + t_) * DM : (r_ < 8192 ? xa + (size_t)r_ * DM : xb + (size_t)(r_ - 8192) * DM); })
    v2u v[8], vn[8];
    { const bf16* src = MODB_SRC((m_lo + gw < m_hi) ? m_lo + gw : m_lo); const bf16* src1 = MODB_SRC((m_lo + gw + NGW < m_hi) ? m_lo + gw + NGW : m_lo);
#pragma unroll
      for (int jj = 0; jj < 4; ++jj) { const v4u t_ = NT_LD((const v4u*)(src + MCOL(2 * jj))); v[2 * jj] = (v2u){t_.x, t_.y}; v[2 * jj + 1] = (v2u){t_.z, t_.w}; }
#pragma unroll
      for (int jj = 0; jj < 4; ++jj) { const v4u t_ = NT_LD((const v4u*)(src1 + MCOL(2 * jj))); vn[2 * jj] = (v2u){t_.x, t_.y}; vn[2 * jj + 1] = (v2u){t_.z, t_.w}; } }
    f32x4 gv[8];
#pragma unroll
    for (int j = 0; j < 8; ++j) gv[j] = *(const f32x4*)(gain + MCOL(j));
    for (int m = m_lo + gw; m < m_hi; m += NGW) {
        const int b = m / LTOK, t = m - b * LTOK;
        const float* mod = (const float*)(F.ws + WS_MOD) + (size_t)(l * 9 + ((t < NCTX) ? 8 : b)) * 6144;
        v2u vnn[8]; f32x4 sh[8], sl[8];
        { const int mn = (m + 2 * NGW < m_hi) ? m + 2 * NGW : m; const bf16* srcn = MODB_SRC(mn);
#pragma unroll
          for (int jj = 0; jj < 4; ++jj) { const v4u t_ = NT_LD((const v4u*)(srcn + MCOL(2 * jj))); vnn[2 * jj] = (v2u){t_.x, t_.y}; vnn[2 * jj + 1] = (v2u){t_.z, t_.w}; } }
#pragma unroll
        for (int j = 0; j < 8; ++j) { const int col = MCOL(j); sh[j] = *(const f32x4*)(mod + col); sl[j] = *(const f32x4*)(mod + 2048 + col); }
        f32x4 x[8]; float ss = 0.f;
#pragma unroll
        for (int j = 0; j < 8; ++j) { x[j] = (f32x4){bflo(v[j].x), bfhi(v[j].x), bflo(v[j].y), bfhi(v[j].y)}; ss += (x[j].x * x[j].x + x[j].y * x[j].y) + (x[j].z * x[j].z + x[j].w * x[j].w); }
        const float rstd = rsqrtf(wave_sum(ss) * (1.f / DM) + EPS);
#pragma unroll
        for (int jj = 0; jj < 4; ++jj) { const int col = MCOL(2 * jj);
            const f32x4 y0 = (x[2 * jj] * rstd) * gv[2 * jj] * (sl[2 * jj] + 1.f) + sh[2 * jj], y1 = (x[2 * jj + 1] * rstd) * gv[2 * jj + 1] * (sl[2 * jj + 1] + 1.f) + sh[2 * jj + 1];
            v4u o; o.x = pg8::cvt_pk_bf16(y0.x, y0.y); o.y = pg8::cvt_pk_bf16(y0.z, y0.w); o.z = pg8::cvt_pk_bf16(y1.x, y1.y); o.w = pg8::cvt_pk_bf16(y1.z, y1.w);
            *(v4u*)(H + (size_t)m * DM + col) = o; }
#pragma unroll
        for (int j = 0; j < 8; ++j) { v[j] = vn[j]; vn[j] = vnn[j]; }
    }
#undef MODB_SRC
}

#undef MCOL
__device__ __forceinline__ void zgemm_phase(Frame& F) {
    const bf16* H = (const bf16*)(F.ws + WS_H); const bf16* WZ = (const bf16*)(F.ws + WS_WZ); unsigned short* LAo = (unsigned short*)(F.ws + WS_LA);
    const int fr = F.lane & 15, fq = F.lane >> 4, wave = F.wave, dir = wave >> 2, rgrp = wave & 3;
    LAS float* red = (LAS float*)F.lds;
    LAS float* zf = (LAS float*)(F.lds + 16384);
    LAS float* WL = (LAS float*)(F.lds + 32768);
    { const float* wa2 = argp(I_WA2); f32x4 t[8];
#pragma unroll
      for (int i = 0; i < 8; ++i) t[i] = *(const f32x4*)(wa2 + (F.tid + 512 * i) * 4);
#pragma unroll
      for (int i = 0; i < 8; ++i) *(LAS f32x4*)(WL + (F.tid + 512 * i) * 4) = t[i]; }
    const float* bp = argp(I_BA2) + dir * 512 + F.lane * 8;
    const f32x4 b0 = *(const f32x4*)bp, b1 = *(const f32x4*)(bp + 4);
    bf16x8 bv0[8], bv1[8], av[8];
    { const bf16* b0p = WZ + (size_t)fr * DM + wave * 256 + 8 * fq; const bf16* b1p = WZ + (size_t)(16 + fr) * DM + wave * 256 + 8 * fq;
#pragma unroll
      for (int k = 0; k < 8; ++k) { bv0[k] = *(const bf16x8*)(b0p + k * 32); bv1[k] = *(const bf16x8*)(b1p + k * 32); } }
    { const bf16* ap = H + (size_t)(blockIdx.x * 16 + fr) * DM + wave * 256 + 8 * fq;
#pragma unroll
      for (int k = 0; k < 8; ++k) av[k] = *(const bf16x8*)(ap + k * 32); }
    asm volatile("s_waitcnt lgkmcnt(0)\n\ts_barrier" ::: "memory");
    for (int u = blockIdx.x; u < MROWS / 16; u += F.G) {
        bf16x8 avn[8];
        { const int un = (u + F.G < MROWS / 16) ? u + F.G : u; const bf16* ap = H + (size_t)(un * 16 + fr) * DM + wave * 256 + 8 * fq;
#pragma unroll
          for (int k = 0; k < 8; ++k) avn[k] = *(const bf16x8*)(ap + k * 32); }
        f32x4 a0 = {0.f, 0.f, 0.f, 0.f}, a1 = {0.f, 0.f, 0.f, 0.f};
#pragma unroll
        for (int k = 0; k < 8; ++k) { a0 = __builtin_amdgcn_mfma_f32_16x16x32_bf16(av[k], bv0[k], a0, 0, 0, 0); a1 = __builtin_amdgcn_mfma_f32_16x16x32_bf16(av[k], bv1[k], a1, 0, 0, 0); }
#pragma unroll
        for (int i = 0; i < 4; ++i) { red[wave * 512 + (fq * 4 + i) * 32 + fr] = a0[i]; red[wave * 512 + (fq * 4 + i) * 32 + 16 + fr] = a1[i]; }
        asm volatile("s_waitcnt lgkmcnt(0)\n\ts_barrier" ::: "memory");
        { float zs = 0.f;
#pragma unroll
          for (int w8 = 0; w8 < 8; ++w8) zs += red[w8 * 512 + F.tid];
          zf[F.tid] = zs; }
        asm volatile("s_waitcnt lgkmcnt(0)\n\ts_barrier" ::: "memory");
        f32x4 x0[4], x1[4];
#pragma unroll
        for (int rr = 0; rr < 4; ++rr) { x0[rr] = b0; x1[rr] = b1; }
#pragma unroll
        for (int r4 = 0; r4 < 4; ++r4) {
            f32x4 w0[4], w1[4];
#pragma unroll
            for (int e = 0; e < 4; ++e) { const LAS float* wl = WL + (dir * 16 + r4 * 4 + e) * 512 + F.lane * 8; w0[e] = *(const LAS f32x4*)wl; w1[e] = *(const LAS f32x4*)(wl + 4); }
#pragma unroll
            for (int rr = 0; rr < 4; ++rr) { const f32x4 zz = *(const LAS f32x4*)(zf + (rgrp * 4 + rr) * 32 + dir * 16 + r4 * 4);
#pragma unroll
                for (int e = 0; e < 4; ++e) { x0[rr] += zz[e] * w0[e]; x1[rr] += zz[e] * w1[e]; } }
        }
#pragma unroll
        for (int rr = 0; rr < 4; ++rr) { const int row = rgrp * 4 + rr;
            typedef _Float16 h8 __attribute__((ext_vector_type(8)));
            h8 hv;
#pragma unroll
            for (int e = 0; e < 4; ++e) {
                const float y0 = x0[rr][e] * 1.4426950408889634f, y1 = x1[rr][e] * 1.4426950408889634f;
                hv[e] = (_Float16)((fminf(y0, 0.f) - __builtin_amdgcn_logf(1.f + __builtin_amdgcn_exp2f(-fabsf(y0)))) * (1.f / 16.f)); hv[4 + e] = (_Float16)((fminf(y1, 0.f) - __builtin_amdgcn_logf(1.f + __builtin_amdgcn_exp2f(-fabsf(y1)))) * (1.f / 16.f)); }
            *(h8*)(LAo + (size_t)(u * 16 + row) * 1024 + dir * 512 + F.lane * 8) = hv;
        }
#pragma unroll
        for (int k = 0; k < 8; ++k) av[k] = avn[k];
    }
    asm volatile("s_waitcnt vmcnt(0)" ::: "memory");
}

#ifndef SC2_ST32
#define SC2_ST32 0
#endif
#ifndef SC2_TOUCH_POS
#define SC2_TOUCH_POS 0
#endif
#ifndef SC2_TOUCH64
#define SC2_TOUCH64 0
#endif
#ifndef SC2_TOUCH_D
#define SC2_TOUCH_D 3
#endif
#ifndef SC_PRIO
#define SC_PRIO 0
#endif
#ifndef PROBE_SC
#define PROBE_SC 0
#endif
#ifndef PROBE_SC_BLOCK
#define PROBE_SC_BLOCK 0
#endif
#ifndef PROBE_SC_WAVE
#define PROBE_SC_WAVE 0
#endif
#if PROBE_SC
#define SC_ON(id) do { if (PROBE_SC == (id)) sc_t0 = __builtin_amdgcn_s_memtime(); } while (0)
#define SC_OFF(id) do { if (PROBE_SC == (id)) sc_acc += __builtin_amdgcn_s_memtime() - sc_t0; } while (0)
#else
#define SC_ON(id) do { } while (0)
#define SC_OFF(id) do { } while (0)
#endif
namespace sc2 {
constexpr int QD_OFF = 0, KI_OFF = 8704, KT_OFF = 17408, VT_OFF = 25600, DEC_OFF = 33792, BUF_BYTES = 34816, W_OFF = 2 * BUF_BYTES, C_OFF = W_OFF + 8192, J_OFF = C_OFF + 512, SC2_TOUCH = SC2_TOUCH_D;
constexpr int ROWB = 272;
typedef float f32x16 __attribute__((ext_vector_type(16)));
typedef short s16x4 __attribute__((ext_vector_type(4)));
__device__ __forceinline__ int crow(int r, int hi) { return (r & 3) + 8 * (r >> 2) + 4 * hi; }
template <int OFF> __device__ __forceinline__ s16x4 tr_read(unsigned a) { s16x4 r; asm volatile("ds_read_b64_tr_b16 %0, %1 offset:%2" : "=&v"(r) : "v"(a), "i"(OFF) : "memory"); return r; }
struct Raw { v4u q, k, v, la; };
}
__device__ __forceinline__ void scan_phase_v2(Frame& F, bf16* OF, bf16* OB) {
    using namespace sc2;
#if PROBE_SC
    unsigned long long sc_acc = 0, sc_t0 = 0;
#endif
    const bf16* P = (const bf16*)(F.ws + WS_P); const unsigned short* LA = (const unsigned short*)(F.ws + WS_LA);
    const int lane = F.lane, wave = F.wave;
    const int r = lane & 31, h = lane >> 5;
    for (int u = blockIdx.x; u < 256; u += F.G) {
        const bool isA = u < 128; const int uu = isA ? u : u - 128;
        int b, hd, dir, vh;
        if (isA) { b = uu >> 4; hd = (uu >> 1) & 7; dir = uu & 1; vh = 0; } else { b = uu >> 4; hd = (uu >> 2) & 3; dir = (uu >> 1) & 1; vh = uu & 1; }
        const int qcol = isA ? EC_AQ + hd * 128 : EC_BQ + hd * 128;
        const int kcol = isA ? (dir ? EC_AFB : EC_AFF) + hd * 128 : EC_BK + hd * 128;
        const int vcol = isA ? EC_AI + hd * 128 : EC_BV + hd * 256 + vh * 128;
        const int ocol = isA ? hd * 128 : 1024 + hd * 256 + vh * 128;
        bf16* OUT = dir ? OB : OF;
        const size_t rowb = (size_t)b * LTOK;
        SC_ON(5);
        __syncthreads();
#define SC2_TOK(ch, tb, ts) do { const int i0_ = (ch) * 32; if (!dir) { tb = i0_; ts = 1; } else { tb = (i0_ < NCTX) ? (NCTX - 1 - i0_) : (LTOK - 1 - (i0_ - NCTX)); ts = -1; } } while (0)
        if (wave >= 4) {
            if (SC_PRIO == 1) __builtin_amdgcn_s_setprio(1);
            const int pw = wave - 4;
            Raw cur[2], nxt[2];
#define SC2_LOAD(dst, ch) do { int tb_, ts_; SC2_TOK(ch, tb_, ts_); const size_t row_ = rowb + tb_ + ts_ * r; \
                _Pragma("unroll") for (int ps = 0; ps < 2; ++ps) { const int d0 = (pw * 4 + ps * 2 + h) * 8; \
                    dst[ps].q = *(const v4u*)(P + row_ * LDP + qcol + d0); dst[ps].k = *(const v4u*)(P + row_ * LDP + kcol + d0); dst[ps].v = *(const v4u*)(P + row_ * LDP + vcol + d0); } \
                if (!isA) { _Pragma("unroll") for (int ps = 0; ps < 2; ++ps) dst[ps].la = *(const v4u*)(LA + row_ * 1024 + dir * 512 + hd * 128 + (pw * 4 + ps * 2 + h) * 8); } } while (0)
#define SC2_FILL(src, bi) do { LAS unsigned char* bb_ = F.lds + (bi) * BUF_BYTES; \
                _Pragma("unroll") for (int ps = 0; ps < 2; ++ps) { const int dg = pw * 4 + ps * 2 + h, d0 = dg * 8; \
                    float q8[8], k8[8], la[8]; unpack8(src[ps].q, q8); unpack8(src[ps].k, k8); \
                    if (isA) { typedef _Float16 h8a_ __attribute__((ext_vector_type(8))); const h8a_ lh_ = __builtin_bit_cast(h8a_, src[ps].k);     \
                        _Pragma("unroll") for (int e = 0; e < 8; ++e) { la[e] = (float)lh_[e]; k8[e] = 1.f - __builtin_amdgcn_exp2f(la[e]); } } \
                    else { typedef _Float16 h8_ __attribute__((ext_vector_type(8))); const h8_ lh_ = __builtin_bit_cast(h8_, src[ps].la); \
                        _Pragma("unroll") for (int e = 0; e < 8; ++e) la[e] = (float)lh_[e]; } \
                      \
                    _Pragma("unroll") for (int e = 0; e < 8; ++e) { float x_ = la[e]; \
                        x_ += __int_as_float(__builtin_amdgcn_update_dpp(0, __float_as_int(x_), 0x111, 0xf, 0xf, true)); x_ += __int_as_float(__builtin_amdgcn_update_dpp(0, __float_as_int(x_), 0x112, 0xf, 0xf, true)); \
                        x_ += __int_as_float(__builtin_amdgcn_update_dpp(0, __float_as_int(x_), 0x114, 0xf, 0xf, true)); x_ += __int_as_float(__builtin_amdgcn_update_dpp(0, __float_as_int(x_), 0x118, 0xf, 0xf, true)); \
                        x_ += __int_as_float(__builtin_amdgcn_update_dpp(0, __float_as_int(x_), 0x142, 0xa, 0xf, true)); la[e] = x_; } \
                    float qd[8], ki[8], kt[8]; \
                    float ebv[8]; \
                    _Pragma("unroll") for (int e = 0; e < 8; ++e) { const float eb = __builtin_amdgcn_exp2f(la[e]); const float ebl = __shfl(eb, 31, 32); const float ei = __builtin_amdgcn_rcpf(eb); qd[e] = q8[e] * eb; ki[e] = k8[e] * ei; kt[e] = ki[e] * ebl; ebv[e] = eb; } \
                    if (r == 31) { *(LAS f32x4*)(bb_ + DEC_OFF + d0 * 4) = (f32x4){ebv[0], ebv[1], ebv[2], ebv[3]}; *(LAS f32x4*)(bb_ + DEC_OFF + d0 * 4 + 16) = (f32x4){ebv[4], ebv[5], ebv[6], ebv[7]}; } \
                    *(LAS v4u*)(bb_ + QD_OFF + r * ROWB + d0 * 2) = pack8c(qd); *(LAS v4u*)(bb_ + KI_OFF + r * ROWB + d0 * 2) = pack8c(ki); \
                    *(LAS v4u*)(bb_ + KT_OFF + (dg >> 2) * 2048 + r * 64 + (dg & 3) * 16) = pack8c(kt); \
                    *(LAS v4u*)(bb_ + VT_OFF + (dg >> 2) * 2048 + r * 64 + (dg & 3) * 16) = src[ps].v; __builtin_amdgcn_sched_barrier(0); } } while (0)
            SC2_LOAD(cur, 0);
            SC2_LOAD(nxt, 1);
            SC2_FILL(cur, 0);
            __syncthreads();
            for (int ch = 0; ch < LTOK / 32; ch += 2) {
                if (ch + 2 < LTOK / 32) SC2_LOAD(cur, ch + 2);
                SC_ON(2); SC2_FILL(nxt, (ch + 1) & 1); SC_OFF(2);
                SC_ON(1); asm volatile("s_waitcnt lgkmcnt(0)\n\ts_barrier" ::: "memory"); SC_OFF(1);
                if (ch + 3 < LTOK / 32) SC2_LOAD(nxt, ch + 3);
                SC_ON(2); if (ch + 2 < LTOK / 32) SC2_FILL(cur, ch & 1); SC_OFF(2);
                SC_ON(1); asm volatile("s_waitcnt lgkmcnt(0)\n\ts_barrier" ::: "memory"); SC_OFF(1);
            }
#undef SC2_LOAD
#undef SC2_FILL
        } else {
            if (SC_PRIO == 2) __builtin_amdgcn_s_setprio(1);
            const int cw = wave;
            f32x16 S[4];
#pragma unroll
            for (int dt = 0; dt < 4; ++dt) S[dt] = (f32x16){};
            const int q4 = (lane & 15) >> 2, p4 = lane & 3, blk = (lane >> 4) & 1;
            const unsigned trl = (unsigned)(q4 * 64 + (16 * blk + 4 * p4) * 2);
            __syncthreads();
#define SC2_TOUCH_ISSUE() do { \
                if (ch + SC2_TOUCH < LTOK / 32) { int tb2, ts2; SC2_TOK(ch + SC2_TOUCH, tb2, ts2); \
                    const int ti = cw * 64 + lane, trw = ti & 31, tw = ti >> 5;             \
                    const size_t trow = rowb + tb2 + ts2 * trw; \
                    const char* tp = (tw < 6) ? (const char*)(P + trow * LDP + (tw < 2 ? qcol : tw < 4 ? kcol : vcol)) + (tw & 1) * 128 : (const char*)(LA + trow * 1024 + dir * 512 + hd * 128) + (tw & 1) * 128; \
                    if (tw < 6 || !isA) { __builtin_amdgcn_global_load_lds((const unsigned*)tp, (LAS unsigned*)(F.lds + J_OFF + cw * 256), 4, 0, 0); \
                        if (SC2_TOUCH64) __builtin_amdgcn_global_load_lds((const unsigned*)(tp + 64), (LAS unsigned*)(F.lds + J_OFF + cw * 256), 4, 0, 0); } }     } while (0)
            for (int ch = 0; ch < LTOK / 32; ++ch) {
                if (SC2_TOUCH_POS == 1) { SC2_TOUCH_ISSUE(); }
                LAS unsigned char* bb = F.lds + (ch & 1) * BUF_BYTES;
                const unsigned bba = (unsigned)(size_t)bb;
                f32x16 X = (f32x16){};
#pragma unroll
                for (int kk = 0; kk < 8; ++kk) {
                    const bf16x8 a = *(const LAS bf16x8*)(bb + KI_OFF + r * ROWB + (16 * kk + 8 * h) * 2), bq = *(const LAS bf16x8*)(bb + QD_OFF + r * ROWB + (16 * kk + 8 * h) * 2);
                    X = __builtin_amdgcn_mfma_f32_32x32x16_bf16(a, bq, X, 0, 0, 0);
                }
#pragma unroll
                for (int g = 0; g < 16; ++g) X[g] = (r >= crow(g, h)) ? X[g] : 0.f;
                v4u xa0, xa1;
                xa0.x = pg8::cvt_pk_bf16(X[0], X[1]); xa0.y = pg8::cvt_pk_bf16(X[2], X[3]); xa0.z = pg8::cvt_pk_bf16(X[4], X[5]); xa0.w = pg8::cvt_pk_bf16(X[6], X[7]);
                xa1.x = pg8::cvt_pk_bf16(X[8], X[9]); xa1.y = pg8::cvt_pk_bf16(X[10], X[11]); xa1.z = pg8::cvt_pk_bf16(X[12], X[13]); xa1.w = pg8::cvt_pk_bf16(X[14], X[15]);
                const unsigned vta = bba + VT_OFF + cw * 2048 + trl;
                s16x4 vp00 = tr_read<0>(vta + (4 * h) * 64), vp01 = tr_read<0>(vta + (8 + 4 * h) * 64), vp10 = tr_read<0>(vta + (16 + 4 * h) * 64), vp11 = tr_read<0>(vta + (24 + 4 * h) * 64);
                s16x4 vn00 = tr_read<0>(vta + (8 * h) * 64), vn01 = tr_read<0>(vta + (8 * h + 4) * 64), vn10 = tr_read<0>(vta + (16 + 8 * h) * 64), vn11 = tr_read<0>(vta + (16 + 8 * h + 4) * 64);
                asm volatile("s_waitcnt lgkmcnt(0)" ::: "memory"); __builtin_amdgcn_sched_barrier(0);
#define SC2_PK(L, H) (bf16x8){L[0], L[1], L[2], L[3], H[0], H[1], H[2], H[3]}
                f32x16 o = (f32x16){};
                o = __builtin_amdgcn_mfma_f32_32x32x16_bf16(__builtin_bit_cast(bf16x8, xa0), SC2_PK(vp00, vp01), o, 0, 0, 0);
                o = __builtin_amdgcn_mfma_f32_32x32x16_bf16(__builtin_bit_cast(bf16x8, xa1), SC2_PK(vp10, vp11), o, 0, 0, 0);
#pragma unroll
                for (int dt = 0; dt < 4; ++dt)
#pragma unroll
                    for (int ks = 0; ks < 2; ++ks) {
                        const LAS unsigned char* qp = bb + QD_OFF + r * ROWB + (32 * dt + 16 * ks + 4 * h) * 2;
                        const s16x4 a0 = *(const LAS s16x4*)qp, a1 = *(const LAS s16x4*)(qp + 16);
                        v4u sb; sb.x = pg8::cvt_pk_bf16(S[dt][8 * ks + 0], S[dt][8 * ks + 1]); sb.y = pg8::cvt_pk_bf16(S[dt][8 * ks + 2], S[dt][8 * ks + 3]);
                        sb.z = pg8::cvt_pk_bf16(S[dt][8 * ks + 4], S[dt][8 * ks + 5]); sb.w = pg8::cvt_pk_bf16(S[dt][8 * ks + 6], S[dt][8 * ks + 7]);
                        o = __builtin_amdgcn_mfma_f32_32x32x16_bf16(SC2_PK(a0, a1), __builtin_bit_cast(bf16x8, sb), o, 0, 0, 0);
                    }
#pragma unroll
                for (int dt = 0; dt < 4; ++dt) {
                    const unsigned kta = bba + KT_OFF + dt * 2048 + trl;
                    s16x4 k00 = tr_read<0>(kta + (8 * h) * 64), k01 = tr_read<0>(kta + (8 * h + 4) * 64), k10 = tr_read<0>(kta + (16 + 8 * h) * 64), k11 = tr_read<0>(kta + (16 + 8 * h + 4) * 64);
#pragma unroll
                    for (int g = 0; g < 4; ++g) { const f32x4 dc = *(const LAS f32x4*)(bb + DEC_OFF + (32 * dt + 8 * g + 4 * h) * 4);
                        S[dt][4 * g + 0] *= dc[0]; S[dt][4 * g + 1] *= dc[1]; S[dt][4 * g + 2] *= dc[2]; S[dt][4 * g + 3] *= dc[3]; }
                    asm volatile("s_waitcnt lgkmcnt(0)" ::: "memory"); __builtin_amdgcn_sched_barrier(0);
                    S[dt] = __builtin_amdgcn_mfma_f32_32x32x16_bf16(SC2_PK(k00, k01), SC2_PK(vn00, vn01), S[dt], 0, 0, 0);
                    S[dt] = __builtin_amdgcn_mfma_f32_32x32x16_bf16(SC2_PK(k10, k11), SC2_PK(vn10, vn11), S[dt], 0, 0, 0);
                }
#undef SC2_PK
                int tb, ts; SC2_TOK(ch, tb, ts);
#pragma unroll
                for (int g = 0; g < 16; g += 2) {
                    bf16* ob_ = OUT + (rowb + tb) * DM + ocol + cw * 32; const int lo_ = (ts * 4 * h) * DM + r; const unsigned pk_ = cvtpk_c(o[g], o[g + 1]);
#if SC2_ST32
                    {
                        const unsigned pn_ = (unsigned)__builtin_amdgcn_update_dpp(0, (int)pk_, 0xB1, 0xf, 0xf, true);
                        const bool odd_ = (r & 1) != 0;
                        const unsigned w_ = odd_ ? ((pn_ >> 16) | (pk_ & 0xffff0000u)) : ((pk_ & 0xffffu) | (pn_ << 16));
                        const int row_ = odd_ ? (((g + 1) & 3) + 8 * ((g + 1) >> 2)) : ((g & 3) + 8 * (g >> 2));
                        *(unsigned*)(ob_ + (lo_ - (r & 1)) + ts * (row_ * DM)) = w_; } }
#else
                    ob_[lo_ + ts * (((g & 3) + 8 * (g >> 2)) * DM)] = (bf16)(pk_ & 0xffffu);
                    ob_[lo_ + ts * ((((g + 1) & 3) + 8 * ((g + 1) >> 2)) * DM)] = (bf16)(pk_ >> 16); }
#endif
                if (SC2_TOUCH_POS == 0) { SC2_TOUCH_ISSUE(); }
                SC_ON(1); asm volatile("s_waitcnt lgkmcnt(0)\n\ts_barrier" ::: "memory"); SC_OFF(1);
            }
            asm volatile("s_waitcnt vmcnt(0)" ::: "memory");
        }
#undef SC2_TOK
#undef SC2_TOUCH_ISSUE
        if (SC_PRIO) __builtin_amdgcn_s_setprio(0);
        __syncthreads();
        SC_OFF(5);
    }
    if (L1_LATE && L1_SCAN_ITEMS > 0 && F.G == 256 && blockIdx.x < 128) {
        p0_transposes(F, L1_SPLIT, L1_SPLIT + L1_SCAN_ITEMS, (int)blockIdx.x * NWAVES + F.wave, 128 * NWAVES); }
#if PROBE_SC
    if (PROBE_SC_BLOCK == 999 && wave == PROBE_SC_WAVE && lane == 0) atomicMax((unsigned*)(F.ws + WS_CTL) + 9216, (unsigned)sc_acc);
    if ((PROBE_SC_BLOCK == 1000 || blockIdx.x == PROBE_SC_BLOCK) && wave == PROBE_SC_WAVE) { const unsigned long long t0_ = __builtin_amdgcn_s_memtime(); while (__builtin_amdgcn_s_memtime() - t0_ < sc_acc) __builtin_amdgcn_s_sleep(8); }
#endif
}

__device__ __forceinline__ void evengate_phase(Frame& F, const bf16* OF) {
    const int gw = blockIdx.x * NWAVES + F.wave, NGW = F.G * NWAVES;
    bf16* Y = (bf16*)(F.ws + WS_H); const bf16* P = (const bf16*)(F.ws + WS_P);
    const float* agp_ = argp(I_AG); const float* bgp_ = argp(I_BG);
    v4u ra[4], rb[4], rg[4];
#define EG_LD(RA, RB, RG, m_) do { const int mm_ = ((m_) < MROWS) ? (m_) : gw; _Pragma("unroll") for (int j = 0; j < 4; ++j) { const int col = j * 512 + F.lane * 8; \
        RA[j] = NT_LD((const v4u*)(OF + (size_t)mm_ * DM + col)); RB[j] = NT_LD((const v4u*)(Y + (size_t)mm_ * DM + col)); RG[j] = NT_LD((const v4u*)(P + (size_t)mm_ * LDP + EC_GATE + col)); } } while (0)
    EG_LD(ra, rb, rg, gw);
    f32x4 gnv[4][2];
#pragma unroll
    for (int j = 0; j < 4; ++j) { const int col = j * 512 + F.lane * 8; const float* gn = (j < 2) ? agp_ + (col & 127) : bgp_ + (col & 255); gnv[j][0] = *(const f32x4*)gn; gnv[j][1] = *(const f32x4*)(gn + 4); }
    for (int m = gw; m < MROWS; m += NGW) {
        v4u na[4], nb[4], ng[4];
        EG_LD(na, nb, ng, m + NGW);
#pragma unroll
        for (int j = 0; j < 4; ++j) {
            const int col = j * 512 + F.lane * 8;
            float a[8], bb[8], g[8];
            unpack8(ra[j], a); unpack8(rb[j], bb); unpack8(rg[j], g);
            float ss = 0.f;
#pragma unroll
            for (int e = 0; e < 8; ++e) { a[e] += bb[e]; ss += a[e] * a[e]; }
            ss += __shfl_xor(ss, 1); ss += __shfl_xor(ss, 2); ss += __shfl_xor(ss, 4); ss += __shfl_xor(ss, 8);
            float rstd;
            if (j < 2) { rstd = rsqrtf(ss * (1.f / 128.f) + EPS); }
            else { ss += __shfl_xor(ss, 16); rstd = rsqrtf(ss * (1.f / 256.f) + EPS); }
            float y[8];
#pragma unroll
            for (int e = 0; e < 8; ++e) y[e] = a[e] * rstd * gnv[j][e >> 2][e & 3] * siluf_(g[e]);
            *(v4u*)(Y + (size_t)m * DM + col) = pack8c(y);
            __builtin_amdgcn_sched_barrier(0);
        }
#pragma unroll
        for (int j = 0; j < 4; ++j) { ra[j] = na[j]; rb[j] = nb[j]; rg[j] = ng[j]; }
    }
#undef EG_LD
}

namespace at2 {
constexpr int STAGE = 65536, K0_OFF = 0, K1_OFF = 16384, V_OFF = 32768, XW_OFF = 131072 + 1024;
typedef float f32x16 __attribute__((ext_vector_type(16)));
typedef short s16x4 __attribute__((ext_vector_type(4)));
__device__ __forceinline__ int crow(int r, int hi) { return (r & 3) + 8 * (r >> 2) + 4 * hi; }
template <int OFF> __device__ __forceinline__ s16x4 tr_read(unsigned a) { s16x4 r; asm volatile("ds_read_b64_tr_b16 %0, %1 offset:%2" : "=&v"(r) : "v"(a), "i"(OFF) : "memory"); return r; }
constexpr int v_rd_off(int d0, int ks, int half) { return d0 * 512 + ks * 8192 + half * 4096; }
template <int D0> __device__ __forceinline__ void pv_one(f32x16& od, unsigned vb, bf16x8 pa0, bf16x8 pa1, bf16x8 pa2, bf16x8 pa3) {
    const s16x4 l0 = tr_read<v_rd_off(D0, 0, 0)>(vb), h0 = tr_read<v_rd_off(D0, 0, 1)>(vb), l1 = tr_read<v_rd_off(D0, 1, 0)>(vb), h1 = tr_read<v_rd_off(D0, 1, 1)>(vb);
    const s16x4 l2 = tr_read<v_rd_off(D0, 2, 0)>(vb), h2 = tr_read<v_rd_off(D0, 2, 1)>(vb), l3 = tr_read<v_rd_off(D0, 3, 0)>(vb), h3 = tr_read<v_rd_off(D0, 3, 1)>(vb);
    asm volatile("s_waitcnt lgkmcnt(0)" ::: "memory"); __builtin_amdgcn_sched_barrier(0);
#define AT2_PK(L, H) (bf16x8){L[0], L[1], L[2], L[3], H[0], H[1], H[2], H[3]}
    od = __builtin_amdgcn_mfma_f32_32x32x16_bf16(pa0, AT2_PK(l0, h0), od, 0, 0, 0);
    od = __builtin_amdgcn_mfma_f32_32x32x16_bf16(pa1, AT2_PK(l1, h1), od, 0, 0, 0);
    od = __builtin_amdgcn_mfma_f32_32x32x16_bf16(pa2, AT2_PK(l2, h2), od, 0, 0, 0);
    od = __builtin_amdgcn_mfma_f32_32x32x16_bf16(pa3, AT2_PK(l3, h3), od, 0, 0, 0);
#undef AT2_PK
}
}
#ifndef PROBE_SW
#define PROBE_SW 0
#endif
#ifndef PROBE_SW_WAVE
#define PROBE_SW_WAVE 0
#endif
#if PROBE_SW
#define SW_ON(id) do { if (PROBE_SW == (id)) sw_t0 = __builtin_amdgcn_s_memtime(); } while (0)
#define SW_OFF(id) do { if (PROBE_SW == (id)) sw_acc += __builtin_amdgcn_s_memtime() - sw_t0; } while (0)
#else
#define SW_ON(id) do { } while (0)
#define SW_OFF(id) do { } while (0)
#endif
__device__ __forceinline__ void attn_phase_v2(Frame& F) {
    using namespace at2;
#if PROBE_SW
    unsigned long long sw_acc = 0, sw_t0 = 0;
#endif
    const bf16* P = (const bf16*)(F.ws + WS_P); bf16* Y2 = (bf16*)(F.ws + WS_O0);
    const int lane = F.lane, wave = F.wave, r32 = lane & 31, hi = lane >> 5, mp = wave >> 2, wq = wave & 3;
    float gqm, gkm;
    { const float* qg = argp(I_QG); const float* kg = argp(I_KG); float a = fmaxf(fabsf(qg[lane]), fabsf(qg[64 + lane])), c = fmaxf(fabsf(kg[lane]), fabsf(kg[64 + lane]));
#pragma unroll
      for (int o = 1; o < 64; o <<= 1) { a = fmaxf(a, __shfl_xor(a, o)); c = fmaxf(c, __shfl_xor(c, o)); }
      gqm = a; gkm = c; }
    const float negBl = __builtin_bit_cast(float, __builtin_amdgcn_readfirstlane(__builtin_bit_cast(int, -(1.4426950408889634f * 11.313708498984761f * 1.02f) * gqm * gkm)));
    const unsigned vrd = (unsigned)(((lane & 3) << 3) | (((lane >> 2) & 3) << 6) | (((lane >> 4) & 1) << 5) | (((lane >> 5) & 1) << 8));
    const unsigned ldsb = (unsigned)(size_t)F.lds;
    LAS float* xw = (LAS float*)(F.lds + XW_OFF) + wave * 64;
    int vidx;
    { const volatile LAS unsigned* misc_ = (const volatile LAS unsigned*)(F.lds + MISC_OFF); const unsigned rk = misc_[10], xc = misc_[11];
      const unsigned* bw = (const unsigned*)(F.ws + WS_CTL) + CW_BAR;
      unsigned c = (lane < 16) ? __hip_atomic_load(bw + XB_XCNT(lane), __ATOMIC_RELAXED, __HIP_MEMORY_SCOPE_AGENT) : 0u;
      c = ((unsigned)lane < xc) ? c : 0u;
#pragma unroll
      for (int o_ = 1; o_ < 16; o_ <<= 1) c += __shfl_xor(c, o_);
      vidx = __builtin_amdgcn_readfirstlane((int)(c + rk)); if (vidx >= F.G || vidx < 0) vidx = blockIdx.x; }
#ifndef ATT_REP
#define ATT_REP 1
#endif
#ifndef ATT_TOUCH
#define ATT_TOUCH 0
#endif
#ifndef ATT_CNEG
#define ATT_CNEG 0
#endif
#ifndef ATT_SPLIT
#define ATT_SPLIT 0
#endif
#ifndef ATT_DMA2
#define ATT_DMA2 0
#endif
#ifndef ATT_PRIO
#define ATT_PRIO 3
#endif
    for (int rd_ = 0; rd_ * F.G + vidx < 1024 * ATT_REP; ++rd_) {
        const int rd = rd_ % (1024 / (F.G > 1024 ? 1024 : F.G));
        int b, h, qb;
        { const int u = rd * F.G + vidx; b = u >> 7; h = (u >> 4) & 7; qb = u & 15; }
        SW_ON(8);
        const char* Kg = (const char*)(P + (size_t)b * LTOK * LDP + OC_K + h * 256);
        const char* Vg = (const char*)(P + (size_t)b * LTOK * LDP + OC_V + h * 256);
#define AT2_DMA4(isK, t) AT2_DMA4W(isK, t, wave)
#define AT2_DMA4W(isK, t, W_) do { const bool k_ = (isK); const int stg_ = (t) & 1; const char* gb_ = (k_ ? Kg : Vg) + (size_t)(t) * 64 * LDP * 2; \
        int ln_ = lane; asm volatile("" : "+v"(ln_)); unsigned vo_; \
        { const int jk_ = (W_) * 64 + ln_, rowk_ = jk_ >> 4, cck_ = (jk_ & 15) ^ (rowk_ & 7); const unsigned ks_ = (unsigned)(rowk_ * (LDP * 2) + cck_ * 16); \
          const int jv_ = (4 * (W_)) * 64 + ln_, st_ = jv_ >> 5, krow_ = (jv_ & 31) >> 2, cch_ = jv_ & 3, kk_ = (st_ >> 3) * 8 + krow_, key_ = (kk_ & ~0xC) | ((kk_ & 4) << 1) | ((kk_ & 8) >> 1); \
          const unsigned vs_ = (unsigned)(key_ * (LDP * 2) + ((st_ & 7) * 32 + cch_ * 8) * 2); vo_ = k_ ? ks_ : vs_; } \
        _Pragma("unroll") for (int i_ = 0; i_ < 4; ++i_) { \
            const unsigned dl_ = k_ ? (unsigned)((i_ >> 1) * 32 * LDP * 2 + (i_ & 1) * 256) : (unsigned)(i_ * 128); \
            const int ld_ = stg_ * STAGE + (k_ ? ((i_ & 1) ? K1_OFF : K0_OFF) + ((W_) + 8 * (i_ >> 1)) * 1024 : V_OFF + (4 * (W_) + i_) * 1024); \
            __builtin_amdgcn_global_load_lds((const unsigned*)(gb_ + dl_ + vo_), (LAS unsigned*)(F.lds + ld_), 16, 0, 0); } } while (0)
#define AT2_WAITBAR4() asm volatile("s_waitcnt vmcnt(4) lgkmcnt(0)\n\ts_barrier" ::: "memory")
#define AT2_WAITBAR0() asm volatile("s_waitcnt vmcnt(0) lgkmcnt(0)\n\ts_barrier" ::: "memory")
#define AT2_WAITBAR8() asm volatile("s_waitcnt vmcnt(8) lgkmcnt(0)\n\ts_barrier" ::: "memory")
        AT2_DMA4(true, 0); AT2_DMA4(false, 0);
        bf16x8 qr[8];
        { const bf16* Pq_ = P; asm volatile("" : "+s"(Pq_));
          int lq_ = lane; asm volatile("" : "+v"(lq_));
          const bf16* Qw = Pq_ + ((size_t)b * LTOK + NCTX + qb * 128 + wq * 32 + (lq_ & 31)) * LDP + OC_Q + h * 256 + mp * 128 + (lq_ >> 5) * 8;
#pragma unroll
          for (int d0 = 0; d0 < 8; ++d0) qr[d0] = *(const bf16x8*)(Qw + d0 * 16); }
        f32x16 o[8];
#pragma unroll
        for (int d0 = 0; d0 < 8; ++d0) o[d0] = (f32x16){};
        float lsum = 0.f;
#if ATT_CNEG
        f32x16 cneg;
#pragma unroll
        for (int g = 0; g < 16; ++g) cneg[g] = negBl;
        asm volatile("" : "+v"(cneg));
#endif
        AT2_WAITBAR0();
#if ATT_DMA2
        if (mp == 1) { AT2_DMA4W(true, 1, 2 * wq); AT2_DMA4W(true, 1, 2 * wq + 1); AT2_WAITBAR8(); }
#else
        if (mp == 1) { AT2_DMA4(true, 1); AT2_WAITBAR4(); }
#endif
        SW_OFF(8); SW_ON(7);
#pragma unroll 1
        for (int t = 0; t < LTOK / 64; ++t) {
            const int stg = t & 1;
            SW_ON(4);
            bool issued;
            if (ATT_PRIO == 4) __builtin_amdgcn_s_setprio(1);
#if ATT_DMA2
            issued = false;
#else
            issued = t + 1 < LTOK / 64; if (issued) AT2_DMA4(mp == 0, t + 1);
#endif
            f32x16 p0, p1; float ps = 0.f;
#if !ATT_CNEG
#pragma unroll
            for (int g = 0; g < 16; ++g) { p0[g] = negBl; p1[g] = negBl; }
#endif
            {
                const unsigned kb_ = ldsb + stg * STAGE + (mp ? K1_OFF : K0_OFF) + r32 * 256;
                const unsigned xs = (unsigned)((hi * 16) ^ ((r32 & 7) << 4));
                const unsigned ka0 = kb_ + (0u ^ xs), ka1 = kb_ + (32u ^ xs), ka2 = kb_ + (64u ^ xs), ka3 = kb_ + (96u ^ xs);
                v4u k0, k1, k2, k3, k4, k5;
#define AT2_KRD(DST, AD, OFF) asm volatile("ds_read_b128 %0, %1 offset:%2" : "=&v"(DST) : "v"(AD), "i"(OFF) : "memory")
#if ATT_SPLIT
#define AT2_KM1(ACC, KF, D0, N) do { asm volatile("s_waitcnt lgkmcnt(" #N ")" ::: "memory"); __builtin_amdgcn_sched_barrier(0); \
                    ACC = __builtin_amdgcn_mfma_f32_32x32x16_bf16(__builtin_bit_cast(bf16x8, KF), qr[D0], ACC, 0, 0, 0); __builtin_amdgcn_sched_barrier(0); } while (0)
#define AT2_SL(G) do { p0[G] = __builtin_amdgcn_exp2f(p0[G]); p0[G + 1] = __builtin_amdgcn_exp2f(p0[G + 1]); ps += p0[G] + p0[G + 1]; __builtin_amdgcn_sched_barrier(0); } while (0)
                AT2_KRD(k0, ka0, 0); AT2_KRD(k1, ka1, 0); AT2_KRD(k2, ka2, 0); AT2_KRD(k3, ka3, 0); AT2_KRD(k4, ka0, 128); AT2_KRD(k5, ka1, 128);
                AT2_KM1(p0, k0, 0, 5); AT2_KRD(k0, ka2, 128);
                AT2_KM1(p0, k1, 1, 5); AT2_KRD(k1, ka3, 128);
                AT2_KM1(p0, k2, 2, 5); AT2_KRD(k2, ka0, 8192);
                AT2_KM1(p0, k3, 3, 5); AT2_KRD(k3, ka1, 8192);
                AT2_KM1(p0, k4, 4, 5); AT2_KRD(k4, ka2, 8192);
                AT2_KM1(p0, k5, 5, 5); AT2_KRD(k5, ka3, 8192);
                AT2_KM1(p0, k0, 6, 5); AT2_KRD(k0, ka0, 8320);
                AT2_KM1(p0, k1, 7, 5); AT2_KRD(k1, ka1, 8320);
                AT2_KM1(p1, k2, 0, 5); AT2_KRD(k2, ka2, 8320); AT2_SL(0);
                AT2_KM1(p1, k3, 1, 5); AT2_KRD(k3, ka3, 8320); AT2_SL(2);
                AT2_KM1(p1, k4, 2, 5); AT2_SL(4);
                AT2_KM1(p1, k5, 3, 4); AT2_SL(6);
                AT2_KM1(p1, k0, 4, 3); AT2_SL(8);
                AT2_KM1(p1, k1, 5, 2); AT2_SL(10);
                AT2_KM1(p1, k2, 6, 1); AT2_SL(12);
                AT2_KM1(p1, k3, 7, 0); AT2_SL(14);
#undef AT2_KM1
#undef AT2_SL
#else
#define AT2_KMM(KA, KB, D0, N) do { asm volatile("s_waitcnt lgkmcnt(" #N ")" ::: "memory"); __builtin_amdgcn_sched_barrier(0); \
                    p0 = __builtin_amdgcn_mfma_f32_32x32x16_bf16(__builtin_bit_cast(bf16x8, KA), qr[D0], p0, 0, 0, 0); p1 = __builtin_amdgcn_mfma_f32_32x32x16_bf16(__builtin_bit_cast(bf16x8, KB), qr[D0], p1, 0, 0, 0); \
                    __builtin_amdgcn_sched_barrier(0); } while (0)
                AT2_KRD(k0, ka0, 0); AT2_KRD(k1, ka0, 8192); AT2_KRD(k2, ka1, 0); AT2_KRD(k3, ka1, 8192); AT2_KRD(k4, ka2, 0); AT2_KRD(k5, ka2, 8192);
#if ATT_CNEG
                asm volatile("s_waitcnt lgkmcnt(4)" ::: "memory"); __builtin_amdgcn_sched_barrier(0);
                p0 = __builtin_amdgcn_mfma_f32_32x32x16_bf16(__builtin_bit_cast(bf16x8, k0), qr[0], cneg, 0, 0, 0); p1 = __builtin_amdgcn_mfma_f32_32x32x16_bf16(__builtin_bit_cast(bf16x8, k1), qr[0], cneg, 0, 0, 0);
                __builtin_amdgcn_sched_barrier(0); AT2_KRD(k0, ka3, 0);   AT2_KRD(k1, ka3, 8192);
#else
                AT2_KMM(k0, k1, 0, 4); AT2_KRD(k0, ka3, 0);   AT2_KRD(k1, ka3, 8192);
#endif
                AT2_KMM(k2, k3, 1, 4); AT2_KRD(k2, ka0, 128); AT2_KRD(k3, ka0, 8320);
                AT2_KMM(k4, k5, 2, 4); AT2_KRD(k4, ka1, 128); AT2_KRD(k5, ka1, 8320);
                AT2_KMM(k0, k1, 3, 4); AT2_KRD(k0, ka2, 128); AT2_KRD(k1, ka2, 8320);
                AT2_KMM(k2, k3, 4, 4); AT2_KRD(k2, ka3, 128); AT2_KRD(k3, ka3, 8320);
                AT2_KMM(k4, k5, 5, 4); AT2_KMM(k0, k1, 6, 2); AT2_KMM(k2, k3, 7, 0);
#undef AT2_KMM
#endif
#undef AT2_KRD
            }
#if ATT_SPLIT
#pragma unroll
            for (int g = 0; g < 16; ++g) { p1[g] = __builtin_amdgcn_exp2f(p1[g]); ps += p1[g]; }
#else
#pragma unroll
            for (int g = 0; g < 16; ++g) { p0[g] = __builtin_amdgcn_exp2f(p0[g]); p1[g] = __builtin_amdgcn_exp2f(p1[g]); ps += p0[g] + p1[g]; }
#endif
            lsum += ps;
            bf16x8 pa0, pa1, pa2, pa3;
#define AT2_PK4(PP, BASE, OUT) do { const unsigned a0 = pg8::cvt_pk_bf16(PP[BASE + 0], PP[BASE + 1]), a1 = pg8::cvt_pk_bf16(PP[BASE + 2], PP[BASE + 3]); \
            const unsigned b0_ = pg8::cvt_pk_bf16(PP[BASE + 4], PP[BASE + 5]), b1_ = pg8::cvt_pk_bf16(PP[BASE + 6], PP[BASE + 7]); \
            auto r0 = __builtin_amdgcn_permlane32_swap(a0, b0_, false, false); auto r1 = __builtin_amdgcn_permlane32_swap(a1, b1_, false, false); \
            v4u w_ = {r0[0], r1[0], r0[1], r1[1]}; OUT = __builtin_bit_cast(bf16x8, w_); } while (0)
            AT2_PK4(p0, 0, pa0); AT2_PK4(p0, 8, pa1); AT2_PK4(p1, 0, pa2); AT2_PK4(p1, 8, pa3);
#undef AT2_PK4
            if (ATT_PRIO == 3 || ATT_PRIO == 4) __builtin_amdgcn_s_setprio(0);
            SW_OFF(4); SW_ON(1); if (issued) AT2_WAITBAR4(); else AT2_WAITBAR0(); SW_OFF(1);
            SW_ON(3);
#if ATT_DMA2
            SW_ON(6); { const int tn_ = t + 1 + mp; issued = tn_ < LTOK / 64; if (issued) { AT2_DMA4W(mp == 1, tn_, 2 * wq); AT2_DMA4W(mp == 1, tn_, 2 * wq + 1); } }
#else
            SW_ON(6); { const int tn_ = t + 1 + mp; issued = tn_ < LTOK / 64; if (issued) AT2_DMA4(mp == 1, tn_); }
#endif
#if ATT_TOUCH
            if (issued && t + ATT_TOUCH < LTOK / 64) { int lt_ = lane; asm volatile("" : "+v"(lt_)); const int li_ = wave * 64 + lt_;
                const char* tp_ = ((li_ >> 8) ? Vg : Kg) + (size_t)((t + ATT_TOUCH) * 64 + ((li_ >> 2) & 63)) * (LDP * 2) + (li_ & 3) * 128;
                __builtin_amdgcn_global_load_lds((const unsigned*)tp_, (LAS unsigned*)(F.lds + LDSCTL_OFF + 4096 + wave * 256), 4, 0, 0); }
#endif
#if PROBE_SW == 6
            asm volatile("s_waitcnt vmcnt(0)" ::: "memory");
#endif
            SW_OFF(6);
            const unsigned vb = ldsb + stg * STAGE + V_OFF + vrd;
            s16x4 va0, va1, va2, va3, vc0, vc1, vc2, vc3, vd0, vd1, vd2, vd3;
#define AT2_RDH(B, D0, KS) do { B##0 = tr_read<v_rd_off(D0, KS, 0)>(vb); B##1 = tr_read<v_rd_off(D0, KS, 1)>(vb); B##2 = tr_read<v_rd_off(D0, KS + 1, 0)>(vb); B##3 = tr_read<v_rd_off(D0, KS + 1, 1)>(vb); } while (0)
#define AT2_PKV(L, H) (bf16x8){L[0], L[1], L[2], L[3], H[0], H[1], H[2], H[3]}
#define AT2_MMH(B, D0, PA, PB, N) do { asm volatile("s_waitcnt lgkmcnt(" #N ")" ::: "memory"); __builtin_amdgcn_sched_barrier(0); \
                o[D0] = __builtin_amdgcn_mfma_f32_32x32x16_bf16(PA, AT2_PKV(B##0, B##1), o[D0], 0, 0, 0); o[D0] = __builtin_amdgcn_mfma_f32_32x32x16_bf16(PB, AT2_PKV(B##2, B##3), o[D0], 0, 0, 0); \
                __builtin_amdgcn_sched_barrier(0); } while (0)
            if (ATT_PRIO == 2) __builtin_amdgcn_s_setprio(1);
            AT2_RDH(va, 0, 0); AT2_RDH(vc, 0, 2);
            AT2_RDH(vd, 1, 0); AT2_MMH(va, 0, pa0, pa1, 8);
            AT2_RDH(va, 1, 2); AT2_MMH(vc, 0, pa2, pa3, 8);
            AT2_RDH(vc, 2, 0); AT2_MMH(vd, 1, pa0, pa1, 8);
            AT2_RDH(vd, 2, 2); AT2_MMH(va, 1, pa2, pa3, 8);
            AT2_RDH(va, 3, 0); AT2_MMH(vc, 2, pa0, pa1, 8);
            AT2_RDH(vc, 3, 2); AT2_MMH(vd, 2, pa2, pa3, 8);
            AT2_RDH(vd, 4, 0); AT2_MMH(va, 3, pa0, pa1, 8);
            AT2_RDH(va, 4, 2); AT2_MMH(vc, 3, pa2, pa3, 8);
            AT2_RDH(vc, 5, 0); AT2_MMH(vd, 4, pa0, pa1, 8);
            AT2_RDH(vd, 5, 2); AT2_MMH(va, 4, pa2, pa3, 8);
            AT2_RDH(va, 6, 0); AT2_MMH(vc, 5, pa0, pa1, 8);
            AT2_RDH(vc, 6, 2); AT2_MMH(vd, 5, pa2, pa3, 8);
            AT2_RDH(vd, 7, 0); AT2_MMH(va, 6, pa0, pa1, 8);
            AT2_RDH(va, 7, 2); AT2_MMH(vc, 6, pa2, pa3, 8);
            AT2_MMH(vd, 7, pa0, pa1, 4);
            AT2_MMH(va, 7, pa2, pa3, 0);
            if (ATT_PRIO == 2) __builtin_amdgcn_s_setprio(0);
#undef AT2_RDH
#undef AT2_PKV
#undef AT2_MMH
#if ATT_DMA2
            SW_OFF(3); SW_ON(2); if (issued) AT2_WAITBAR8(); else AT2_WAITBAR0(); SW_OFF(2);
#else
            SW_OFF(3); SW_ON(2); if (issued) AT2_WAITBAR4(); else AT2_WAITBAR0(); SW_OFF(2);
#endif
        }
        SW_OFF(7);
        if (mp == 0) AT2_WAITBAR0();
#undef AT2_DMA4
#undef AT2_WAITBAR4
#undef AT2_WAITBAR0
#undef AT2_WAITBAR8
#undef AT2_DMA4W
        SW_ON(5);
        int lane_e = lane; asm volatile("" : "+v"(lane_e)); const int r32e = lane_e & 31, hie = lane_e >> 5;
        { auto rr = __builtin_amdgcn_permlane32_swap(__float_as_uint(lsum), __float_as_uint(lsum), false, false); lsum = __uint_as_float(rr[0]) + __uint_as_float(rr[1]); }
        v4u gtr[8];
        { const bf16* gb_ = P + ((size_t)b * LTOK + NCTX + qb * 128 + wave * 16 + hie) * LDP + OC_GATE + h * 256 + r32e * 8;
#pragma unroll
          for (int it = 0; it < 8; ++it) gtr[it] = *(const v4u*)(gb_ + (size_t)(it * 2) * LDP); }
        if (hie == 0) xw[r32e] = lsum;
        asm volatile("s_waitcnt lgkmcnt(0)" ::: "memory");
        {   float rli[16];
#pragma unroll
            for (int g = 0; g < 16; ++g) rli[g] = __builtin_amdgcn_rcpf(xw[crow(g, hie)]);
#pragma unroll
            for (int d0 = 0; d0 < 8; ++d0)
#pragma unroll
                for (int g = 0; g < 16; ++g) o[d0][g] *= rli[g];
        }
        __builtin_amdgcn_sched_barrier(0);
        {   LAS unsigned char* img = F.lds + mp * 65536 + wq * 16384 + (4 * hie) * 512 + r32e * 2;
#pragma unroll
            for (int d0 = 0; d0 < 8; ++d0) {
#pragma unroll
                for (int g = 0; g < 16; ++g) *(LAS unsigned short*)(img + ((g & 3) + 8 * (g >> 2)) * 512 + d0 * 64) = (unsigned short)f2bf(o[d0][g]);
                __builtin_amdgcn_sched_barrier(0); }
        }
        __syncthreads();
        {   const float* lq = argp(I_LQK);
            const float d01 = wave_sum(lq[lane_e] * lq[128 + lane_e] + lq[64 + lane_e] * lq[192 + lane_e]);
            const float d23 = wave_sum(lq[256 + lane_e] * lq[384 + lane_e] + lq[320 + lane_e] * lq[448 + lane_e]);
            const float nlam = -(expf(d01) - expf(d23) + LAM_INIT1);
            const int c8 = r32e * 8;
            const float* cg = argp(I_CG) + c8;
            const f32x4 g0 = *(const f32x4*)cg, g1 = *(const f32x4*)(cg + 4);
            const float gn[8] = {g0[0], g0[1], g0[2], g0[3], g1[0], g1[1], g1[2], g1[3]};
            bf16* ybase = Y2 + ((size_t)b * SEQ + qb * 128) * DM + h * 256 + c8;
#pragma unroll
            for (int it = 0; it < 8; ++it) {
                const int rr = wave * 16 + it * 2 + hie;
                const LAS unsigned char* ip = F.lds + (rr >> 5) * 16384 + (rr & 31) * 512 + c8 * 2;
                float a[8], bb[8], gt[8];
                unpack8(*(const LAS v4u*)ip, a); unpack8(*(const LAS v4u*)(ip + 65536), bb); unpack8(gtr[it], gt);
                float ss = 0.f;
#pragma unroll
                for (int e = 0; e < 8; ++e) { a[e] = fmaf(nlam, bb[e], a[e]); ss = fmaf(a[e], a[e], ss); }
                ss += __shfl_xor(ss, 1); ss += __shfl_xor(ss, 2); ss += __shfl_xor(ss, 4); ss += __shfl_xor(ss, 8); ss += __shfl_xor(ss, 16);
                const float rstd = rsqrtf(ss * (1.f / 256.f) + EPS) * (1.f - LAM_INIT1);
                float y[8];
#pragma unroll
                for (int e = 0; e < 8; ++e) y[e] = a[e] * rstd * gn[e] * siluf_(gt[e]);
                *(v4u*)(ybase + (size_t)rr * DM) = pack8(y);
            }
        }
        __syncthreads();
        SW_OFF(5);
    }
#if PROBE_SW
    if (wave == PROBE_SW_WAVE) { const unsigned long long t0_ = __builtin_amdgcn_s_memtime(); while (__builtin_amdgcn_s_memtime() - t0_ < sw_acc) __builtin_amdgcn_s_sleep(8); }
#endif
}

__global__ void __launch_bounds__(NWAVES * 64, 2) mega_fwd(Args args) {
    extern __shared__ __attribute__((aligned(16))) unsigned char lds[];
    Frame F;
    F.lds = (LAS unsigned char*)lds;
    F.G = gridDim.x;
#if MK_ONE_LAUNCH
    if (args.ph_hi == 0x7fffffff) cg::this_grid().sync();
    { const int t0_ = tid_();
      for (int u = t0_; u < (LDS_BYTES - LDSCTL_OFF) / 4; u += NWAVES * 64) ((LAS unsigned*)(F.lds + LDSCTL_OFF))[u] = 0u;
      __syncthreads();
      if ((t0_ & 63) == 0) ((volatile LAS unsigned*)(F.lds + WTAB_OFF))[hw_slot_()] = (unsigned)(t0_ >> 6);
      __syncthreads(); }
    F.ids();
    const XcdBarrier bar = xcd_barrier_post((unsigned*)(args.ws + WS_CTL) + CW_BAR, (volatile LAS unsigned*)(F.lds + MISC_OFF) + 8, F.wave, F.lds);
    if (F.tid == 0) {
        volatile LAS unsigned* misc_ = (volatile LAS unsigned*)(F.lds + MISC_OFF);
        misc_[10] = __hip_atomic_fetch_add((unsigned*)(args.ws + WS_CTL) + CW_RANK + 64 * bar.x, 1u, __ATOMIC_RELAXED, __HIP_MEMORY_SCOPE_AGENT); misc_[11] = bar.x; }
    __syncthreads();
#endif
    const int lo = args.ph_lo, hi = args.ph_hi;
#define IN(k) (lo <= (k) && (k) < hi)
#if PROBE_PH_MASK
    unsigned long long ph_acc = 0, ph_t0 = 0;
#define PH_ON(k) do { if ((PROBE_PH_MASK >> (k)) & 1) ph_t0 = __builtin_amdgcn_s_memtime(); } while (0)
#define PH_OFF(k) do { if ((PROBE_PH_MASK >> (k)) & 1) ph_acc += __builtin_amdgcn_s_memtime() - ph_t0; } while (0)
#else
#define PH_ON(k) do { } while (0)
#define PH_OFF(k) do { } while (0)
#endif
#if MK_ONE_LAUNCH
#define GRIDBAR() do { XcdBarrier b_; b_.bar = (unsigned*)(karg_ptr_(168) + WS_CTL) + CW_BAR; b_.x = xb_xcc_id(); b_.w = 0; b_.st = (volatile LAS unsigned*)(F.lds + MISC_OFF) + 8; b_.lds0 = F.lds; xcd_barrier(b_); } while (0)
#define SEAM(k) do { if (IN(k) && IN((k) + 1)) { XcdBarrier b_; b_.bar = (unsigned*)(karg_ptr_(168) + WS_CTL) + CW_BAR; b_.x = xb_xcc_id(); b_.w = 0; b_.st = (volatile LAS unsigned*)(F.lds + MISC_OFF) + 8; b_.lds0 = F.lds; xcd_barrier(b_); } } while (0)
#else
#define SEAM(k) do { } while (0)
#endif
#define Hb ((bf16*)(F.ws + WS_H))
#define Pb ((bf16*)(F.ws + WS_P))
#define mod0 ((const float*)(F.ws + WS_MOD))
#define mod1 ((const float*)(F.ws + WS_MOD) + 9 * 6144)
#define ctx1 ((float*)(F.ws + WS_CTX1))

#ifndef PROBE_P0X
#define PROBE_P0X 0
#endif
#if PROBE_P0X
    const unsigned long long px_s = __builtin_amdgcn_s_memrealtime();
#endif
    PH_ON(0); if (IN(0)) for (int rep_ = 0; rep_ < (((PROBE_DUP_MASK >> 0) & 1) ? 2 : 1); ++rep_) { F.ids(); p0_prologue(F); }
#if PROBE_P0X
    { const unsigned long long px_e = __builtin_amdgcn_s_memrealtime(); unsigned long long* pw = (unsigned long long*)(karg_ptr_(168) + WS_CTL) + 16384;
      if (lane_id_() == 0) { __hip_atomic_fetch_max(pw + 0, px_s, __ATOMIC_RELAXED, __HIP_MEMORY_SCOPE_AGENT); __hip_atomic_fetch_max(pw + 8, (1ull << 62) - px_s, __ATOMIC_RELAXED, __HIP_MEMORY_SCOPE_AGENT);
                             __hip_atomic_fetch_max(pw + 16, px_e - px_s, __ATOMIC_RELAXED, __HIP_MEMORY_SCOPE_AGENT); } }
#endif
    PH_ON(14); SEAM(0); PH_OFF(14); PH_OFF(0);
#if PROBE_P0X
    if (blockIdx.x == 0 && F.wave == 0) { unsigned long long* pw = (unsigned long long*)(karg_ptr_(168) + WS_CTL) + 16384;
      const unsigned long long w0 = __hip_atomic_load(pw + 0, __ATOMIC_RELAXED, __HIP_MEMORY_SCOPE_AGENT), w1 = __hip_atomic_load(pw + 8, __ATOMIC_RELAXED, __HIP_MEMORY_SCOPE_AGENT), w2 = __hip_atomic_load(pw + 16, __ATOMIC_RELAXED, __HIP_MEMORY_SCOPE_AGENT);
      const unsigned long long d_ = (PROBE_P0X == 1) ? (w0 - ((1ull << 62) - w1)) : w2;
      const unsigned long long t0_ = __builtin_amdgcn_s_memrealtime(); while (__builtin_amdgcn_s_memrealtime() - t0_ < 4 * d_) __builtin_amdgcn_s_sleep(8); }
#endif
    PH_ON(1); if (IN(1)) for (int rep_ = 0; rep_ < (((PROBE_DUP_MASK >> 1) & 1) ? 2 : 1); ++rep_) { F.ids(); modulate_phase(F, 0, argp(I_X), argp(I_CTX)); } SEAM(1); PH_OFF(1);
    PH_ON(2); if (IN(2)) for (int rep_ = 0; rep_ < (((PROBE_DUP_MASK >> 2) & 1) ? 2 : 1); ++rep_) { F.ids();
        PH_ON(15); zgemm_phase(F); PH_OFF(15);
        __syncthreads();
        pg8::Gemm g{Hb, (const bf16*)(F.ws + WS_WIE), MROWS, NP, DM}; pg8::StaticOrder S; S.init(MROWS, NP, F.G, (int)blockIdx.x);
        pg8::EpiEven E{Pb, LDP, (const float*)(F.ws + WS_LBT)};
        pg8::gemm_phase<pg8::EpiEven, pg8::StaticOrder, true, true>(F.lds, g, S, E, F.tid);
    } SEAM(2); PH_OFF(2);
        PH_ON(3); if (IN(3)) for (int rep_ = 0; rep_ < (((PROBE_DUP_MASK >> 3) & 1) ? 2 : 1); ++rep_) { F.ids(); PH_ON(19); scan_phase_v2(F, (bf16*)F.out, Hb); PH_OFF(19); } SEAM(3); PH_OFF(3);
    PH_ON(4); if (IN(4)) for (int rep_ = 0; rep_ < (((PROBE_DUP_MASK >> 4) & 1) ? 2 : 1); ++rep_) { F.ids(); evengate_phase(F, (const bf16*)F.out); } SEAM(4); PH_OFF(4);
    PH_ON(5); if (IN(5) && IN(6)) { F.ids();
        if (F.G == 256) {
            { pg8::Gemm g{Hb, (const bf16*)(F.ws + WS_WOE), MROWS, DM, DM}; pg8::RangeOrder S; S.init(64 * 256, DM, F.G, (int)blockIdx.x); S.pm0 = 0;
              pg8::EpiResL0 E{argp(I_X), argp(I_CTX), (bf16*)(F.ws + WS_X1A), (bf16*)(F.ws + WS_X1B), (bf16*)(F.ws + WS_C1B), mod0};
              pg8::gemm_phase<pg8::EpiResL0, pg8::RangeOrder, true, true>(F.lds, g, S, E, F.tid); }
            PH_ON(10); GRIDBAR(); PH_OFF(10);
            PH_ON(6);
            F.ids();
            if (blockIdx.x < 64) { pg8::Gemm g{Hb, (const bf16*)(F.ws + WS_WOE), MROWS, DM, DM}; pg8::RangeOrder S; S.init(8 * 256, DM, 64, (int)blockIdx.x); S.pm0 = 64;
              pg8::EpiResL0 E{argp(I_X), argp(I_CTX), (bf16*)(F.ws + WS_X1A), (bf16*)(F.ws + WS_X1B), (bf16*)(F.ws + WS_C1B), mod0};
              pg8::gemm_phase<pg8::EpiResL0, pg8::RangeOrder, true, true>(F.lds, g, S, E, F.tid); }
            else { PH_ON(17); modulate_phase_b(F, 1, 0, 64 * 256, ((int)blockIdx.x - 64) * NWAVES + F.wave, 192 * NWAVES); PH_OFF(17);
                   PH_ON(18); if (L1_LATE) p0_transposes(F, L1_SPLIT + L1_SCAN_ITEMS, P0_I_E + P0_I_S + P0_I_O + P0_I_S, ((int)blockIdx.x - 64) * NWAVES + F.wave, 192 * NWAVES); PH_OFF(18); }
            GRIDBAR();
            PH_OFF(6); PH_ON(8);
            F.ids(); modulate_phase_b(F, 1, 64 * 256, MROWS, blockIdx.x * NWAVES + F.wave, F.G * NWAVES);
            PH_OFF(8);
        } else {
            { pg8::Gemm g{Hb, (const bf16*)(F.ws + WS_WOE), MROWS, DM, DM}; pg8::StaticOrder S; S.init(MROWS, DM, F.G, (int)blockIdx.x);
              pg8::EpiResL0 E{argp(I_X), argp(I_CTX), (bf16*)(F.ws + WS_X1A), (bf16*)(F.ws + WS_X1B), (bf16*)(F.ws + WS_C1B), mod0};
              pg8::gemm_phase<pg8::EpiResL0, pg8::StaticOrder, true, true>(F.lds, g, S, E, F.tid); }
            GRIDBAR();
            F.ids(); modulate_phase_b(F, 1, 0, MROWS, blockIdx.x * NWAVES + F.wave, F.G * NWAVES);
        }
    } SEAM(6); PH_OFF(5);
#ifndef PROBE_IDLE
#define PROBE_IDLE 0
#endif
#if PROBE_IDLE
    { const unsigned long long t0_ = __builtin_amdgcn_s_memrealtime(); while (__builtin_amdgcn_s_memrealtime() - t0_ < (unsigned long long)(PROBE_IDLE)) __builtin_amdgcn_s_sleep(32); }
#endif
    PH_ON(7); if (IN(7)) for (int rep_ = 0; rep_ < (((PROBE_DUP_MASK >> 7) & 1) ? 2 : 1); ++rep_) { F.ids();
        pg8::Gemm g{Hb, (const bf16*)(F.ws + WS_WIO), MROWS, NP, DM}; pg8::StaticOrder S; S.init(MROWS, NP, F.G, (int)blockIdx.x);
        pg8::EpiOdd E{Pb, LDP, argp(I_QG), argp(I_KG), (const float*)(F.ws + WS_ROPE), (LAS float*)(F.lds + LDSCTL_OFF + 4096), QSCALE};
        pg8::gemm_phase<pg8::EpiOdd, pg8::StaticOrder, true, true>(F.lds, g, S, E, F.tid);
    } SEAM(7); PH_OFF(7);
    PH_ON(9); if (IN(9)) for (int rep_ = 0; rep_ < (((PROBE_DUP_MASK >> 9) & 1) ? 2 : 1); ++rep_) { F.ids(); attn_phase_v2(F); } SEAM(9); PH_OFF(9);
    PH_ON(11); if (IN(11)) for (int rep_ = 0; rep_ < (((PROBE_DUP_MASK >> 11) & 1) ? 2 : 1); ++rep_) { F.ids();
        pg8::Gemm g{(const bf16*)(F.ws + WS_O0), (const bf16*)(F.ws + WS_WOO), MLAT, DM, DM}; pg8::StaticOrder S; S.init(MLAT, DM, F.G, (int)blockIdx.x);
        pg8::EpiResL1 E{(const bf16*)(F.ws + WS_X1A), (const bf16*)(F.ws + WS_X1B), F.out, mod1};
        pg8::gemm_phase<pg8::EpiResL1, pg8::StaticOrder, true, true>(F.lds, g, S, E, F.tid);
    }
    PH_OFF(11);
#if PROBE_PH_MASK
    if (blockIdx.x == PROBE_PH_BLOCK && F.wave == 0 && lane_id_() == 0) { const unsigned long long t0_ = __builtin_amdgcn_s_memtime(); while (__builtin_amdgcn_s_memtime() - t0_ < PROBE_PH_AMP * ph_acc) __builtin_amdgcn_s_sleep(8); }
#endif
#undef Hb
#undef Pb
#undef mod0
#undef mod1
#undef ctx1
#undef IN
#undef SEAM
}
constexpr int N_PHASES = 12;

extern "C" void kernel_launch(void* const* d_in, const int* in_sizes, int n_in, void* d_out, int out_size, void* d_ws, size_t ws_size, hipStream_t stream) {
    static int grid = 0;
    if (grid == 0) {
        if (n_in != 20 || in_sizes[0] != MLAT * DM || out_size != MLAT * DM || ws_size < WS_END) {
            fprintf(stderr, "kernel_launch: unexpected shapes: n_in %d in0 %d out %d ws %zu (need >= %zu)\n", n_in, n_in > 0 ? in_sizes[0] : -1, out_size, ws_size, (size_t)WS_END); grid = -1; return; }
        int dev = 0, cus = 0, per_cu = 0;
        if (hipGetDevice(&dev) != hipSuccess || hipDeviceGetAttribute(&cus, hipDeviceAttributeMultiprocessorCount, dev) != hipSuccess) { grid = -1; return; }
        if (hipFuncSetAttribute((const void*)mega_fwd, hipFuncAttributeMaxDynamicSharedMemorySize, LDS_BYTES) != hipSuccess) { fprintf(stderr, "kernel_launch: hipFuncSetAttribute failed\n"); grid = -1; return; }
        if (hipOccupancyMaxActiveBlocksPerMultiprocessor(&per_cu, (const void*)mega_fwd, NWAVES * 64, LDS_BYTES) != hipSuccess || per_cu < 1) { fprintf(stderr, "kernel_launch: occupancy query says %d blocks per CU\n", per_cu); (void)hipGetLastError(); grid = -1; return; }
        grid = cus;
    }
    if (grid < 0) return;
    Args a{};
    for (int i = 0; i < 20; ++i) a.in[i] = (const float*)d_in[i];
    a.out = (float*)d_out; a.ws = (unsigned char*)d_ws;
#if MK_ONE_LAUNCH
    if (hipMemsetAsync((char*)d_ws + WS_CTL, 0, CTL_ZERO_BYTES, stream) != hipSuccess) { fprintf(stderr, "kernel_launch: hipMemsetAsync failed\n"); return; }
    a.ph_lo = 0; a.ph_hi = N_PHASES;
    void* kargs[] = {&a};
    const hipError_t e = hipLaunchCooperativeKernel((const void*)mega_fwd, dim3(grid), dim3(NWAVES * 64), kargs, LDS_BYTES, stream);
    if (e != hipSuccess) fprintf(stderr, "kernel_launch: cooperative launch failed: %s (grid %d)\n", hipGetErrorString(e), grid);
#else
    for (int p = 0; p < N_PHASES; ++p) {
        a.ph_lo = p; a.ph_hi = p + 1;
        hipLaunchKernelGGL(mega_fwd, dim3(grid), dim3(NWAVES * 64), LDS_BYTES, stream, a);
    }
    const hipError_t le = hipPeekAtLastError();
    if (le != hipSuccess) fprintf(stderr, "kernel_launch: launch failed: %s\n", hipGetErrorName(le));
#endif
}
```
